# Optimizing an MI355X kernel written in HIP

```python
import math
import jax, jax.numpy as jnp
from jax import lax
import numpy as np

D_MODEL = 2048
BATCH = 1
SEQ = 16384
DEPTH = 1

DEEPNORM_ALPHA = (2.0 * DEPTH) ** 0.25
DEEPNORM_BETA = (8.0 * DEPTH) ** -0.25
LN_EPS = 1e-5
RMS_EPS = 1e-6
ROPE_THETA = 10000.0
NEG_INF = -1e30
Q_BLOCK = 128

D_FF = 5632
FFN_RES_WEIGHT = 0.5

MLA_HEADS = 8
MLA_Q_RANK = 512
MLA_KV_RANK = 256
MLA_NOPE_DIM = 128
MLA_ROPE_DIM = 64
MLA_V_DIM = 128

NSA_HEADS = 8
NSA_KV_HEADS = 2
NSA_HEAD_DIM = 128
NSA_GROUP = NSA_HEADS // NSA_KV_HEADS
CMP_BLOCK = 32
CMP_STRIDE = 16
CMP_HIDDEN = 256
SEL_BLOCK = 64
SEL_TOPK = 16
WINDOW = 512
N_BRANCH = 3
FORCE_BONUS = 1e4

MIX_WIDTH = MLA_HEADS * MLA_V_DIM + NSA_HEADS * NSA_HEAD_DIM
NSA_KV_WIDTH = NSA_KV_HEADS * NSA_HEAD_DIM
IN_SIZES = (MLA_Q_RANK, MLA_KV_RANK, MLA_ROPE_DIM, NSA_HEADS * NSA_HEAD_DIM,
            NSA_KV_WIDTH, NSA_KV_WIDTH, NSA_KV_WIDTH, NSA_KV_WIDTH, NSA_KV_WIDTH, NSA_KV_WIDTH,
            N_BRANCH * NSA_HEADS)
IN_COLS = sum(IN_SIZES)

kernel_name = "hybrid_mla_nsa_macaron_deepnorm"


def layer_norm(x, g, b):
    xf = x.astype(jnp.float32)
    mu = jnp.mean(xf, axis=-1, keepdims=True)
    var = jnp.mean(jnp.square(xf - mu), axis=-1, keepdims=True)
    return ((xf - mu) * lax.rsqrt(var + LN_EPS) * g + b).astype(x.dtype)


def rms_norm(x, g):
    xf = x.astype(jnp.float32)
    ms = jnp.mean(jnp.square(xf), axis=-1, keepdims=True)
    return (xf * lax.rsqrt(ms + RMS_EPS) * g).astype(x.dtype)


def rope(x, pos):
    d = x.shape[-1]
    half = d // 2
    inv = ROPE_THETA ** (-jnp.arange(half, dtype=jnp.float32) * (2.0 / d))
    ang = pos.astype(jnp.float32)[:, None] * inv[None, :]
    cos, sin = jnp.cos(ang), jnp.sin(ang)
    x1 = x[..., :half].astype(jnp.float32)
    x2 = x[..., half:].astype(jnp.float32)
    return jnp.concatenate([x1 * cos - x2 * sin, x2 * cos + x1 * sin], axis=-1).astype(x.dtype)


def swiglu(x, w_gate, w_up, w_down):
    return (jax.nn.silu(x @ w_gate) * (x @ w_up)) @ w_down


def split_cols(h, sizes):
    offsets = [int(v) for v in np.cumsum(sizes)[:-1]]
    return jnp.split(h, offsets, axis=-1)


def to_heads(t, n):
    b, s, _ = t.shape
    return t.reshape(b, s, n, -1).transpose(0, 2, 1, 3)


def masked_probs(s, mask):
    s = jnp.where(mask, s, NEG_INF)
    m = jnp.max(s, axis=-1, keepdims=True)
    p = jnp.where(mask, jnp.exp(s - m), 0.0)
    return p / jnp.maximum(jnp.sum(p, axis=-1, keepdims=True), 1e-30)


def mla_attention(c_q, c_kv, k_rope, q_norm_g, w_uq, kv_norm_g, w_ukv, pos):
    b, s, _ = c_q.shape
    q = (rms_norm(c_q, q_norm_g) @ w_uq).reshape(b, s, MLA_HEADS, MLA_NOPE_DIM + MLA_ROPE_DIM)
    q = q.transpose(0, 2, 1, 3)
    q_nope = q[..., :MLA_NOPE_DIM]
    q_rope = rope(q[..., MLA_NOPE_DIM:], pos)
    kv = (rms_norm(c_kv, kv_norm_g) @ w_ukv).reshape(b, s, MLA_HEADS, MLA_NOPE_DIM + MLA_V_DIM)
    kv = kv.transpose(0, 2, 1, 3)
    k_nope, v = kv[..., :MLA_NOPE_DIM], kv[..., MLA_NOPE_DIM:]
    k_r = rope(k_rope, pos)
    scale = (MLA_NOPE_DIM + MLA_ROPE_DIM) ** -0.5
    kpos = jnp.arange(s)

    def block(i):
        q0 = i * Q_BLOCK
        qn = lax.dynamic_slice_in_dim(q_nope, q0, Q_BLOCK, axis=2)
        qr = lax.dynamic_slice_in_dim(q_rope, q0, Q_BLOCK, axis=2)
        sc = (jnp.einsum("bhqd,bhkd->bhqk", qn, k_nope, preferred_element_type=jnp.float32)
              + jnp.einsum("bhqd,bkd->bhqk", qr, k_r, preferred_element_type=jnp.float32)) * scale
        tq = q0 + jnp.arange(Q_BLOCK)
        mask = tq[:, None] >= kpos[None, :]
        p = jax.nn.softmax(jnp.where(mask, sc, NEG_INF), axis=-1)
        return jnp.einsum("bhqk,bhkd->bhqd", p.astype(v.dtype), v)

    o = lax.map(block, jnp.arange(s // Q_BLOCK))
    return o.transpose(1, 0, 3, 2, 4).reshape(b, s, MLA_HEADS * MLA_V_DIM)


def nsa_attention(q, k_cmp, v_cmp, k_sel, v_sel, k_win, v_win, gate_logits, gate_b,
                  pe_k, w1_k, w2_k, pe_v, w1_v, w2_v, pos):
    b, s, _ = q.shape
    hk, g, d = NSA_KV_HEADS, NSA_GROUP, NSA_HEAD_DIM
    qg = rope(to_heads(q, NSA_HEADS), pos).reshape(b, hk, g, s, d)
    k_cmp = rope(to_heads(k_cmp, hk), pos)
    v_cmp = to_heads(v_cmp, hk)
    k_sel = rope(to_heads(k_sel, hk), pos)
    v_sel = to_heads(v_sel, hk)
    k_win = rope(to_heads(k_win, hk), pos)
    v_win = to_heads(v_win, hk)

    n_cmp = (s - CMP_BLOCK) // CMP_STRIDE + 1
    idx = jnp.arange(n_cmp)[:, None] * CMP_STRIDE + jnp.arange(CMP_BLOCK)[None, :]

    def compress(t, pe, w1, w2):
        blk = t[:, :, idx, :] + pe
        flat = blk.reshape(b, hk, n_cmp, CMP_BLOCK * d)
        return jax.nn.gelu(flat @ w1) @ w2

    kc = compress(k_cmp, pe_k, w1_k, w2_k)
    vc = compress(v_cmp, pe_v, w1_v, w2_v)
    cmp_end = jnp.arange(n_cmp) * CMP_STRIDE + CMP_BLOCK - 1

    n_sel = s // SEL_BLOCK
    top_n = min(SEL_TOPK, n_sel)
    ci = jnp.arange(n_cmp)[:, None] * CMP_STRIDE
    sj = jnp.arange(n_sel)[None, :] * SEL_BLOCK
    ov = jnp.clip(jnp.minimum(ci + CMP_BLOCK, sj + SEL_BLOCK) - jnp.maximum(ci, sj), 0, None)
    ov = ov.astype(jnp.float32) / CMP_STRIDE
    ks_blocks = k_sel.reshape(b, hk, n_sel, SEL_BLOCK, d)
    vs_blocks = v_sel.reshape(b, hk, n_sel, SEL_BLOCK, d)
    gather = jax.vmap(jax.vmap(lambda blocks, ix: blocks[ix]))
    bj = jnp.arange(n_sel)

    kw_pad = jnp.pad(k_win, ((0, 0), (0, 0), (WINDOW, 0), (0, 0)))
    vw_pad = jnp.pad(v_win, ((0, 0), (0, 0), (WINDOW, 0), (0, 0)))

    gates = jax.nn.sigmoid((gate_logits + gate_b).astype(jnp.float32))
    gates = gates.reshape(b, s, N_BRANCH, hk, g).transpose(0, 2, 3, 4, 1)
    scale = d ** -0.5

    def block(i):
        q0 = i * Q_BLOCK
        qb = lax.dynamic_slice_in_dim(qg, q0, Q_BLOCK, axis=3)
        tq = q0 + jnp.arange(Q_BLOCK)
        s_c = jnp.einsum("bhgqd,bhkd->bhgqk", qb, kc, preferred_element_type=jnp.float32) * scale
        p_c = masked_probs(s_c, cmp_end[None, :] <= tq[:, None])
        o_c = jnp.einsum("bhgqk,bhkd->bhgqd", p_c.astype(vc.dtype), vc)
        imp = jnp.einsum("bhgqc,cj->bhqj", p_c, ov)
        cur = tq // SEL_BLOCK
        valid = bj[None, :] * SEL_BLOCK <= tq[:, None]
        forced = (bj[None, :] == 0) | (bj[None, :] == cur[:, None]) | (bj[None, :] == cur[:, None] - 1)
        score = jnp.where(valid, imp + FORCE_BONUS * forced.astype(jnp.float32), NEG_INF)
        top_s, top_j = lax.top_k(score, top_n)
        sel_ok = top_s > 0.5 * NEG_INF
        kg = gather(ks_blocks, top_j).reshape(b, hk, Q_BLOCK, top_n * SEL_BLOCK, d)
        vg = gather(vs_blocks, top_j).reshape(b, hk, Q_BLOCK, top_n * SEL_BLOCK, d)
        key_pos = (top_j[..., None] * SEL_BLOCK + jnp.arange(SEL_BLOCK)).reshape(b, hk, Q_BLOCK, top_n * SEL_BLOCK)
        m_s = (key_pos <= tq[:, None]) & jnp.repeat(sel_ok, SEL_BLOCK, axis=-1)
        s_s = jnp.einsum("bhgqd,bhqkd->bhgqk", qb, kg, preferred_element_type=jnp.float32) * scale
        p_s = masked_probs(s_s, m_s[:, :, None])
        o_s = jnp.einsum("bhgqk,bhqkd->bhgqd", p_s.astype(vg.dtype), vg)
        kw = lax.dynamic_slice_in_dim(kw_pad, q0, WINDOW + Q_BLOCK, axis=2)
        vw = lax.dynamic_slice_in_dim(vw_pad, q0, WINDOW + Q_BLOCK, axis=2)
        wpos = q0 - WINDOW + jnp.arange(WINDOW + Q_BLOCK)
        m_w = (wpos[None, :] <= tq[:, None]) & (wpos[None, :] > tq[:, None] - WINDOW) & (wpos[None, :] >= 0)
        s_w = jnp.einsum("bhgqd,bhkd->bhgqk", qb, kw, preferred_element_type=jnp.float32) * scale
        p_w = masked_probs(s_w, m_w)
        o_w = jnp.einsum("bhgqk,bhkd->bhgqd", p_w.astype(vw.dtype), vw)
        gb = lax.dynamic_slice_in_dim(gates, q0, Q_BLOCK, axis=4).astype(o_c.dtype)
        return gb[:, 0, ..., None] * o_c + gb[:, 1, ..., None] * o_s + gb[:, 2, ..., None] * o_w

    o = lax.map(block, jnp.arange(s // Q_BLOCK))
    return o.transpose(1, 0, 4, 2, 3, 5).reshape(b, s, NSA_HEADS * d)


def setup_inputs(seed: int = 0) -> dict:
    key = jax.random.key(seed)
    ks = iter(jax.random.split(key, 40))

    def nrm(shape, scale):
        return jax.random.normal(next(ks), shape, jnp.float32) * scale

    def gain(shape):
        return 1.0 + nrm(shape, 0.02)

    L = DEPTH
    hd = NSA_HEAD_DIM
    return {
        "x": nrm((BATCH, SEQ, D_MODEL), 1.0),
        "ffn1_w_gate": nrm((L, D_MODEL, D_FF), D_MODEL ** -0.5),
        "ffn1_w_up": nrm((L, D_MODEL, D_FF), D_MODEL ** -0.5),
        "ffn1_w_down": nrm((L, D_FF, D_MODEL), D_FF ** -0.5 * DEEPNORM_BETA),
        "ln1_g": gain((L, D_MODEL)),
        "ln1_b": nrm((L, D_MODEL), 0.02),
        "w_in": nrm((L, D_MODEL, IN_COLS), D_MODEL ** -0.5),
        "mla_q_norm_g": gain((L, MLA_Q_RANK)),
        "mla_w_uq": nrm((L, MLA_Q_RANK, MLA_HEADS * (MLA_NOPE_DIM + MLA_ROPE_DIM)), MLA_Q_RANK ** -0.5),
        "mla_kv_norm_g": gain((L, MLA_KV_RANK)),
        "mla_w_ukv": nrm((L, MLA_KV_RANK, MLA_HEADS * (MLA_NOPE_DIM + MLA_V_DIM)), MLA_KV_RANK ** -0.5),
        "nsa_gate_b": nrm((L, N_BRANCH * NSA_HEADS), 0.02),
        "nsa_cmp_pe_k": nrm((L, CMP_BLOCK, hd), 0.1),
        "nsa_cmp_w1_k": nrm((L, CMP_BLOCK * hd, CMP_HIDDEN), (CMP_BLOCK * hd) ** -0.5),
        "nsa_cmp_w2_k": nrm((L, CMP_HIDDEN, hd), CMP_HIDDEN ** -0.5),
        "nsa_cmp_pe_v": nrm((L, CMP_BLOCK, hd), 0.1),
        "nsa_cmp_w1_v": nrm((L, CMP_BLOCK * hd, CMP_HIDDEN), (CMP_BLOCK * hd) ** -0.5),
        "nsa_cmp_w2_v": nrm((L, CMP_HIDDEN, hd), CMP_HIDDEN ** -0.5),
        "w_out": nrm((L, MIX_WIDTH, D_MODEL), MIX_WIDTH ** -0.5 * DEEPNORM_BETA),
        "ln2_g": gain((L, D_MODEL)),
        "ln2_b": nrm((L, D_MODEL), 0.02),
        "ffn2_w_gate": nrm((L, D_MODEL, D_FF), D_MODEL ** -0.5),
        "ffn2_w_up": nrm((L, D_MODEL, D_FF), D_MODEL ** -0.5),
        "ffn2_w_down": nrm((L, D_FF, D_MODEL), D_FF ** -0.5 * DEEPNORM_BETA),
        "ln3_g": gain((L, D_MODEL)),
        "ln3_b": nrm((L, D_MODEL), 0.02),
    }


def reference(x, ffn1_w_gate, ffn1_w_up, ffn1_w_down, ln1_g, ln1_b, w_in,
              mla_q_norm_g, mla_w_uq, mla_kv_norm_g, mla_w_ukv, nsa_gate_b,
              nsa_cmp_pe_k, nsa_cmp_w1_k, nsa_cmp_w2_k, nsa_cmp_pe_v, nsa_cmp_w1_v, nsa_cmp_w2_v,
              w_out, ln2_g, ln2_b, ffn2_w_gate, ffn2_w_up, ffn2_w_down, ln3_g, ln3_b):
    pos = jnp.arange(x.shape[1])
    for l in range(DEPTH):
        x = layer_norm(DEEPNORM_ALPHA * x + FFN_RES_WEIGHT * swiglu(x, ffn1_w_gate[l], ffn1_w_up[l], ffn1_w_down[l]),
                       ln1_g[l], ln1_b[l])
        (c_q, c_kv, k_rope, q_nsa, k_c, v_c, k_s, v_s, k_w, v_w, g_nsa) = split_cols(x @ w_in[l], IN_SIZES)
        o_mla = mla_attention(c_q, c_kv, k_rope, mla_q_norm_g[l], mla_w_uq[l], mla_kv_norm_g[l], mla_w_ukv[l], pos)
        o_nsa = nsa_attention(q_nsa, k_c, v_c, k_s, v_s, k_w, v_w, g_nsa, nsa_gate_b[l],
                              nsa_cmp_pe_k[l], nsa_cmp_w1_k[l], nsa_cmp_w2_k[l],
                              nsa_cmp_pe_v[l], nsa_cmp_w1_v[l], nsa_cmp_w2_v[l], pos)
        mix = jnp.concatenate([o_mla, o_nsa], axis=-1) @ w_out[l]
        x = layer_norm(DEEPNORM_ALPHA * x + mix, ln2_g[l], ln2_b[l])
        x = layer_norm(DEEPNORM_ALPHA * x + FFN_RES_WEIGHT * swiglu(x, ffn2_w_gate[l], ffn2_w_up[l], ffn2_w_down[l]),
                       ln3_g[l], ln3_b[l])
    return x
```

```cpp
#include <hip/hip_runtime.h>
#include <hip/hip_cooperative_groups.h>
#include <cstdio>
#include <cstdint>
namespace cg = cooperative_groups;

#define LAS __attribute__((address_space(3)))
#define GAS __attribute__((address_space(1)))
typedef unsigned short bf16_t;
typedef short bf16x8 __attribute__((ext_vector_type(8)));
typedef short s16x4 __attribute__((ext_vector_type(4)));
typedef float f32x2 __attribute__((ext_vector_type(2)));
typedef float f32x4 __attribute__((ext_vector_type(4)));
typedef float f32x16 __attribute__((ext_vector_type(16)));
typedef unsigned u32x4 __attribute__((ext_vector_type(4)));
typedef unsigned u32x2 __attribute__((ext_vector_type(2)));
typedef __bf16 bf16x2_t __attribute__((ext_vector_type(2)));

constexpr int M = 16384, DM = 2048, DFF = 5632;
constexpr float ALPHA = 1.189207115002721f;
constexpr float LN_EPS = 1e-5f, RMS_EPS = 1e-6f;
constexpr float C2M = 0.10411754627697264f;
constexpr float C2N = 0.12751743082459868f;
constexpr int NTHREADS = 512, NWAVES = 8;
constexpr int LDS_BYTES = 147456;

constexpr size_t MiB = 1u << 20;
constexpr size_t WS_WGU = 0, WS_WD = 44 * MiB, WS_WIN = 66 * MiB, WS_WVN = 78 * MiB, WS_WUQ = 80 * MiB, WS_WKN = 82 * MiB,
                 WS_WVM = 83 * MiB, WS_W1K = 84 * MiB, WS_W1V = 86 * MiB, WS_WOUT = 88 * MiB, WS_TAB128 = 96 * MiB, WS_TAB64 = 104 * MiB,
                 WS_SSQ = 108 * MiB, WS_MISC = 110 * MiB, WS_HCP = 111 * MiB, WS_KC = 127 * MiB, WS_XB = 128 * MiB, WS_R = 192 * MiB;
constexpr size_t WS_H = WS_R;
constexpr size_t WS_CQ = 192 * MiB, WS_CKV = 208 * MiB, WS_KR = 216 * MiB, WS_GL = 218 * MiB, WS_QN = 220 * MiB, WS_KCR = 252 * MiB,
                 WS_VCR = 260 * MiB, WS_KS = 268 * MiB, WS_KW = 276 * MiB, WS_VTN = 284 * MiB, WS_QM = 300 * MiB, WS_KN = 348 * MiB,
                 WS_VT = 380 * MiB, WS_OACC = 412 * MiB, WS_END = 460 * MiB;

__device__ __forceinline__ unsigned pk2(float lo, float hi) { f32x2 v = {lo, hi}; bf16x2_t b = __builtin_convertvector(v, bf16x2_t); return __builtin_bit_cast(unsigned, b); }
__device__ __forceinline__ float bf2f(unsigned short h) { return __uint_as_float(((unsigned)h) << 16); }
__device__ __forceinline__ int get_tid0() { return (int)threadIdx.x; }
__device__ __forceinline__ float wave_sum(float v) {
#pragma unroll
    for (int o = 1; o < 64; o <<= 1) v += __shfl_xor(v, o);
    return v;
}

namespace pg8 {
constexpr int BM = 256, BK = 64, HALF = 128, HTB = HALF * BK * 2, STAGE_BYTES = 8 * HTB, NXCD = 8, WGM = 8;
__host__ __device__ __forceinline__ int lds_byte(int r, int c) { const int st = (r >> 4) * 2 + (c >> 5), rr = r & 15, cc = c & 31, ob = rr * 64 + cc * 2; return st * 1024 + (ob ^ (((ob >> 9) & 1) << 5)); }
__host__ __device__ __forceinline__ void stage_rc(int b, int& R, int& C) { const int st = b / 1024, sb = b % 1024, swz = sb ^ (((sb >> 9) & 1) << 5); R = (st >> 1) * 16 + swz / 64; C = (st & 1) * 32 + (swz % 64) / 2; }
__host__ __device__ __forceinline__ int perm32(int rho) { const int n = rho >> 4, i = rho & 15; return 8 * (i >> 2) + 4 * n + (i & 3); }

struct Unit { int pm, pn; };
struct Gemm { const bf16_t* A; const bf16_t* Bt; int lda, ldb, K; };

struct StaticOrder {
    int nM, nN, nwg, G, c;
    __device__ __forceinline__ void init(int nM_, int nN_, int G_, int c_) { nM = nM_; nN = nN_; nwg = nM * nN; G = G_; c = c_; }
    __device__ __forceinline__ bool next(int i, Unit& u) const {
        const long L = (long)i * G + c; if (L >= nwg) return false;
        int wgid = (int)L; { const int q = nwg / NXCD, r = nwg % NXCD, xcd = wgid % NXCD, off = wgid / NXCD; wgid = (xcd < r ? xcd * (q + 1) : r * (q + 1) + (xcd - r) * q) + off; }
        const int nig = WGM * nN, gid = wgid / nig, fm = gid * WGM, gsz = (nM - fm) < WGM ? (nM - fm) : WGM;
        u.pm = fm + ((wgid % nig) % gsz); u.pn = (wgid % nig) / gsz; return true;
    }
};

template <class Epi>
__device__ __forceinline__ void gemm_phase(LAS unsigned char* lds, const Gemm g, const StaticOrder& S, const Epi& E) {
    int tid = threadIdx.x; asm volatile("" : "+v"(tid)); const int wid = __builtin_amdgcn_readfirstlane(tid >> 6), lane = tid & 63, wr = wid >> 2, wc = wid & 3, fr = lane & 15, fq = lane >> 4;
    const int K = g.K, nt = K / BK;
    unsigned voffA[2], voffB[2];
#pragma unroll
    for (int i = 0; i < 2; ++i) { int R, C; stage_rc(tid * 16 + i * 8192, R, C); const int Rb = Epi::PERM ? ((R & ~31) + perm32(R & 31)) : R;
        voffA[i] = (unsigned)(R * g.lda + C) * 2u; voffB[i] = (unsigned)(Rb * g.ldb + C) * 2u; }
    const size_t kstep = (size_t)(BK * 2);
    const size_t hstepA = (size_t)HALF * g.lda * 2, hstepB = (size_t)HALF * g.ldb * 2;
    const size_t tstepA = 2 * hstepA, tstepB = 2 * hstepB;
    const unsigned ldsw = (unsigned)wid * 1024u;
    const int aoff = lds_byte(wr * 64 + fr, fq * 8), boff = lds_byte(wc * 32 + fr, fq * 8);
#define PG8_SA(b, h) (((b) * 2 + (h)) * HTB)
#define PG8_SB(b, h) ((4 + (b) * 2 + (h)) * HTB)
#define PG8_STAGE(bufoff, gbase, voff) do { _Pragma("unroll") for (int _i = 0; _i < 2; ++_i) \
        __builtin_amdgcn_global_load_lds((const unsigned*)((const char*)(gbase) + (voff)[_i]), (LAS unsigned*)(lds + (bufoff) + ldsw + _i * 8192), 16, 0, 0); } while (0)
#define PG8_LDA(dst, b, h) do { _Pragma("unroll") for (int m = 0; m < 4; ++m) _Pragma("unroll") for (int k = 0; k < 2; ++k) dst[m][k] = *(const LAS bf16x8*)(lds + PG8_SA(b, h) + aoff + m * 2048 + k * 1024); } while (0)
#define PG8_LDB(dst, b, h) do { _Pragma("unroll") for (int n = 0; n < 2; ++n) _Pragma("unroll") for (int k = 0; k < 2; ++k) dst[n][k] = *(const LAS bf16x8*)(lds + PG8_SB(b, h) + boff + n * 2048 + k * 1024); } while (0)
#define PG8_MMA(ai, bj, At, Bt) do { __builtin_amdgcn_s_setprio(1); _Pragma("unroll") for (int m = 0; m < 4; ++m) _Pragma("unroll") for (int n = 0; n < 2; ++n) _Pragma("unroll") for (int k = 0; k < 2; ++k) \
        acc[ai][bj][m][n] = __builtin_amdgcn_mfma_f32_16x16x32_bf16(Bt[n][k], At[m][k], acc[ai][bj][m][n], 0, 0, 0); __builtin_amdgcn_s_setprio(0); } while (0)
#define PG8_WAIT_V(n) asm volatile("s_waitcnt vmcnt(" #n ")" ::: "memory")
#define PG8_WAIT_L(n) asm volatile("s_waitcnt lgkmcnt(" #n ")" ::: "memory")
#define PG8_BAR __builtin_amdgcn_s_barrier()
#define PG8_SCHED __builtin_amdgcn_sched_barrier(0)
    Unit cur, nxt; int ui = 0;
    if (!S.next(0, cur)) return;
    f32x4 acc[2][2][4][2];
#pragma unroll
    for (int a = 0; a < 2; ++a)
#pragma unroll
        for (int b = 0; b < 2; ++b)
#pragma unroll
            for (int m = 0; m < 4; ++m)
#pragma unroll
                for (int n = 0; n < 2; ++n) acc[a][b][m][n] = (f32x4){0.f, 0.f, 0.f, 0.f};
    bf16x8 At[4][2], B0[2][2], B1[2][2];
    const char* cA = (const char*)g.A + (size_t)cur.pm * tstepA; const char* cB = (const char*)g.Bt + (size_t)cur.pn * tstepB;
    PG8_STAGE(PG8_SB(0, 0), cB, voffB); PG8_STAGE(PG8_SB(0, 1), cB + hstepB, voffB); PG8_STAGE(PG8_SA(0, 0), cA, voffA); PG8_STAGE(PG8_SA(0, 1), cA + hstepA, voffA);
    if (wr == 1) PG8_BAR;
    PG8_WAIT_V(2); PG8_BAR;
    PG8_STAGE(PG8_SB(1, 0), cB + kstep, voffB); PG8_STAGE(PG8_SA(1, 0), cA + kstep, voffA); PG8_STAGE(PG8_SB(1, 1), cB + hstepB + kstep, voffB);
    PG8_WAIT_V(6); PG8_BAR;
    for (;;) {
        const bool has_next = S.next(ui + 1, nxt);
        const char* nA = has_next ? (const char*)g.A + (size_t)nxt.pm * tstepA : cA; const char* nB = has_next ? (const char*)g.Bt + (size_t)nxt.pn * tstepB : cB;
        for (int t = 0; t < nt; t += 2) {
            const bool last = (t == nt - 2);
            const char* a1 = cA + (size_t)(t + 1) * kstep;
            const char* a2 = last ? nA : cA + (size_t)(t + 2) * kstep; const char* b2 = last ? nB : cB + (size_t)(t + 2) * kstep;
            const char* a3 = a2 + kstep; const char* b3 = b2 + kstep;
            PG8_LDB(B0, 0, 0); PG8_LDB(B1, 0, 1); PG8_SCHED; PG8_LDA(At, 0, 0); PG8_STAGE(PG8_SA(1, 1), a1 + hstepA, voffA);
            PG8_WAIT_V(8); PG8_WAIT_L(0); PG8_BAR; PG8_MMA(0, 0, At, B0); PG8_MMA(0, 1, At, B1); PG8_BAR; PG8_SCHED;
            PG8_LDA(At, 0, 1); PG8_STAGE(PG8_SB(0, 0), b2, voffB); PG8_STAGE(PG8_SB(0, 1), b2 + hstepB, voffB); PG8_STAGE(PG8_SA(0, 0), a2, voffA);
            PG8_WAIT_V(8); PG8_WAIT_L(0); PG8_BAR; PG8_MMA(1, 0, At, B0); PG8_MMA(1, 1, At, B1); PG8_BAR; PG8_SCHED;
            PG8_LDB(B0, 1, 0); PG8_LDB(B1, 1, 1); PG8_SCHED; PG8_LDA(At, 1, 0); PG8_STAGE(PG8_SA(0, 1), a2 + hstepA, voffA);
            PG8_WAIT_V(8); PG8_WAIT_L(0); PG8_BAR; PG8_MMA(0, 0, At, B0); PG8_MMA(0, 1, At, B1); PG8_BAR; PG8_SCHED;
            PG8_LDA(At, 1, 1); PG8_STAGE(PG8_SB(1, 0), b3, voffB); PG8_STAGE(PG8_SB(1, 1), b3 + hstepB, voffB); PG8_STAGE(PG8_SA(1, 0), a3, voffA);
            PG8_WAIT_V(8); PG8_WAIT_L(0); PG8_BAR; PG8_MMA(1, 0, At, B0); PG8_MMA(1, 1, At, B1); PG8_BAR; PG8_SCHED;
        }
        if (wr == 0) PG8_BAR;
        E(acc, cur, wr, wc, fr, fq);
        if (!has_next) break;
#pragma unroll
        for (int a = 0; a < 2; ++a)
#pragma unroll
            for (int b = 0; b < 2; ++b)
#pragma unroll
                for (int m = 0; m < 4; ++m)
#pragma unroll
                    for (int n = 0; n < 2; ++n) acc[a][b][m][n] = (f32x4){0.f, 0.f, 0.f, 0.f};
        cur = nxt; cA = nA; cB = nB; ++ui;
        if (wr == 1) PG8_BAR;
    }
    PG8_WAIT_V(0);
    PG8_BAR;
#undef PG8_SA
#undef PG8_SB
#undef PG8_STAGE
#undef PG8_LDA
#undef PG8_LDB
#undef PG8_MMA
#undef PG8_WAIT_V
#undef PG8_WAIT_L
#undef PG8_BAR
#undef PG8_SCHED
}
}

typedef f32x4 AccT[2][2][4][2];

struct EpiSwiglu {
    static constexpr bool PERM = true;
    bf16_t* H;
    __device__ __forceinline__ void operator()(const AccT& acc, const pg8::Unit& u, int wr, int wc, int fr, int fq) const {
        const int col = u.pn * 128 + wc * 32 + fq * 8;
#pragma unroll
        for (int ai = 0; ai < 2; ++ai)
#pragma unroll
            for (int m = 0; m < 4; ++m) {
                const int row = u.pm * 256 + ai * 128 + wr * 64 + m * 16 + fr;
                float o[8];
#pragma unroll
                for (int n = 0; n < 2; ++n)
#pragma unroll
                    for (int j = 0; j < 4; ++j) { const float gt = acc[ai][0][m][n][j], up = acc[ai][1][m][n][j];
                        const float sg = gt * __builtin_amdgcn_rcpf(1.f + __builtin_amdgcn_exp2f(-gt * 1.4426950408889634f)); o[n * 4 + j] = sg * up; }
                u32x4 w; w.x = pk2(o[0], o[1]); w.y = pk2(o[2], o[3]); w.z = pk2(o[4], o[5]); w.w = pk2(o[6], o[7]);
                *(u32x4*)(H + (size_t)row * DFF + col) = w;
            }
    }
};
struct EpiResid {
    static constexpr bool PERM = false;
    const float* res; float* out; float a, b;
    __device__ __forceinline__ void operator()(const AccT& acc, const pg8::Unit& u, int wr, int wc, int fr, int fq) const {
#pragma unroll
        for (int ai = 0; ai < 2; ++ai)
#pragma unroll
            for (int m = 0; m < 4; ++m) {
                const size_t rowoff = (size_t)(u.pm * 256 + ai * 128 + wr * 64 + m * 16 + fr) * DM + u.pn * 256 + wc * 32 + fq * 4;
#pragma unroll
                for (int bj = 0; bj < 2; ++bj)
#pragma unroll
                    for (int n = 0; n < 2; ++n) { const size_t off = rowoff + bj * 128 + n * 16; const f32x4 r = *(const f32x4*)(res + off);
                        *(f32x4*)(out + off) = r * a + acc[ai][bj][m][n] * b; }
            }
    }
};
template <bool RES_BF16, bool OUT_F32 = false>
struct EpiResidB {
    static constexpr bool PERM = true;
    const void* res; void* out; float a, b;
    __device__ __forceinline__ void operator()(const AccT& acc, const pg8::Unit& u, int wr, int wc, int fr, int fq) const {
#pragma unroll
        for (int ai = 0; ai < 2; ++ai)
#pragma unroll
            for (int m = 0; m < 4; ++m) {
                const size_t rowoff = (size_t)(u.pm * 256 + ai * 128 + wr * 64 + m * 16 + fr) * DM + u.pn * 256 + wc * 32 + fq * 8;
#pragma unroll
                for (int bj = 0; bj < 2; ++bj) { const size_t off = rowoff + bj * 128; float r[8];
                    if (RES_BF16) { const u32x4 w = *(const u32x4*)((const bf16_t*)res + off);
                        r[0] = __uint_as_float(w.x << 16); r[1] = __uint_as_float(w.x & 0xffff0000u); r[2] = __uint_as_float(w.y << 16); r[3] = __uint_as_float(w.y & 0xffff0000u);
                        r[4] = __uint_as_float(w.z << 16); r[5] = __uint_as_float(w.z & 0xffff0000u); r[6] = __uint_as_float(w.w << 16); r[7] = __uint_as_float(w.w & 0xffff0000u); }
                    else { const f32x4 x0 = *(const f32x4*)((const float*)res + off), x1 = *(const f32x4*)((const float*)res + off + 4);
                        r[0] = x0[0]; r[1] = x0[1]; r[2] = x0[2]; r[3] = x0[3]; r[4] = x1[0]; r[5] = x1[1]; r[6] = x1[2]; r[7] = x1[3]; }
                    const f32x4 v0 = acc[ai][bj][m][0], v1 = acc[ai][bj][m][1];
                    if (OUT_F32) { *(f32x4*)((float*)out + off) = (f32x4){r[0] * a + v0[0] * b, r[1] * a + v0[1] * b, r[2] * a + v0[2] * b, r[3] * a + v0[3] * b};
                        *(f32x4*)((float*)out + off + 4) = (f32x4){r[4] * a + v1[0] * b, r[5] * a + v1[1] * b, r[6] * a + v1[2] * b, r[7] * a + v1[3] * b}; }
                    else { u32x4 o; o.x = pk2(r[0] * a + v0[0] * b, r[1] * a + v0[1] * b); o.y = pk2(r[2] * a + v0[2] * b, r[3] * a + v0[3] * b);
                        o.z = pk2(r[4] * a + v1[0] * b, r[5] * a + v1[1] * b); o.w = pk2(r[6] * a + v1[2] * b, r[7] * a + v1[3] * b);
                        *(u32x4*)((bf16_t*)out + off) = o; } }
            }
    }
};
struct EpiF32 {
    static constexpr bool PERM = false;
    float* out; int ld;
    __device__ __forceinline__ void operator()(const AccT& acc, const pg8::Unit& u, int wr, int wc, int fr, int fq) const {
#pragma unroll
        for (int ai = 0; ai < 2; ++ai)
#pragma unroll
            for (int m = 0; m < 4; ++m) {
                const size_t rowoff = (size_t)(u.pm * 256 + ai * 128 + wr * 64 + m * 16 + fr) * ld + u.pn * 256 + wc * 32 + fq * 4;
#pragma unroll
                for (int bj = 0; bj < 2; ++bj)
#pragma unroll
                    for (int n = 0; n < 2; ++n) *(f32x4*)(out + rowoff + bj * 128 + n * 16) = acc[ai][bj][m][n];
            }
    }
};
__device__ __forceinline__ void rope4(const f32x4 x1, const f32x4 x2, const f32x4 t01, const f32x4 t23, float sc, u32x2& lo, u32x2& hi) {
    const float c0 = t01[0], s0 = t01[1], c1 = t01[2], s1 = t01[3], c2 = t23[0], s2 = t23[1], c3 = t23[2], s3 = t23[3];
    const float l0 = (x1[0] * c0 - x2[0] * s0) * sc, l1 = (x1[1] * c1 - x2[1] * s1) * sc, l2 = (x1[2] * c2 - x2[2] * s2) * sc, l3 = (x1[3] * c3 - x2[3] * s3) * sc;
    const float h0 = (x2[0] * c0 + x1[0] * s0) * sc, h1 = (x2[1] * c1 + x1[1] * s1) * sc, h2 = (x2[2] * c2 + x1[2] * s2) * sc, h3 = (x2[3] * c3 + x1[3] * s3) * sc;
    lo.x = pk2(l0, l1); lo.y = pk2(l2, l3); hi.x = pk2(h0, h1); hi.y = pk2(h2, h3);
}
struct EpiWin {
    static constexpr bool PERM = true;
    bf16_t *CQ, *CKV, *KR, *GL, *QN, *KCR, *VCR, *KS, *KW; float* SSQ; const float* tab128; const float* tab64;
    __device__ __forceinline__ void operator()(const AccT& acc, const pg8::Unit& u, int wr, int wc, int fr, int fq) const {
        const int c8 = wc * 32 + fq * 8;
#pragma unroll
        for (int bj = 0; bj < 2; ++bj) {
            const int blk = 2 * u.pn + bj;
            if (blk == 23) continue;
#pragma unroll
            for (int ai = 0; ai < 2; ++ai)
#pragma unroll
                for (int m = 0; m < 4; ++m) {
                    const int row = u.pm * 256 + ai * 128 + wr * 64 + m * 16 + fr;
                    const f32x4 v0 = acc[ai][bj][m][0], v1 = acc[ai][bj][m][1];
                    u32x4 raw; raw.x = pk2(v0[0], v0[1]); raw.y = pk2(v0[2], v0[3]); raw.z = pk2(v1[0], v1[1]); raw.w = pk2(v1[2], v1[3]);
                    if (blk < 6) {
                        bf16_t* dst = (blk < 4) ? CQ + (size_t)row * 512 + blk * 128 + c8 : CKV + (size_t)row * 256 + (blk - 4) * 128 + c8;
                        *(u32x4*)dst = raw;
                        float s = (v0[0] * v0[0] + v0[1] * v0[1]) + (v0[2] * v0[2] + v0[3] * v0[3]) + (v1[0] * v1[0] + v1[1] * v1[1]) + (v1[2] * v1[2] + v1[3] * v1[3]);
                        s += __shfl_xor(s, 16); s += __shfl_xor(s, 32);
                        if (fq == 0) SSQ[(size_t)row * 24 + blk * 4 + wc] = s;
                    } else if (blk == 6) {
                        if (wc < 2) { const int i = wc * 4 + fq; const f32x4* tp = (const f32x4*)(tab64 + ((size_t)row * 32 + 4 * i) * 2);
                            u32x2 lo, hi; rope4(v0, v1, tp[0], tp[1], 1.f, lo, hi);
                            *(u32x2*)(KR + (size_t)row * 64 + 4 * i) = lo; *(u32x2*)(KR + (size_t)row * 64 + 32 + 4 * i) = hi; }
                        else if (wc == 2) { *(u32x4*)(GL + (size_t)row * 32 + fq * 8) = raw; }
                    } else if (blk == 17 || blk == 18) {
                        *(u32x4*)(VCR + ((size_t)(blk - 17) * M + row) * 128 + c8) = raw;
                    } else {
                        const int i = wc * 4 + fq; const f32x4* tp = (const f32x4*)(tab128 + ((size_t)row * 64 + 4 * i) * 2);
                        bf16_t* base; float sc = 1.f;
                        if (blk <= 14) { base = QN + ((size_t)(blk - 7) * M + row) * 128; sc = C2N; }
                        else if (blk <= 16) base = KCR + ((size_t)(blk - 15) * M + row) * 128;
                        else if (blk <= 20) base = KS + ((size_t)(blk - 19) * M + row) * 128;
                        else base = KW + ((size_t)(blk - 21) * M + row) * 128;
                        u32x2 lo, hi; rope4(v0, v1, tp[0], tp[1], sc, lo, hi);
                        *(u32x2*)(base + 4 * i) = lo; *(u32x2*)(base + 64 + 4 * i) = hi;
                    }
                }
        }
    }
};
__device__ __forceinline__ float ssq_sum16(const float* p) { const f32x4 a = *(const f32x4*)p, b = *(const f32x4*)(p + 4), c = *(const f32x4*)(p + 8), d = *(const f32x4*)(p + 12);
    return ((a[0] + a[1]) + (a[2] + a[3])) + ((b[0] + b[1]) + (b[2] + b[3])) + ((c[0] + c[1]) + (c[2] + c[3])) + ((d[0] + d[1]) + (d[2] + d[3])); }
__device__ __forceinline__ float ssq_sum8(const float* p) { const f32x4 a = *(const f32x4*)p, b = *(const f32x4*)(p + 4);
    return ((a[0] + a[1]) + (a[2] + a[3])) + ((b[0] + b[1]) + (b[2] + b[3])); }
struct EpiQup {
    static constexpr bool PERM = true;
    bf16_t* QM; const float* SSQ; const float* tab64;
    __device__ __forceinline__ void operator()(const AccT& acc, const pg8::Unit& u, int wr, int wc, int fr, int fq) const {
        const int c8 = wc * 32 + fq * 8;
#pragma unroll
        for (int ai = 0; ai < 2; ++ai)
#pragma unroll
            for (int m = 0; m < 4; ++m) {
                const int row = u.pm * 256 + ai * 128 + wr * 64 + m * 16 + fr;
                const float rs = C2M / sqrtf(ssq_sum16(SSQ + (size_t)row * 24) * (1.f / 512.f) + RMS_EPS);
#pragma unroll
                for (int bj = 0; bj < 2; ++bj) {
                    const int blk = 2 * u.pn + bj;
                    const f32x4 v0 = acc[ai][bj][m][0] * rs, v1 = acc[ai][bj][m][1] * rs;
                    if (blk < 8) { u32x4 raw; raw.x = pk2(v0[0], v0[1]); raw.y = pk2(v0[2], v0[3]); raw.z = pk2(v1[0], v1[1]); raw.w = pk2(v1[2], v1[3]);
                        *(u32x4*)(QM + ((size_t)blk * M + row) * 192 + c8) = raw; }
                    else { const int head = 2 * (blk - 8) + (wc >> 1), i = (wc & 1) * 4 + fq; const f32x4* tp = (const f32x4*)(tab64 + ((size_t)row * 32 + 4 * i) * 2);
                        u32x2 lo, hi; rope4(v0, v1, tp[0], tp[1], 1.f, lo, hi);
                        bf16_t* base = QM + ((size_t)head * M + row) * 192 + 128;
                        *(u32x2*)(base + 4 * i) = lo; *(u32x2*)(base + 32 + 4 * i) = hi; }
                }
            }
    }
};
struct EpiKn {
    static constexpr bool PERM = true;
    bf16_t* KN; const float* SSQ;
    __device__ __forceinline__ void operator()(const AccT& acc, const pg8::Unit& u, int wr, int wc, int fr, int fq) const {
        const int c8 = wc * 32 + fq * 8;
#pragma unroll
        for (int ai = 0; ai < 2; ++ai)
#pragma unroll
            for (int m = 0; m < 4; ++m) {
                const int row = u.pm * 256 + ai * 128 + wr * 64 + m * 16 + fr;
                const float rs = 1.f / sqrtf(ssq_sum8(SSQ + (size_t)row * 24 + 16) * (1.f / 256.f) + RMS_EPS);
#pragma unroll
                for (int bj = 0; bj < 2; ++bj) {
                    const int blk = 2 * u.pn + bj;
                    const f32x4 v0 = acc[ai][bj][m][0] * rs, v1 = acc[ai][bj][m][1] * rs;
                    u32x4 raw; raw.x = pk2(v0[0], v0[1]); raw.y = pk2(v0[2], v0[3]); raw.z = pk2(v1[0], v1[1]); raw.w = pk2(v1[2], v1[3]);
                    *(u32x4*)(KN + ((size_t)blk * M + row) * 128 + c8) = raw;
                }
            }
    }
};
struct EpiColBf16 {
    static constexpr bool PERM = true;
    bf16_t* out; int ld; const float* SSQ;
    __device__ __forceinline__ void operator()(const AccT& acc, const pg8::Unit& u, int wr, int wc, int fr, int fq) const {
#pragma unroll
        for (int bj = 0; bj < 2; ++bj) {
            const int col = u.pn * 256 + bj * 128 + wc * 32 + fq * 8;
            float cs[8];
#pragma unroll
            for (int j = 0; j < 8; ++j) cs[j] = SSQ ? 1.f / sqrtf(ssq_sum8(SSQ + (size_t)(col + j) * 24 + 16) * (1.f / 256.f) + RMS_EPS) : 1.f;
#pragma unroll
            for (int ai = 0; ai < 2; ++ai)
#pragma unroll
                for (int m = 0; m < 4; ++m) {
                    const int row = u.pm * 256 + ai * 128 + wr * 64 + m * 16 + fr;
                    const f32x4 v0 = acc[ai][bj][m][0], v1 = acc[ai][bj][m][1];
                    u32x2 ra, rb; ra.x = pk2(v0[0] * cs[0], v0[1] * cs[1]); ra.y = pk2(v0[2] * cs[2], v0[3] * cs[3]); rb.x = pk2(v1[0] * cs[4], v1[1] * cs[5]); rb.y = pk2(v1[2] * cs[6], v1[3] * cs[7]);
                    bf16_t* gp = out + (size_t)row * ld + (col & ~15);
                    *(u32x2*)(gp + ((col & 8) ? 4 : 0)) = ra; *(u32x2*)(gp + ((col & 8) ? 12 : 8)) = rb;
                }
        }
    }
};

__device__ __forceinline__ int perm128_d(int p) { const int i = p >> 3, j = p & 7; return (j < 4) ? 4 * i + j : 64 + 4 * i + (j - 4); }
__device__ __forceinline__ int perm64_d(int p) { const int i = p >> 3, j = p & 7; return (j < 4) ? 4 * i + j : 32 + 4 * i + (j - 4); }
enum { MAP_PLAIN = 0, MAP_GU = 1, MAP_WIN = 2, MAP_WVN = 3, MAP_UQ = 4, MAP_UKV0 = 5, MAP_UKV1 = 6 };
template <int MODE> __device__ __forceinline__ int map_col(int n, int& which) {
    which = 0;
    if (MODE == MAP_PLAIN) return n;
    if (MODE == MAP_GU) { const int pn = n >> 8, r = n & 255; which = (r < 128) ? 0 : 1; return 128 * pn + (r & 127); }
    if (MODE == MAP_WIN) { const int blk = n >> 7, p = n & 127; int col = -1;
        if (blk < 4) col = 128 * blk + p;
        else if (blk < 6) col = 512 + 128 * (blk - 4) + p;
        else if (blk == 6) { if (p < 64) col = 768 + perm64_d(p); else if (p < 88) col = 3392 + (p - 64); }
        else if (blk <= 14) col = 832 + 128 * (blk - 7) + perm128_d(p);
        else if (blk <= 16) col = 1856 + 128 * (blk - 15) + perm128_d(p);
        else if (blk <= 18) col = 2112 + 128 * (blk - 17) + p;
        else if (blk <= 20) col = 2368 + 128 * (blk - 19) + perm128_d(p);
        else if (blk <= 22) col = 2880 + 128 * (blk - 21) + perm128_d(p);
        return col; }
    if (MODE == MAP_WVN) { const int blk = n >> 7, p = n & 127; return (blk < 2) ? 2624 + 128 * blk + p : 3136 + 128 * (blk - 2) + p; }
    if (MODE == MAP_UQ) { const int blk = n >> 7, p = n & 127; if (blk < 8) return 192 * blk + p; const int head = 2 * (blk - 8) + (p >> 6); return 192 * head + 128 + perm64_d(p & 63); }
    if (MODE == MAP_UKV0) return 256 * (n >> 7) + (n & 127);
    return 256 * (n >> 7) + 128 + (n & 127);
}
template <int MODE>
__device__ __forceinline__ void transpose_job(const float* src0, const float* src1, int ld, const float* ks, int K, int NR, bf16_t* WT, LAS float* scr, int gw, int NGW, int lane) {
    const int nblk = NR / 32, items = (K / 64) * nblk;
    for (int it = gw; it < items; it += NGW) {
        const int kb = it / nblk, nb = it % nblk, k0 = 64 * kb, n0 = 32 * nb;
        int which; const int col = map_col<MODE>(n0 + (lane & 31), which);
        const float* sp = (which ? src1 : src0) + (col >= 0 ? col : 0);
#pragma unroll 8
        for (int i = 0; i < 32; ++i) { const int kk = 2 * i + (lane >> 5);
            float v = sp[(size_t)(k0 + kk) * ld]; if (ks) v *= ks[k0 + kk]; if (col < 0) v = 0.f;
            scr[kk * 33 + (lane & 31)] = v; }
        asm volatile("s_waitcnt lgkmcnt(0)" ::: "memory");
        const int c = lane & 7;
#pragma unroll
        for (int j = 0; j < 4; ++j) { const int n = (lane >> 3) + 8 * j; const LAS float* s = scr + (8 * c) * 33 + n;
            u32x4 o; o.x = pk2(s[0 * 33], s[1 * 33]); o.y = pk2(s[2 * 33], s[3 * 33]); o.z = pk2(s[4 * 33], s[5 * 33]); o.w = pk2(s[6 * 33], s[7 * 33]);
            *(u32x4*)(WT + (size_t)(n0 + n) * K + k0 + 8 * c) = o; }
        asm volatile("s_waitcnt lgkmcnt(0)" ::: "memory");
    }
}

__device__ __forceinline__ void ln_row(const float* xin, float* xout, bf16_t* xb, const f32x4 (&gq)[8], const f32x4 (&bq)[8], int lane) {
    const f32x4* xr = (const f32x4*)xin + lane;
    f32x4 v[8]; float s = 0.f;
#pragma unroll
    for (int j = 0; j < 8; ++j) { v[j] = xr[64 * j]; s += (v[j][0] + v[j][1]) + (v[j][2] + v[j][3]); }
    const float mean = wave_sum(s) * (1.f / DM); float s2 = 0.f;
#pragma unroll
    for (int j = 0; j < 8; ++j) { v[j] = v[j] - mean; s2 += (v[j][0] * v[j][0] + v[j][1] * v[j][1]) + (v[j][2] * v[j][2] + v[j][3] * v[j][3]); }
    const float rstd = 1.f / sqrtf(wave_sum(s2) * (1.f / DM) + LN_EPS);
#pragma unroll
    for (int j = 0; j < 8; ++j) { const f32x4 gg = gq[j], bb = bq[j];
        const f32x4 y = v[j] * rstd * gg + bb;
        ((f32x4*)xout)[64 * j + lane] = y;
        if (xb) { u32x2 w; w.x = pk2(y[0], y[1]); w.y = pk2(y[2], y[3]); ((u32x2*)xb)[64 * j + lane] = w; } }
}

__device__ __forceinline__ void ln_load_gb(f32x4 (&gq)[8], f32x4 (&bq)[8], const float* g, const float* b, int lane) {
#pragma unroll
    for (int j = 0; j < 4; ++j) { const int e0 = 8 * lane + 512 * j; gq[2 * j] = *(const f32x4*)(g + e0); gq[2 * j + 1] = *(const f32x4*)(g + e0 + 4); bq[2 * j] = *(const f32x4*)(b + e0); bq[2 * j + 1] = *(const f32x4*)(b + e0 + 4); }
}
template <bool OUT_F32>
__device__ __forceinline__ void ln_row_b(const u32x4 (&xw)[4], void* xout, const f32x4 (&gq)[8], const f32x4 (&bq)[8], int lane) {
    float v[32]; float s = 0.f;
#pragma unroll
    for (int j = 0; j < 4; ++j) { const u32x4 w = xw[j];
        v[8 * j + 0] = __uint_as_float(w.x << 16); v[8 * j + 1] = __uint_as_float(w.x & 0xffff0000u); v[8 * j + 2] = __uint_as_float(w.y << 16); v[8 * j + 3] = __uint_as_float(w.y & 0xffff0000u);
        v[8 * j + 4] = __uint_as_float(w.z << 16); v[8 * j + 5] = __uint_as_float(w.z & 0xffff0000u); v[8 * j + 6] = __uint_as_float(w.w << 16); v[8 * j + 7] = __uint_as_float(w.w & 0xffff0000u); }
#pragma unroll
    for (int i = 0; i < 32; ++i) s += v[i];
    const float mean = wave_sum(s) * (1.f / DM); float s2 = 0.f;
#pragma unroll
    for (int i = 0; i < 32; ++i) { v[i] -= mean; s2 += v[i] * v[i]; }
    const float rstd = 1.f / sqrtf(wave_sum(s2) * (1.f / DM) + LN_EPS);
#pragma unroll
    for (int j = 0; j < 4; ++j) { const int e0 = 8 * lane + 512 * j;
        const f32x4 g0 = gq[2 * j], g1 = gq[2 * j + 1], b0 = bq[2 * j], b1 = bq[2 * j + 1];
        float y[8];
#pragma unroll
        for (int k = 0; k < 4; ++k) { y[k] = v[8 * j + k] * rstd * g0[k] + b0[k]; y[4 + k] = v[8 * j + 4 + k] * rstd * g1[k] + b1[k]; }
        if (OUT_F32) { *(f32x4*)((float*)xout + e0) = (f32x4){y[0], y[1], y[2], y[3]}; *(f32x4*)((float*)xout + e0 + 4) = (f32x4){y[4], y[5], y[6], y[7]}; }
        else { u32x4 w; w.x = pk2(y[0], y[1]); w.y = pk2(y[2], y[3]); w.z = pk2(y[4], y[5]); w.w = pk2(y[6], y[7]); *(u32x4*)((bf16_t*)xout + e0) = w; } }
}
__device__ __forceinline__ int crow(int r, int hi) { return (r & 3) + 8 * (r >> 2) + 4 * hi; }
constexpr int VRS = 144;

struct TileSrc { const GAS bf16_t* K; const GAS bf16_t* KX; const GAS bf16_t* VT; int ldv; };

template <int KRS, bool HAS_X>
struct TileRegs { u32x4 k0, k1, kx, v0, v1; };

template <int KRS, bool HAS_X>
__device__ __forceinline__ void tile_load(TileRegs<KRS, HAS_X>& R, const TileSrc& s, int t, int tid) {
    const GAS bf16_t* kp = s.K + (size_t)t * 64 * 128 + tid * 8;
    R.k0 = *(const GAS u32x4*)kp; R.k1 = *(const GAS u32x4*)(kp + 4096);
    if (HAS_X) R.kx = *(const GAS u32x4*)(s.KX + (size_t)t * 64 * 64 + tid * 8);
    const int d = tid >> 3, ch = tid & 7;
    const GAS bf16_t* vp = s.VT + (size_t)d * s.ldv + t * 64 + ch * 8;
    R.v0 = *(const GAS u32x4*)vp; R.v1 = *(const GAS u32x4*)(vp + (size_t)64 * s.ldv);
}
template <int KRS, bool HAS_X>
__device__ __forceinline__ void tile_store(const TileRegs<KRS, HAS_X>& R, LAS unsigned char* buf, int tid) {
    { const int row = tid >> 4, col = tid & 15; *(LAS u32x4*)(buf + row * KRS + col * 16) = R.k0; *(LAS u32x4*)(buf + (row + 32) * KRS + col * 16) = R.k1; }
    if (HAS_X) { const int row = tid >> 3, col = tid & 7; *(LAS u32x4*)(buf + row * KRS + 256 + col * 16) = R.kx; }
    { const int d = tid >> 3, ch = tid & 7; LAS unsigned char* vb = buf + 64 * KRS + d * VRS + ch * 16;
      *(LAS u32x4*)(vb) = R.v0; *(LAS u32x4*)(vb + 64 * VRS) = R.v1; }
}
template <int KRS, bool HAS_X, bool MIDSTORE, class Body>
__device__ __forceinline__ void flash_loop(LAS unsigned char* lds, const TileSrc& src, int tb, int te, int tid, Body&& body) {
    constexpr int BUFB = 64 * KRS + 128 * VRS;
    if (tb >= te) return;
    TileRegs<KRS, HAS_X> R;
    tile_load<KRS, HAS_X>(R, src, tb, tid); tile_store<KRS, HAS_X>(R, lds, tid);
    if (tb + 1 < te) tile_load<KRS, HAS_X>(R, src, tb + 1, tid);
    __syncthreads();
    for (int t = tb; t < te; ++t) {
        const int cur = (t - tb) & 1;
        if (t + 1 < te) tile_store<KRS, HAS_X>(R, lds + (cur ^ 1) * BUFB, tid);
        if (t + 2 < te) tile_load<KRS, HAS_X>(R, src, t + 2, tid);
        body(t, (const LAS unsigned char*)(lds + cur * BUFB), []() __attribute__((always_inline)) {});
        __syncthreads();
    }
}
template <int NKS, int KRS>
__device__ __forceinline__ void qk_tile(f32x16& p0, f32x16& p1, const LAS unsigned char* Kt, const bf16x8 (&qf)[NKS], int r32, int hi) {
    const LAS unsigned char* kb = Kt + r32 * KRS + hi * 16;
#pragma unroll
    for (int r = 0; r < 16; ++r) { p0[r] = 0.f; p1[r] = 0.f; }
    bf16x8 a0[3], a1[3];
    a0[0] = *(const LAS bf16x8*)(kb); a1[0] = *(const LAS bf16x8*)(kb + 32 * KRS);
    a0[1] = *(const LAS bf16x8*)(kb + 32); a1[1] = *(const LAS bf16x8*)(kb + 32 * KRS + 32);
    __builtin_amdgcn_sched_barrier(0);
#pragma unroll
    for (int ks = 0; ks < NKS; ++ks) {
        if (ks + 2 < NKS) { a0[(ks + 2) % 3] = *(const LAS bf16x8*)(kb + (ks + 2) * 32); a1[(ks + 2) % 3] = *(const LAS bf16x8*)(kb + 32 * KRS + (ks + 2) * 32); }
        p0 = __builtin_amdgcn_mfma_f32_32x32x16_bf16(a0[ks % 3], qf[ks], p0, 0, 0, 0);
        p1 = __builtin_amdgcn_mfma_f32_32x32x16_bf16(a1[ks % 3], qf[ks], p1, 0, 0, 0);
        __builtin_amdgcn_sched_barrier(0);
    }
}
__device__ __forceinline__ void pv_tile(f32x16 (&o)[4], const f32x16& p0, const f32x16& p1, const LAS unsigned char* Vt, int r32, int hi) {
    bf16x8 pa[4];
#pragma unroll
    for (int s = 0; s < 4; ++s) { const int b = 8 * (s & 1); u32x4 w;
        if (s < 2) { w.x = pk2(p0[b], p0[b + 1]); w.y = pk2(p0[b + 2], p0[b + 3]); w.z = pk2(p0[b + 4], p0[b + 5]); w.w = pk2(p0[b + 6], p0[b + 7]); }
        else { w.x = pk2(p1[b], p1[b + 1]); w.y = pk2(p1[b + 2], p1[b + 3]); w.z = pk2(p1[b + 4], p1[b + 5]); w.w = pk2(p1[b + 6], p1[b + 7]); }
        pa[s] = __builtin_bit_cast(bf16x8, w); }
    const LAS unsigned char* vb2 = Vt + r32 * VRS + hi * 16;
    bf16x8 vf[4];
#define PV_LD(i_) do { vf[(i_) & 3] = *(const LAS bf16x8*)(vb2 + ((i_) & 3) * 32 * VRS + ((i_) >> 2) * 32); } while (0)
    PV_LD(0); PV_LD(1); PV_LD(2);
    __builtin_amdgcn_sched_barrier(0);
#pragma unroll
    for (int i = 0; i < 16; ++i) {
        if (i + 3 < 16) PV_LD(i + 3);
        o[i & 3] = __builtin_amdgcn_mfma_f32_32x32x16_bf16(pa[i >> 2], vf[i & 3], o[i & 3], 0, 0, 0);
        __builtin_amdgcn_sched_barrier(0);
    }
#undef PV_LD
}
template <bool WITH_O>
__device__ __forceinline__ void softmax_step(float& m, float& l, f32x16 (&o)[4], f32x16& p0, f32x16& p1, LAS float* wsf, int r32, int hi) {
    float mx = fmaxf(p0[0], p1[0]);
#pragma unroll
    for (int r = 1; r < 16; ++r) mx = fmaxf(mx, fmaxf(p0[r], p1[r]));
    mx = fmaxf(mx, __shfl_xor(mx, 32));
    const bool grow = __any(mx > m + 8.f);
    const float mnew = grow ? fmaxf(m, mx) : m;
    const float f = grow ? __builtin_amdgcn_exp2f(m - mnew) : 1.f;
    m = mnew;
    float s = 0.f;
#pragma unroll
    for (int r = 0; r < 16; ++r) { p0[r] = __builtin_amdgcn_exp2f(p0[r] - mnew); p1[r] = __builtin_amdgcn_exp2f(p1[r] - mnew); s += p0[r] + p1[r]; }
    l = l * f + s;
    if (WITH_O) {
        if (grow) {
            if (hi == 0) wsf[r32] = f;
            asm volatile("s_waitcnt lgkmcnt(0)" ::: "memory");
#pragma unroll
            for (int r = 0; r < 16; ++r) { const float fr = wsf[crow(r, hi)];
#pragma unroll
                for (int db = 0; db < 4; ++db) o[db][r] *= fr; }
        }
    }
}
__device__ __forceinline__ void row_factors(float (&fr)[16], float fac, LAS float* wsf, int r32, int hi) {
    if (hi == 0) wsf[r32] = fac;
    asm volatile("s_waitcnt lgkmcnt(0)" ::: "memory");
#pragma unroll
    for (int r = 0; r < 16; ++r) fr[r] = wsf[crow(r, hi)];
    asm volatile("s_waitcnt lgkmcnt(0)" ::: "memory");
}

constexpr int KRS_MLA = 400, KRS_NSA = 272;
struct AttnPtrs { unsigned char* ws; const float* gate_b; };
#define OPQ_WS(name) GAS unsigned char* name = (GAS unsigned char*)P.ws; asm volatile("" : "+s"(name))
#define WSP(T, base, off) ((GAS T*)((base) + (off)))

__device__ __forceinline__ void mla_unit(int h, int qb, LAS unsigned char* lds, LAS float* wsf, const AttnPtrs& P) {
    int tid = threadIdx.x; asm volatile("" : "+v"(tid)); const int lane = tid & 63, w = __builtin_amdgcn_readfirstlane(tid >> 6), r32 = lane & 31, hi = lane >> 5;
    const int qrow = qb * 256 + w * 32 + r32;
    bf16x8 qf[12];
    OPQ_WS(wsl);
    { const GAS bf16_t* qp = WSP(const bf16_t, wsl, WS_QM) + ((size_t)h * M + qrow) * 192 + 8 * hi;
#pragma unroll
      for (int ks = 0; ks < 12; ++ks) qf[ks] = *(const GAS bf16x8*)(qp + 16 * ks); }
    asm volatile("s_waitcnt vmcnt(0)" ::: "memory");
#pragma unroll
    for (int ks = 0; ks < 12; ++ks) asm volatile("" : "+v"(qf[ks]));
    float m = -1e30f, l = 0.f; f32x16 o[4];
#pragma unroll
    for (int db = 0; db < 4; ++db)
#pragma unroll
        for (int r = 0; r < 16; ++r) o[db][r] = 0.f;
    TileSrc src{WSP(const bf16_t, wsl, WS_KN) + (size_t)h * M * 128, WSP(const bf16_t, wsl, WS_KR), WSP(const bf16_t, wsl, WS_VT) + (size_t)h * 128 * M, M};
    const int qmin = qb * 256 + w * 32;
    flash_loop<KRS_MLA, true, true>(lds, src, 0, 4 * qb + 4, tid, [&](int t, const LAS unsigned char* buf, auto&& mid) __attribute__((always_inline)) {
        const bool act = 64 * t <= qmin + 31;
        f32x16 p0, p1;
        if (act) {
            qk_tile<12, KRS_MLA>(p0, p1, buf, qf, r32, hi);
            if (64 * t + 63 > qmin) {
#pragma unroll
                for (int r = 0; r < 16; ++r) { const int key = 64 * t + crow(r, hi); if (key > qrow) p0[r] = -INFINITY; if (key + 32 > qrow) p1[r] = -INFINITY; }
            }
            softmax_step<true>(m, l, o, p0, p1, wsf, r32, hi);
        }
        mid();
        if (act) pv_tile(o, p0, p1, buf + 64 * KRS_MLA, r32, hi);
    });
    const float lt = l + __shfl_xor(l, 32);
    float fr[16]; row_factors(fr, 1.f / fmaxf(lt, 1e-30f), wsf, r32, hi);
    OPQ_WS(wso);
#pragma unroll
    for (int r = 0; r < 16; ++r) { GAS bf16_t* op = WSP(bf16_t, wso, WS_XB) + (size_t)(qb * 256 + w * 32 + crow(r, hi)) * DM + h * 128 + r32;
#pragma unroll
        for (int db = 0; db < 4; ++db) op[32 * db] = (bf16_t)(pk2(o[db][r] * fr[r], 0.f) & 0xffffu); }
}

constexpr int IMP_OFF = 2 * (64 * KRS_NSA + 128 * VRS);
constexpr int IMP_RS = 257;
constexpr int SEL_OFF = IMP_OFF + 64 * IMP_RS * 4;
constexpr int UNI_OFF = SEL_OFF + 64 * 8 * 4;
constexpr int WSF_OFF = 143360;

__device__ __forceinline__ unsigned range_mask(int lo, int hi, int k) {
    const int a = lo > 32 * k ? lo : 32 * k, b = hi < 32 * k + 31 ? hi : 32 * k + 31;
    if (a > b) return 0u; const int n = b - a + 1; const unsigned mk = (n >= 32) ? 0xffffffffu : ((1u << n) - 1u); return mk << (a - 32 * k);
}
template <int MODE>
__device__ __forceinline__ void nsa_finish(const f32x16 (&o)[4], float fac, LAS float* wsf, unsigned char* wsb0, int t0, int w, int hk, int tid, int r32, int hi) {
    float fr[16]; row_factors(fr, fac, wsf, r32, hi);
    GAS unsigned char* wsb = (GAS unsigned char*)wsb0; asm volatile("" : "+s"(wsb));
    GAS f32x4* ap = (GAS f32x4*)(WSP(float, wsb, WS_OACC) + (size_t)blockIdx.x * 32768 + (size_t)tid * 64);
    GAS bf16_t* OMIX = WSP(bf16_t, wsb, WS_XB);
#pragma unroll
    for (int db = 0; db < 4; ++db) {
#pragma unroll
        for (int r4 = 0; r4 < 4; ++r4) {
            f32x4 v = {o[db][4 * r4] * fr[4 * r4], o[db][4 * r4 + 1] * fr[4 * r4 + 1], o[db][4 * r4 + 2] * fr[4 * r4 + 2], o[db][4 * r4 + 3] * fr[4 * r4 + 3]};
            if (MODE >= 1) v += ap[db * 4 + r4];
            if (MODE <= 1) ap[db * 4 + r4] = v;
            else {
#pragma unroll
                for (int k = 0; k < 4; ++k) { const int row = crow(4 * r4 + k, hi), tok = t0 + 8 * w + (row >> 2), head = 4 * hk + (row & 3);
                    OMIX[(size_t)tok * DM + 1024 + head * 128 + 32 * db + r32] = (bf16_t)(pk2(v[k], 0.f) & 0xffffu); }
            }
        }
        asm volatile("" ::: "memory");
    }
}
__device__ __forceinline__ float gate_val(const AttnPtrs& P, int tok, int br, int head) {
    OPQ_WS(wsg);
    const float x = bf2f(WSP(const bf16_t, wsg, WS_GL)[(size_t)tok * 32 + br * 8 + head]) + P.gate_b[br * 8 + head];
    return 1.f / (1.f + __builtin_amdgcn_exp2f(-x * 1.4426950408889634f));
}

__device__ __forceinline__ void nsa_unit(int hk, int T, LAS unsigned char* lds, LAS float* wsf, const AttnPtrs& P) {
    int tid = threadIdx.x; asm volatile("" : "+v"(tid)); const int lane = tid & 63, w = __builtin_amdgcn_readfirstlane(tid >> 6), r32 = lane & 31, hi = lane >> 5;
    const int t0 = 64 * T, qi = r32 >> 2, g = r32 & 3, tq = t0 + 8 * w + qi, head = 4 * hk + g;
    LAS float* imp = (LAS float*)(lds + IMP_OFF);
    LAS unsigned* sel = (LAS unsigned*)(lds + SEL_OFF);
    LAS unsigned* uni = (LAS unsigned*)(lds + UNI_OFF);
    bf16x8 qf[8];
    { OPQ_WS(wsq); const GAS bf16_t* qp = WSP(const bf16_t, wsq, WS_QN) + ((size_t)head * M + tq) * 128 + 8 * hi;
#pragma unroll
      for (int ks = 0; ks < 8; ++ks) qf[ks] = *(const GAS bf16x8*)(qp + 16 * ks); }
    asm volatile("s_waitcnt vmcnt(0)" ::: "memory");
#pragma unroll
    for (int ks = 0; ks < 8; ++ks) asm volatile("" : "+v"(qf[ks]));
    const float gate_c = gate_val(P, tq, 0, head), gate_s = gate_val(P, tq, 1, head), gate_w = gate_val(P, tq, 2, head);
    f32x16 o[4];
#define ZERO_O() do { _Pragma("unroll") for (int db = 0; db < 4; ++db) _Pragma("unroll") for (int r = 0; r < 16; ++r) o[db][r] = 0.f; } while (0)
    const int cmaxT = (t0 + 63 >= 31) ? ((t0 + 63 - 31) >> 4) : -1;
    const int NTc = cmaxT >= 0 ? (cmaxT >> 6) + 1 : 0;
    const int mycmax = (tq >= 31) ? ((tq - 31) >> 4) : -1;
    OPQ_WS(wsc);
    TileSrc csrc{WSP(const bf16_t, wsc, WS_KC) + (size_t)hk * 1024 * 128, nullptr, WSP(const bf16_t, wsc, WS_KC) + 2 * 1024 * 128 + (size_t)hk * 128 * 1024, 1024};
    float m = -1e30f, l = 0.f;
    flash_loop<KRS_NSA, false, false>(lds, csrc, 0, NTc, tid, [&](int t, const LAS unsigned char* buf, auto&& mid) __attribute__((always_inline)) {
        f32x16 p0, p1;
        qk_tile<8, KRS_NSA>(p0, p1, buf, qf, r32, hi);
#pragma unroll
        for (int r = 0; r < 16; ++r) { const int c = 64 * t + crow(r, hi); if (c > mycmax) p0[r] = -INFINITY; if (c + 32 > mycmax) p1[r] = -INFINITY; }
        softmax_step<false>(m, l, o, p0, p1, wsf, r32, hi);
    });
    const float invl = 1.f / fmaxf(l + __shfl_xor(l, 32), 1e-30f);
    for (int i = tid; i < 64 * IMP_RS; i += NTHREADS) imp[i] = 0.f;
    __syncthreads();
    ZERO_O();
    flash_loop<KRS_NSA, false, false>(lds, csrc, 0, NTc, tid, [&](int t, const LAS unsigned char* buf, auto&& mid) __attribute__((always_inline)) {
        f32x16 p0, p1;
        qk_tile<8, KRS_NSA>(p0, p1, buf, qf, r32, hi);
#pragma unroll
        for (int r = 0; r < 16; ++r) { const int c = 64 * t + crow(r, hi);
            p0[r] = (c > mycmax) ? 0.f : __builtin_amdgcn_exp2f(p0[r] - m) * invl;
            p1[r] = (c + 32 > mycmax) ? 0.f : __builtin_amdgcn_exp2f(p1[r] - m) * invl; }
        float A[8], B[8];
#pragma unroll
        for (int a = 0; a < 4; ++a) {
            A[a] = 2.f * (p0[4 * a] + p0[4 * a + 1] + p0[4 * a + 2]) + p0[4 * a + 3]; B[a] = p0[4 * a + 3];
            A[4 + a] = 2.f * (p1[4 * a] + p1[4 * a + 1] + p1[4 * a + 2]) + p1[4 * a + 3]; B[4 + a] = p1[4 * a + 3]; }
#pragma unroll
        for (int a = 0; a < 8; ++a) {
            A[a] += __int_as_float(__builtin_amdgcn_mov_dpp(__float_as_int(A[a]), 0xB1, 0xF, 0xF, true)); A[a] += __int_as_float(__builtin_amdgcn_mov_dpp(__float_as_int(A[a]), 0x4E, 0xF, 0xF, true));
            B[a] += __int_as_float(__builtin_amdgcn_mov_dpp(__float_as_int(B[a]), 0xB1, 0xF, 0xF, true)); B[a] += __int_as_float(__builtin_amdgcn_mov_dpp(__float_as_int(B[a]), 0x4E, 0xF, 0xF, true)); }
        LAS float* ir = imp + (8 * w + qi) * IMP_RS + 16 * t + hi;
        if (g == 0) {
#pragma unroll
            for (int a = 0; a < 8; ++a) ir[2 * (a & 3) + 8 * (a >> 2)] += A[a];
        }
        asm volatile("s_waitcnt lgkmcnt(0)" ::: "memory");
        if (g == 0) {
#pragma unroll
            for (int a = 0; a < 8; ++a) ir[2 * (a & 3) + 8 * (a >> 2) + 1] += B[a];
        }
        asm volatile("s_waitcnt lgkmcnt(0)" ::: "memory");
        pv_tile(o, p0, p1, buf + 64 * KRS_NSA, r32, hi);
    });
    nsa_finish<0>(o, gate_c, wsf, P.ws, t0, w, hk, tid, r32, hi);
    {
        const int nforced = (T == 0) ? 1 : (T == 1) ? 2 : 3, npick = 16 - nforced, ncand = T - 2 > 0 ? T - 2 : 0;
        unsigned uniword = 0u;
        for (int q = 0; q < 8; ++q) {
            unsigned myword = 0u;
            if (lane < 8) { myword = range_mask(0, 0, lane) | range_mask(T, T, lane); if (T >= 1) myword |= range_mask(T - 1, T - 1, lane); }
            if (ncand <= npick) { if (lane < 8 && ncand > 0) myword |= range_mask(1, T - 2, lane); }
            else {
                const LAS float* irow = imp + (8 * w + q) * IMP_RS;
                unsigned k0 = 0u, k1 = 0u, k2 = 0u, k3 = 0u;
                { int j = lane; if (j >= 1 && j <= T - 2) k0 = __float_as_uint(irow[j]) + 1u; j += 64; if (j <= T - 2) k1 = __float_as_uint(irow[j]) + 1u;
                  j += 64; if (j <= T - 2) k2 = __float_as_uint(irow[j]) + 1u; j += 64; if (j <= T - 2) k3 = __float_as_uint(irow[j]) + 1u; }
                unsigned prefix = 0u;
                for (int bit = 31; bit >= 0; --bit) {
                    const unsigned cand = prefix | (1u << bit);
                    const int cnt = __popcll(__ballot(k0 >= cand)) + __popcll(__ballot(k1 >= cand)) + __popcll(__ballot(k2 >= cand)) + __popcll(__ballot(k3 >= cand));
                    if (cnt >= npick) prefix = cand;
                }
                const unsigned long long g0 = __ballot(k0 > prefix), g1 = __ballot(k1 > prefix), g2 = __ballot(k2 > prefix), g3 = __ballot(k3 > prefix);
                const unsigned long long e0 = __ballot(k0 == prefix), e1 = __ballot(k1 == prefix), e2 = __ballot(k2 == prefix), e3 = __ballot(k3 == prefix);
                const int need = npick - (__popcll(g0) + __popcll(g1) + __popcll(g2) + __popcll(g3));
                const unsigned long long ltm = (lane == 0) ? 0ull : ((~0ull) >> (64 - lane));
                int base = 0;
                const bool c0 = ((e0 >> lane) & 1ull) && (base + __popcll(e0 & ltm) < need); base += __popcll(e0);
                const bool c1 = ((e1 >> lane) & 1ull) && (base + __popcll(e1 & ltm) < need); base += __popcll(e1);
                const bool c2 = ((e2 >> lane) & 1ull) && (base + __popcll(e2 & ltm) < need); base += __popcll(e2);
                const bool c3 = ((e3 >> lane) & 1ull) && (base + __popcll(e3 & ltm) < need);
                const unsigned long long s0 = g0 | __ballot(c0), s1 = g1 | __ballot(c1), s2 = g2 | __ballot(c2), s3 = g3 | __ballot(c3);
                const unsigned long long sm = (lane >> 1) == 0 ? s0 : (lane >> 1) == 1 ? s1 : (lane >> 1) == 2 ? s2 : s3;
                if (lane < 8) myword |= (lane & 1) ? (unsigned)(sm >> 32) : (unsigned)sm;
            }
            if (lane < 8) { sel[(8 * w + q) * 8 + lane] = myword; uniword |= myword; }
        }
        if (lane < 8) uni[w * 8 + lane] = uniword;
        asm volatile("s_waitcnt lgkmcnt(0)" ::: "memory");
    }
    {
        OPQ_WS(wss);
        TileSrc ssrc{WSP(const bf16_t, wss, WS_KS) + (size_t)hk * M * 128, nullptr, WSP(const bf16_t, wss, WS_VTN) + (size_t)(hk * 128) * M, M};
        m = -1e30f; l = 0.f; ZERO_O();
        flash_loop<KRS_NSA, false, true>(lds, ssrc, 0, T + 1, tid, [&](int j, const LAS unsigned char* buf, auto&& mid) __attribute__((always_inline)) {
            const unsigned uw = __builtin_amdgcn_readfirstlane(uni[w * 8 + (j >> 5)]);
            const bool act = ((uw >> (j & 31)) & 1u) != 0u;
            f32x16 p0, p1;
            if (act) {
                qk_tile<8, KRS_NSA>(p0, p1, buf, qf, r32, hi);
                const unsigned mw = sel[(8 * w + qi) * 8 + (j >> 5)];
                const bool mine = (mw >> (j & 31)) & 1u;
#pragma unroll
                for (int r = 0; r < 16; ++r) { const int key = 64 * j + crow(r, hi);
                    if (!mine || key > tq) p0[r] = -INFINITY; if (!mine || key + 32 > tq) p1[r] = -INFINITY; }
                softmax_step<true>(m, l, o, p0, p1, wsf, r32, hi);
            }
            mid();
            if (act) pv_tile(o, p0, p1, buf + 64 * KRS_NSA, r32, hi);
        });
        const float lt = l + __shfl_xor(l, 32);
        nsa_finish<1>(o, gate_s / fmaxf(lt, 1e-30f), wsf, P.ws, t0, w, hk, tid, r32, hi);
    }
    {
        OPQ_WS(wsw);
        TileSrc wsrc{WSP(const bf16_t, wsw, WS_KW) + (size_t)hk * M * 128, nullptr, WSP(const bf16_t, wsw, WS_VTN) + (size_t)(256 + hk * 128) * M, M};
        m = -1e30f; l = 0.f; ZERO_O();
        flash_loop<KRS_NSA, false, true>(lds, wsrc, T >= 8 ? T - 8 : 0, T + 1, tid, [&](int j, const LAS unsigned char* buf, auto&& mid) __attribute__((always_inline)) {
            f32x16 p0, p1;
            qk_tile<8, KRS_NSA>(p0, p1, buf, qf, r32, hi);
            if (j == T || j == T - 8) {
#pragma unroll
                for (int r = 0; r < 16; ++r) { const int key = 64 * j + crow(r, hi);
                    if (key > tq || key <= tq - 512) p0[r] = -INFINITY; if (key + 32 > tq || key + 32 <= tq - 512) p1[r] = -INFINITY; }
            }
            softmax_step<true>(m, l, o, p0, p1, wsf, r32, hi);
            mid();
            pv_tile(o, p0, p1, buf + 64 * KRS_NSA, r32, hi);
        });
        const float lt = l + __shfl_xor(l, 32);
        nsa_finish<2>(o, gate_w / fmaxf(lt, 1e-30f), wsf, P.ws, t0, w, hk, tid, r32, hi);
    }
#undef ZERO_O
}

struct Args { const float* in[26]; float* out; unsigned char* ws; int ph_lo, ph_hi; };
constexpr int N_PHASES = 13;
#ifndef PROBE_REP7
#define PROBE_REP7 1
#endif
#ifndef PROBE_REP1
#define PROBE_REP1 1
#endif

__global__ void __launch_bounds__(NTHREADS) mega_fwd(Args args) {
    extern __shared__ __attribute__((aligned(16))) unsigned char lds_raw[];
    LAS unsigned char* lds = (LAS unsigned char*)lds_raw;
    cg::grid_group grid = cg::this_grid();
    const int G = gridDim.x, bx = blockIdx.x;
#define PHASE_IDS int tid = threadIdx.x; asm volatile("" : "+v"(tid)); const int lane = tid & 63, wave = __builtin_amdgcn_readfirstlane(tid >> 6); \
    const int gw = bx * NWAVES + wave, NGW = G * NWAVES; const int gtid = bx * NTHREADS + tid, NGT = G * NTHREADS; LAS float* scr = (LAS float*)(lds + wave * 16384); \
    (void)lane; (void)gw; (void)NGW; (void)gtid; (void)NGT; (void)scr
    unsigned char* ws = args.ws;
    float* out = args.out;
    bf16_t* WGU = (bf16_t*)(ws + WS_WGU); bf16_t* WD = (bf16_t*)(ws + WS_WD); bf16_t* WIN = (bf16_t*)(ws + WS_WIN); bf16_t* WVN = (bf16_t*)(ws + WS_WVN);
    bf16_t* WUQ = (bf16_t*)(ws + WS_WUQ); bf16_t* WKN = (bf16_t*)(ws + WS_WKN); bf16_t* WVM = (bf16_t*)(ws + WS_WVM); bf16_t* W1K = (bf16_t*)(ws + WS_W1K);
    bf16_t* W1V = (bf16_t*)(ws + WS_W1V); bf16_t* WOUT = (bf16_t*)(ws + WS_WOUT);
    float* TAB128 = (float*)(ws + WS_TAB128); float* TAB64 = (float*)(ws + WS_TAB64); float* SSQ = (float*)(ws + WS_SSQ); float* CBIAS = (float*)(ws + WS_MISC);
    float* HCP = (float*)(ws + WS_HCP); bf16_t* KC = (bf16_t*)(ws + WS_KC); bf16_t* VCT = KC + 2 * 1024 * 128;
    bf16_t* XB = (bf16_t*)(ws + WS_XB); bf16_t* H = (bf16_t*)(ws + WS_H);
    float* PRE3 = (float*)(ws + 384 * MiB);
    bf16_t* D0 = (bf16_t*)out; bf16_t* D1 = D0 + (size_t)M * DM;
    bf16_t* CQ = (bf16_t*)(ws + WS_CQ); bf16_t* CKV = (bf16_t*)(ws + WS_CKV); bf16_t* KR = (bf16_t*)(ws + WS_KR); bf16_t* GL = (bf16_t*)(ws + WS_GL);
    bf16_t* QN = (bf16_t*)(ws + WS_QN); bf16_t* KCR = (bf16_t*)(ws + WS_KCR); bf16_t* VCR = (bf16_t*)(ws + WS_VCR); bf16_t* KS = (bf16_t*)(ws + WS_KS);
    bf16_t* KW = (bf16_t*)(ws + WS_KW); bf16_t* VTN = (bf16_t*)(ws + WS_VTN); bf16_t* QM = (bf16_t*)(ws + WS_QM); bf16_t* KN = (bf16_t*)(ws + WS_KN);
    bf16_t* VT = (bf16_t*)(ws + WS_VT); float* OACC = (float*)(ws + WS_OACC);
    const int lo = args.ph_lo, hi_ph = args.ph_hi;
    unsigned* barctr = (unsigned*)(ws + WS_MISC + 65536); unsigned epoch = 0u;
    grid.sync();
#ifndef ONLY_PHASE
#define ONLY_PHASE -1
#endif
#define IN(k) ((ONLY_PHASE < 0 || ONLY_PHASE == (k)) && lo <= (k) && (k) < hi_ph)
#define SEAM(k) do { if (IN(k) && IN((k) + 1)) { \
        asm volatile("s_waitcnt vmcnt(0)" ::: "memory"); __syncthreads(); epoch += (unsigned)G; \
        if (threadIdx.x == 0) { __builtin_amdgcn_fence(__ATOMIC_RELEASE, "agent"); asm volatile("s_waitcnt vmcnt(0)" ::: "memory"); \
            __hip_atomic_fetch_add(barctr, 1u, __ATOMIC_RELAXED, __HIP_MEMORY_SCOPE_AGENT); \
            while (__hip_atomic_load(barctr, __ATOMIC_RELAXED, __HIP_MEMORY_SCOPE_AGENT) < epoch) __builtin_amdgcn_s_sleep(2); \
            __builtin_amdgcn_fence(__ATOMIC_ACQUIRE, "agent"); asm volatile("s_waitcnt vmcnt(0)" ::: "memory"); } \
        __syncthreads(); } } while (0)

    if (IN(0)) {
        PHASE_IDS;
        transpose_job<MAP_GU>(args.in[1], args.in[2], DFF, nullptr, DM, 2 * DFF, WGU, scr, gw, NGW, lane);
        transpose_job<MAP_PLAIN>(args.in[3], args.in[3], DM, nullptr, DFF, DM, WD, scr, gw, NGW, lane);
        transpose_job<MAP_WIN>(args.in[6], args.in[6], 3416, nullptr, DM, 3072, WIN, scr, gw, NGW, lane);
        transpose_job<MAP_WVN>(args.in[6], args.in[6], 3416, nullptr, DM, 512, WVN, scr, gw, NGW, lane);
        transpose_job<MAP_UQ>(args.in[8], args.in[8], 1536, args.in[7], 512, 1536, WUQ, scr, gw, NGW, lane);
        transpose_job<MAP_UKV0>(args.in[10], args.in[10], 2048, args.in[9], 256, 1024, WKN, scr, gw, NGW, lane);
        transpose_job<MAP_UKV1>(args.in[10], args.in[10], 2048, args.in[9], 256, 1024, WVM, scr, gw, NGW, lane);
        transpose_job<MAP_PLAIN>(args.in[13], args.in[13], 256, nullptr, 4096, 256, W1K, scr, gw, NGW, lane);
        transpose_job<MAP_PLAIN>(args.in[16], args.in[16], 256, nullptr, 4096, 256, W1V, scr, gw, NGW, lane);
        transpose_job<MAP_PLAIN>(args.in[18], args.in[18], DM, nullptr, DM, DM, WOUT, scr, gw, NGW, lane);
        { const float* x = args.in[0];
          const size_t nvec = (size_t)M * DM / 8;
          for (size_t i = gtid; i < nvec; i += (size_t)4 * NGT) {
              f32x4 a[4], b[4];
#pragma unroll
              for (int k = 0; k < 4; ++k) { const size_t ii = i + (size_t)k * NGT; if (ii < nvec) { a[k] = ((const f32x4*)x)[2 * ii]; b[k] = ((const f32x4*)x)[2 * ii + 1]; } }
#pragma unroll
              for (int k = 0; k < 4; ++k) { const size_t ii = i + (size_t)k * NGT; if (ii < nvec) {
                  u32x4 w; w.x = pk2(a[k][0], a[k][1]); w.y = pk2(a[k][2], a[k][3]); w.z = pk2(b[k][0], b[k][1]); w.w = pk2(b[k][2], b[k][3]); ((u32x4*)XB)[ii] = w; } }
          } }
        for (int i = gtid; i < M * 96; i += NGT) {
            int pos, f; double base; float* dst;
            if (i < M * 64) { pos = i >> 6; f = i & 63; base = 0.8659643233600653; dst = TAB128 + 2 * (size_t)i; }
            else { const int k = i - M * 64; pos = k >> 5; f = k & 31; base = 0.7498942093324558; dst = TAB64 + 2 * (size_t)k; }
            double inv = 1.0; for (int e = 0; e < f; ++e) inv *= base;
            const double ang = (double)pos * inv;
            const double kq = __builtin_rint(ang * 0.6366197723675814);
            double y = __builtin_fma(-kq, 1.5707963267948966, ang); y = __builtin_fma(-kq, 6.123233995736766e-17, y);
            const double y2 = y * y;
            double sn = -1.0 / 39916800.0; sn = sn * y2 + 1.0 / 362880.0; sn = sn * y2 - 1.0 / 5040.0; sn = sn * y2 + 1.0 / 120.0; sn = sn * y2 - 1.0 / 6.0; sn = sn * y2 * y + y;
            double cs = 1.0 / 479001600.0; cs = cs * y2 - 1.0 / 3628800.0; cs = cs * y2 + 1.0 / 40320.0; cs = cs * y2 - 1.0 / 720.0; cs = cs * y2 + 1.0 / 24.0; cs = cs * y2 - 0.5; cs = cs * y2 + 1.0;
            const int qd = ((int)((long long)kq & 3));
            double c, s; if (qd == 0) { c = cs; s = sn; } else if (qd == 1) { c = -sn; s = cs; } else if (qd == 2) { c = -cs; s = -sn; } else { c = sn; s = -cs; }
            dst[0] = (float)c; dst[1] = (float)s;
        }
        for (int item = bx; item < 256; item += G) {
            const int kv = item >> 7, n = 2 * (item & 127) + (tid & 1), k0 = (tid >> 1) * 16;
            const float* pe = args.in[kv ? 15 : 12]; const float* w1 = args.in[kv ? 16 : 13];
            float sacc = 0.f;
#pragma unroll
            for (int k = 0; k < 16; ++k) sacc += pe[k0 + k] * w1[(size_t)(k0 + k) * 256 + n];
            LAS float* red = (LAS float*)lds;
            __syncthreads(); red[tid] = sacc; __syncthreads();
            for (int st = 256; st >= 2; st >>= 1) { if (tid < st) red[tid] += red[tid + st]; __syncthreads(); }
            if (tid < 2) CBIAS[kv * 256 + 2 * (item & 127) + tid] = red[tid];
            __syncthreads();
        }
    }
    SEAM(0);
    if (IN(1)) for (int rep1 = 0; rep1 < PROBE_REP1; ++rep1) { pg8::Gemm g{XB, WGU, DM, DM, DM}; pg8::StaticOrder S; S.init(64, 44, G, bx); EpiSwiglu E{H}; pg8::gemm_phase(lds, g, S, E); }
    SEAM(1);
    if (IN(2)) { pg8::Gemm g{H, WD, DFF, DFF, DFF}; pg8::StaticOrder S; S.init(64, 8, G, bx); EpiResidB<false> E{args.in[0], D0, ALPHA, 0.5f}; pg8::gemm_phase(lds, g, S, E); }
    SEAM(2);
    if (IN(3)) {
        PHASE_IDS;
        { f32x4 gq[8], bq[8]; ln_load_gb(gq, bq, args.in[4], args.in[5], lane);
          for (int r = gw; r < M; r += 2 * NGW) { const int r2 = r + NGW; u32x4 xa[4], xb2[4];
#pragma unroll
              for (int j = 0; j < 4; ++j) { xa[j] = *(const u32x4*)(D0 + (size_t)r * DM + 8 * lane + 512 * j); if (r2 < M) xb2[j] = *(const u32x4*)(D0 + (size_t)r2 * DM + 8 * lane + 512 * j); }
              ln_row_b<false>(xa, D1 + (size_t)r * DM, gq, bq, lane); if (r2 < M) ln_row_b<false>(xb2, D1 + (size_t)r2 * DM, gq, bq, lane); } }
        transpose_job<MAP_GU>(args.in[21], args.in[22], DFF, nullptr, DM, 2 * DFF, WGU, scr, gw, NGW, lane);
        transpose_job<MAP_PLAIN>(args.in[23], args.in[23], DM, nullptr, DFF, DM, WD, scr, gw, NGW, lane);
    }
    SEAM(3);
    if (IN(4)) {
        { pg8::Gemm g{D1, WIN, DM, DM, DM}; pg8::StaticOrder S; S.init(64, 12, G, bx);
          EpiWin E{CQ, CKV, KR, GL, QN, KCR, VCR, KS, KW, SSQ, TAB128, TAB64}; pg8::gemm_phase(lds, g, S, E); }
        { pg8::Gemm g{WVN, D1, DM, DM, DM}; pg8::StaticOrder S; S.init(2, 64, G, bx); EpiColBf16 E{VTN, M, nullptr}; pg8::gemm_phase(lds, g, S, E); }
    }
    SEAM(4);
    if (IN(5)) {
        int off = 0;
        for (int job = 0; job < 16; ++job) { const int kv = job >> 3, hk = (job >> 2) & 1, sp = job & 3;
            pg8::Gemm g{(kv ? VCR : KCR) + (size_t)hk * M * 128 + sp * 1024, (kv ? W1V : W1K) + sp * 1024, 2048, 4096, 1024};
            pg8::StaticOrder S; S.init(4, 1, G, (bx + G - (off % G)) % G); EpiF32 E{HCP + (size_t)job * 1024 * 256, 256}; pg8::gemm_phase(lds, g, S, E); off += 4; }
        { pg8::Gemm g{CQ, WUQ, 512, 512, 512}; pg8::StaticOrder S; S.init(64, 6, G, (bx + G - (off % G)) % G); EpiQup E{QM, SSQ, TAB64}; pg8::gemm_phase(lds, g, S, E); off += 384; }
        { pg8::Gemm g{CKV, WKN, 256, 256, 256}; pg8::StaticOrder S; S.init(64, 4, G, (bx + G - (off % G)) % G); EpiKn E{KN, SSQ}; pg8::gemm_phase(lds, g, S, E); off += 256; }
        { pg8::Gemm g{WVM, CKV, 256, 256, 256}; pg8::StaticOrder S; S.init(4, 64, G, (bx + G - (off % G)) % G); EpiColBf16 E{VT, M, SSQ}; pg8::gemm_phase(lds, g, S, E); }
    }
    SEAM(5);
    if (IN(6)) {
        PHASE_IDS;
        LAS float* hid = (LAS float*)lds;
        for (int item = bx; item < 256; item += G) {
            const int kv = item >> 7, hk = (item >> 6) & 1, c0 = 16 * (item & 63);
            const float* hp = HCP + (size_t)((kv * 2 + hk) * 4) * 1024 * 256;
#pragma unroll
            for (int e = 0; e < 8; ++e) { const int idx = tid + 512 * e, c = idx >> 8, n = idx & 255; const size_t o = (size_t)(c0 + c) * 256 + n;
                float s = hp[o] + hp[o + 262144] + hp[o + 524288] + hp[o + 786432] + CBIAS[kv * 256 + n];
                const float u = 0.7978845608028654f * (s + 0.044715f * s * s * s);
                const float e2 = __builtin_amdgcn_exp2f(2.f * u * 1.4426950408889634f);
                const float th = 1.f - 2.f / (e2 + 1.f);
                hid[idx] = 0.5f * s * (1.f + th); }
            __syncthreads();
            const int d = tid & 127, cg4 = tid >> 7; const float* w2 = args.in[kv ? 17 : 14];
            float a0 = 0.f, a1 = 0.f, a2 = 0.f, a3 = 0.f;
#pragma unroll 16
            for (int n = 0; n < 256; ++n) { const float wv = w2[n * 128 + d]; a0 += hid[(4 * cg4) * 256 + n] * wv; a1 += hid[(4 * cg4 + 1) * 256 + n] * wv; a2 += hid[(4 * cg4 + 2) * 256 + n] * wv; a3 += hid[(4 * cg4 + 3) * 256 + n] * wv; }
            float av[4] = {a0, a1, a2, a3};
#pragma unroll
            for (int j = 0; j < 4; ++j) { const int c = c0 + 4 * cg4 + j; const float v = (c == 1023) ? 0.f : av[j]; const bf16_t b = (bf16_t)(pk2(v, 0.f) & 0xffffu);
                if (kv == 0) KC[((size_t)hk * 1024 + c) * 128 + d] = b; else { const int cpos = (c & ~15) | (c & 3) | ((c & 4) << 1) | ((c & 8) >> 1); VCT[((size_t)hk * 128 + d) * 1024 + cpos] = b; } }
            __syncthreads();
        }
    }
    SEAM(6);
    if (IN(7)) {
        PHASE_IDS;
        AttnPtrs P{ws, args.in[11]};
        LAS float* wsf = (LAS float*)(lds + WSF_OFF) + wave * 32;
        for (int rep7 = 0; rep7 < PROBE_REP7; ++rep7)
        for (int c = bx; c < 256; c += G) {
            const int x = c & 7, y = c >> 3;
#ifndef NO_NSA
            { const int hk = x & 1, pair = (x >> 1) * 32 + y;
#pragma unroll 1
              for (int rep = 0; rep < 2; ++rep) nsa_unit(hk, rep ? pair : 255 - pair, lds, wsf, P); }
#endif
#ifndef NO_MLA
            { const int h = x, pair = y;
#pragma unroll 1
              for (int rep = 0; rep < 2; ++rep) mla_unit(h, rep ? pair : 63 - pair, lds, wsf, P); }
#endif
        }
    }
    SEAM(7);
    if (IN(8)) { pg8::Gemm g{XB, WOUT, DM, DM, DM}; pg8::StaticOrder S; S.init(64, 8, G, bx); EpiResidB<true> E{D1, D0, ALPHA, 1.0f}; pg8::gemm_phase(lds, g, S, E); }
    SEAM(8);
    if (IN(9)) { PHASE_IDS; f32x4 gq[8], bq[8]; ln_load_gb(gq, bq, args.in[19], args.in[20], lane); for (int r = gw; r < M; r += 2 * NGW) { const int r2 = r + NGW; u32x4 xa[4], xb2[4];
#pragma unroll
            for (int j = 0; j < 4; ++j) { xa[j] = *(const u32x4*)(D0 + (size_t)r * DM + 8 * lane + 512 * j); if (r2 < M) xb2[j] = *(const u32x4*)(D0 + (size_t)r2 * DM + 8 * lane + 512 * j); }
            ln_row_b<false>(xa, D1 + (size_t)r * DM, gq, bq, lane); if (r2 < M) ln_row_b<false>(xb2, D1 + (size_t)r2 * DM, gq, bq, lane); } }
    SEAM(9);
    if (IN(10)) { pg8::Gemm g{D1, WGU, DM, DM, DM}; pg8::StaticOrder S; S.init(64, 44, G, bx); EpiSwiglu E{H}; pg8::gemm_phase(lds, g, S, E); }
    SEAM(10);
    if (IN(11)) { pg8::Gemm g{H, WD, DFF, DFF, DFF}; pg8::StaticOrder S; S.init(64, 8, G, bx); EpiResidB<true, true> E{D1, PRE3, ALPHA, 0.5f}; pg8::gemm_phase(lds, g, S, E); }
    SEAM(11);
    if (IN(12)) { PHASE_IDS; f32x4 gq[8], bq[8];
#pragma unroll
        for (int j = 0; j < 8; ++j) { gq[j] = ((const f32x4*)args.in[24])[64 * j + lane]; bq[j] = ((const f32x4*)args.in[25])[64 * j + lane]; }
        for (int r = gw; r < M; r += NGW) ln_row(PRE3 + (size_t)r * DM, out + (size_t)r * DM, nullptr, gq, bq, lane); }
#undef IN
#undef SEAM
}

#ifndef MK_PER_PHASE
#define MK_PER_PHASE 0
#endif
extern "C" void kernel_launch(void* const* d_in, const int* in_sizes, int n_in, void* d_out, int out_size, void* d_ws, size_t ws_size, hipStream_t stream) {
    static int grid = 0;
    if (grid == 0) {
        if (n_in != 26 || out_size != M * DM || ws_size < 512 * MiB) { fprintf(stderr, "kernel_launch: unexpected shapes (n_in %d out %d ws %zu)\n", n_in, out_size, ws_size); grid = -1; return; }
        int dev = 0, cus = 0, per_cu = 0;
        hipGetDevice(&dev); hipDeviceGetAttribute(&cus, hipDeviceAttributeMultiprocessorCount, dev);
        hipFuncSetAttribute((const void*)mega_fwd, hipFuncAttributeMaxDynamicSharedMemorySize, LDS_BYTES);
        if (hipOccupancyMaxActiveBlocksPerMultiprocessor(&per_cu, (const void*)mega_fwd, NTHREADS, LDS_BYTES) != hipSuccess || per_cu < 1) per_cu = 1;
        (void)hipGetLastError();
        grid = cus * per_cu;
    }
    if (grid < 0) return;
    Args a{};
    for (int i = 0; i < 26; ++i) a.in[i] = (const float*)d_in[i];
    a.out = (float*)d_out; a.ws = (unsigned char*)d_ws;
#if MK_PER_PHASE
    for (int p = 0; p < N_PHASES; ++p) { a.ph_lo = p; a.ph_hi = p + 1; void* kargs[] = {&a};
        hipError_t e = hipLaunchCooperativeKernel((const void*)mega_fwd, dim3(grid), dim3(NTHREADS), kargs, LDS_BYTES, stream);
        if (e != hipSuccess) { fprintf(stderr, "launch failed: %s\n", hipGetErrorString(e)); break; } }
#else
    (void)hipMemsetAsync((unsigned char*)d_ws + WS_MISC + 65536, 0, 256, stream);
    a.ph_lo = 0; a.ph_hi = N_PHASES; void* kargs[] = {&a};
    hipError_t e = hipLaunchCooperativeKernel((const void*)mega_fwd, dim3(grid), dim3(NTHREADS), kargs, LDS_BYTES, stream);
    if (e != hipSuccess) fprintf(stderr, "cooperative launch failed: %s (grid %d)\n", hipGetErrorString(e), grid);
#endif
}
```

```cpp
#include <hip/hip_runtime.h>
#include <hip/hip_cooperative_groups.h>
#include <cstdio>
#include <cstdint>
namespace cg = cooperative_groups;

#define LAS __attribute__((address_space(3)))
#define GAS __attribute__((address_space(1)))
typedef unsigned short bf16_t;
typedef short bf16x8 __attribute__((ext_vector_type(8)));
typedef short s16x4 __attribute__((ext_vector_type(4)));
typedef float f32x2 __attribute__((ext_vector_type(2)));
typedef float f32x4 __attribute__((ext_vector_type(4)));
typedef float f32x16 __attribute__((ext_vector_type(16)));
typedef unsigned u32x4 __attribute__((ext_vector_type(4)));
typedef unsigned u32x2 __attribute__((ext_vector_type(2)));
typedef __bf16 bf16x2_t __attribute__((ext_vector_type(2)));

constexpr int M = 16384, DM = 2048, DFF = 5632;
constexpr float ALPHA = 1.189207115002721f;
constexpr float LN_EPS = 1e-5f, RMS_EPS = 1e-6f;
constexpr float C2M = 0.10411754627697264f;
constexpr float C2N = 0.12751743082459868f;
constexpr int NTHREADS = 512, NWAVES = 8;
constexpr int LDS_BYTES = 147456;

constexpr size_t MiB = 1u << 20;
constexpr size_t WS_WGU = 0, WS_WD = 44 * MiB, WS_WIN = 66 * MiB, WS_WVN = 78 * MiB, WS_WUQ = 80 * MiB, WS_WKN = 82 * MiB,
                 WS_WVM = 83 * MiB, WS_W1K = 84 * MiB, WS_W1V = 86 * MiB, WS_WOUT = 88 * MiB, WS_TAB128 = 96 * MiB, WS_TAB64 = 104 * MiB,
                 WS_SSQ = 108 * MiB, WS_MISC = 110 * MiB, WS_HCP = 111 * MiB, WS_KC = 127 * MiB, WS_XB = 128 * MiB, WS_R = 192 * MiB;
constexpr size_t WS_H = WS_R;
constexpr size_t WS_CQ = 192 * MiB, WS_CKV = 208 * MiB, WS_KR = 216 * MiB, WS_GL = 218 * MiB, WS_QN = 220 * MiB, WS_KCR = 252 * MiB,
                 WS_VCR = 260 * MiB, WS_KS = 268 * MiB, WS_KW = 276 * MiB, WS_VTN = 284 * MiB, WS_QM = 300 * MiB, WS_KN = 348 * MiB,
                 WS_VT = 380 * MiB, WS_OACC = 412 * MiB, WS_END = 460 * MiB;

__device__ __forceinline__ unsigned pk2(float lo, float hi) { f32x2 v = {lo, hi}; bf16x2_t b = __builtin_convertvector(v, bf16x2_t); return __builtin_bit_cast(unsigned, b); }
__device__ __forceinline__ float bf2f(unsigned short h) { return __uint_as_float(((unsigned)h) << 16); }
__device__ __forceinline__ int get_tid0() { return (int)threadIdx.x; }
__device__ __forceinline__ float wave_sum(float v) {
#pragma unroll
    for (int o = 1; o < 64; o <<= 1) v += __shfl_xor(v, o);
    return v;
}

namespace pg8 {
constexpr int BM = 256, BK = 64, HALF = 128, HTB = HALF * BK * 2, STAGE_BYTES = 8 * HTB, NXCD = 8, WGM = 8;
__host__ __device__ __forceinline__ int lds_byte(int r, int c) { const int st = (r >> 4) * 2 + (c >> 5), rr = r & 15, cc = c & 31, ob = rr * 64 + cc * 2; return st * 1024 + (ob ^ (((ob >> 9) & 1) << 5)); }
__host__ __device__ __forceinline__ void stage_rc(int b, int& R, int& C) { const int st = b / 1024, sb = b % 1024, swz = sb ^ (((sb >> 9) & 1) << 5); R = (st >> 1) * 16 + swz / 64; C = (st & 1) * 32 + (swz % 64) / 2; }
__host__ __device__ __forceinline__ int perm32(int rho) { const int n = rho >> 4, i = rho & 15; return 8 * (i >> 2) + 4 * n + (i & 3); }

struct Unit { int pm, pn; };
struct Gemm { const bf16_t* A; const bf16_t* Bt; int lda, ldb, K; };

struct StaticOrder {
    int nM, nN, nwg, G, c;
    __device__ __forceinline__ void init(int nM_, int nN_, int G_, int c_) { nM = nM_; nN = nN_; nwg = nM * nN; G = G_; c = c_; }
    __device__ __forceinline__ bool next(int i, Unit& u) const {
        const long L = (long)i * G + c; if (L >= nwg) return false;
        int wgid = (int)L; { const int q = nwg / NXCD, r = nwg % NXCD, xcd = wgid % NXCD, off = wgid / NXCD; wgid = (xcd < r ? xcd * (q + 1) : r * (q + 1) + (xcd - r) * q) + off; }
        const int nig = WGM * nN, gid = wgid / nig, fm = gid * WGM, gsz = (nM - fm) < WGM ? (nM - fm) : WGM;
        u.pm = fm + ((wgid % nig) % gsz); u.pn = (wgid % nig) / gsz; return true;
    }
};

template <class Epi>
__device__ __forceinline__ void gemm_phase(LAS unsigned char* lds, const Gemm g, const StaticOrder& S, const Epi& E) {
    int tid = threadIdx.x; asm volatile("" : "+v"(tid)); const int wid = __builtin_amdgcn_readfirstlane(tid >> 6), lane = tid & 63, wr = wid >> 2, wc = wid & 3, fr = lane & 15, fq = lane >> 4;
    const int K = g.K, nt = K / BK;
    unsigned voffA[2], voffB[2];
#pragma unroll
    for (int i = 0; i < 2; ++i) { int R, C; stage_rc(tid * 16 + i * 8192, R, C); const int Rb = Epi::PERM ? ((R & ~31) + perm32(R & 31)) : R;
        voffA[i] = (unsigned)(R * g.lda + C) * 2u; voffB[i] = (unsigned)(Rb * g.ldb + C) * 2u; }
    const size_t kstep = (size_t)(BK * 2);
    const size_t hstepA = (size_t)HALF * g.lda * 2, hstepB = (size_t)HALF * g.ldb * 2;
    const size_t tstepA = 2 * hstepA, tstepB = 2 * hstepB;
    const unsigned ldsw = (unsigned)wid * 1024u;
    const int aoff = lds_byte(wr * 64 + fr, fq * 8), boff = lds_byte(wc * 32 + fr, fq * 8);
#define PG8_SA(b, h) (((b) * 2 + (h)) * HTB)
#define PG8_SB(b, h) ((4 + (b) * 2 + (h)) * HTB)
#define PG8_STAGE(bufoff, gbase, voff) do { _Pragma("unroll") for (int _i = 0; _i < 2; ++_i) \
        __builtin_amdgcn_global_load_lds((const unsigned*)((const char*)(gbase) + (voff)[_i]), (LAS unsigned*)(lds + (bufoff) + ldsw + _i * 8192), 16, 0, 0); } while (0)
#define PG8_LDA(dst, b, h) do { _Pragma("unroll") for (int m = 0; m < 4; ++m) _Pragma("unroll") for (int k = 0; k < 2; ++k) dst[m][k] = *(const LAS bf16x8*)(lds + PG8_SA(b, h) + aoff + m * 2048 + k * 1024); } while (0)
#define PG8_LDB(dst, b, h) do { _Pragma("unroll") for (int n = 0; n < 2; ++n) _Pragma("unroll") for (int k = 0; k < 2; ++k) dst[n][k] = *(const LAS bf16x8*)(lds + PG8_SB(b, h) + boff + n * 2048 + k * 1024); } while (0)
#define PG8_MMA(ai, bj, At, Bt) do { __builtin_amdgcn_s_setprio(1); _Pragma("unroll") for (int m = 0; m < 4; ++m) _Pragma("unroll") for (int n = 0; n < 2; ++n) _Pragma("unroll") for (int k = 0; k < 2; ++k) \
        acc[ai][bj][m][n] = __builtin_amdgcn_mfma_f32_16x16x32_bf16(Bt[n][k], At[m][k], acc[ai][bj][m][n], 0, 0, 0); __builtin_amdgcn_s_setprio(0); } while (0)
#define PG8_WAIT_V(n) asm volatile("s_waitcnt vmcnt(" #n ")" ::: "memory")
#define PG8_WAIT_L(n) asm volatile("s_waitcnt lgkmcnt(" #n ")" ::: "memory")
#define PG8_BAR __builtin_amdgcn_s_barrier()
#define PG8_SCHED __builtin_amdgcn_sched_barrier(0)
    Unit cur, nxt; int ui = 0;
    if (!S.next(0, cur)) return;
    f32x4 acc[2][2][4][2];
#pragma unroll
    for (int a = 0; a < 2; ++a)
#pragma unroll
        for (int b = 0; b < 2; ++b)
#pragma unroll
            for (int m = 0; m < 4; ++m)
#pragma unroll
                for (int n = 0; n < 2; ++n) acc[a][b][m][n] = (f32x4){0.f, 0.f, 0.f, 0.f};
    bf16x8 At[4][2], B0[2][2], B1[2][2];
    const char* cA = (const char*)g.A + (size_t)cur.pm * tstepA; const char* cB = (const char*)g.Bt + (size_t)cur.pn * tstepB;
    PG8_STAGE(PG8_SB(0, 0), cB, voffB); PG8_STAGE(PG8_SB(0, 1), cB + hstepB, voffB); PG8_STAGE(PG8_SA(0, 0), cA, voffA); PG8_STAGE(PG8_SA(0, 1), cA + hstepA, voffA);
    if (wr == 1) PG8_BAR;
    PG8_WAIT_V(2); PG8_BAR;
    PG8_STAGE(PG8_SB(1, 0), cB + kstep, voffB); PG8_STAGE(PG8_SA(1, 0), cA + kstep, voffA); PG8_STAGE(PG8_SB(1, 1), cB + hstepB + kstep, voffB);
    PG8_WAIT_V(6); PG8_BAR;
    for (;;) {
        const bool has_next = S.next(ui + 1, nxt);
        const char* nA = has_next ? (const char*)g.A + (size_t)nxt.pm * tstepA : cA; const char* nB = has_next ? (const char*)g.Bt + (size_t)nxt.pn * tstepB : cB;
        for (int t = 0; t < nt; t += 2) {
            const bool last = (t == nt - 2);
            const char* a1 = cA + (size_t)(t + 1) * kstep;
            const char* a2 = last ? nA : cA + (size_t)(t + 2) * kstep; const char* b2 = last ? nB : cB + (size_t)(t + 2) * kstep;
            const char* a3 = a2 + kstep; const char* b3 = b2 + kstep;
            PG8_LDB(B0, 0, 0); PG8_LDB(B1, 0, 1); PG8_SCHED; PG8_LDA(At, 0, 0); PG8_STAGE(PG8_SA(1, 1), a1 + hstepA, voffA);
            PG8_WAIT_V(8); PG8_WAIT_L(0); PG8_BAR; PG8_MMA(0, 0, At, B0); PG8_MMA(0, 1, At, B1); PG8_BAR; PG8_SCHED;
            PG8_LDA(At, 0, 1); PG8_STAGE(PG8_SB(0, 0), b2, voffB); PG8_STAGE(PG8_SB(0, 1), b2 + hstepB, voffB); PG8_STAGE(PG8_SA(0, 0), a2, voffA);
            PG8_WAIT_V(8); PG8_WAIT_L(0); PG8_BAR; PG8_MMA(1, 0, At, B0); PG8_MMA(1, 1, At, B1); PG8_BAR; PG8_SCHED;
            PG8_LDB(B0, 1, 0); PG8_LDB(B1, 1, 1); PG8_SCHED; PG8_LDA(At, 1, 0); PG8_STAGE(PG8_SA(0, 1), a2 + hstepA, voffA);
            PG8_WAIT_V(8); PG8_WAIT_L(0); PG8_BAR; PG8_MMA(0, 0, At, B0); PG8_MMA(0, 1, At, B1); PG8_BAR; PG8_SCHED;
            PG8_LDA(At, 1, 1); PG8_STAGE(PG8_SB(1, 0), b3, voffB); PG8_STAGE(PG8_SB(1, 1), b3 + hstepB, voffB); PG8_STAGE(PG8_SA(1, 0), a3, voffA);
            PG8_WAIT_V(8); PG8_WAIT_L(0); PG8_BAR; PG8_MMA(1, 0, At, B0); PG8_MMA(1, 1, At, B1); PG8_BAR; PG8_SCHED;
        }
        if (wr == 0) PG8_BAR;
        E(acc, cur, wr, wc, fr, fq);
        if (!has_next) break;
#pragma unroll
        for (int a = 0; a < 2; ++a)
#pragma unroll
            for (int b = 0; b < 2; ++b)
#pragma unroll
                for (int m = 0; m < 4; ++m)
#pragma unroll
                    for (int n = 0; n < 2; ++n) acc[a][b][m][n] = (f32x4){0.f, 0.f, 0.f, 0.f};
        cur = nxt; cA = nA; cB = nB; ++ui;
        if (wr == 1) PG8_BAR;
    }
    PG8_WAIT_V(0);
    PG8_BAR;
#undef PG8_SA
#undef PG8_SB
#undef PG8_STAGE
#undef PG8_LDA
#undef PG8_LDB
#undef PG8_MMA
#undef PG8_WAIT_V
#undef PG8_WAIT_L
#undef PG8_BAR
#undef PG8_SCHED
}
}

typedef f32x4 AccT[2][2][4][2];

struct EpiSwiglu {
    static constexpr bool PERM = true;
    bf16_t* H;
    __device__ __forceinline__ void operator()(const AccT& acc, const pg8::Unit& u, int wr, int wc, int fr, int fq) const {
        const int col = u.pn * 128 + wc * 32 + fq * 8;
#pragma unroll
        for (int ai = 0; ai < 2; ++ai)
#pragma unroll
            for (int m = 0; m < 4; ++m) {
                const int row = u.pm * 256 + ai * 128 + wr * 64 + m * 16 + fr;
                float o[8];
#pragma unroll
                for (int n = 0; n < 2; ++n)
#pragma unroll
                    for (int j = 0; j < 4; ++j) { const float gt = acc[ai][0][m][n][j], up = acc[ai][1][m][n][j];
                        const float sg = gt * __builtin_amdgcn_rcpf(1.f + __builtin_amdgcn_exp2f(-gt * 1.4426950408889634f)); o[n * 4 + j] = sg * up; }
                u32x4 w; w.x = pk2(o[0], o[1]); w.y = pk2(o[2], o[3]); w.z = pk2(o[4], o[5]); w.w = pk2(o[6], o[7]);
                *(u32x4*)(H + (size_t)row * DFF + col) = w;
            }
    }
};
struct EpiResid {
    static constexpr bool PERM = false;
    const float* res; float* out; float a, b;
    __device__ __forceinline__ void operator()(const AccT& acc, const pg8::Unit& u, int wr, int wc, int fr, int fq) const {
#pragma unroll
        for (int ai = 0; ai < 2; ++ai)
#pragma unroll
            for (int m = 0; m < 4; ++m) {
                const size_t rowoff = (size_t)(u.pm * 256 + ai * 128 + wr * 64 + m * 16 + fr) * DM + u.pn * 256 + wc * 32 + fq * 4;
#pragma unroll
                for (int bj = 0; bj < 2; ++bj)
#pragma unroll
                    for (int n = 0; n < 2; ++n) { const size_t off = rowoff + bj * 128 + n * 16; const f32x4 r = *(const f32x4*)(res + off);
                        *(f32x4*)(out + off) = r * a + acc[ai][bj][m][n] * b; }
            }
    }
};
template <bool RES_BF16, bool OUT_F32 = false>
struct EpiResidB {
    static constexpr bool PERM = true;
    const void* res; void* out; float a, b;
    __device__ __forceinline__ void operator()(const AccT& acc, const pg8::Unit& u, int wr, int wc, int fr, int fq) const {
#pragma unroll
        for (int ai = 0; ai < 2; ++ai)
#pragma unroll
            for (int m = 0; m < 4; ++m) {
                const size_t rowoff = (size_t)(u.pm * 256 + ai * 128 + wr * 64 + m * 16 + fr) * DM + u.pn * 256 + wc * 32 + fq * 8;
#pragma unroll
                for (int bj = 0; bj < 2; ++bj) { const size_t off = rowoff + bj * 128; float r[8];
                    if (RES_BF16) { const u32x4 w = *(const u32x4*)((const bf16_t*)res + off);
                        r[0] = __uint_as_float(w.x << 16); r[1] = __uint_as_float(w.x & 0xffff0000u); r[2] = __uint_as_float(w.y << 16); r[3] = __uint_as_float(w.y & 0xffff0000u);
                        r[4] = __uint_as_float(w.z << 16); r[5] = __uint_as_float(w.z & 0xffff0000u); r[6] = __uint_as_float(w.w << 16); r[7] = __uint_as_float(w.w & 0xffff0000u); }
                    else { const f32x4 x0 = *(const f32x4*)((const float*)res + off), x1 = *(const f32x4*)((const float*)res + off + 4);
                        r[0] = x0[0]; r[1] = x0[1]; r[2] = x0[2]; r[3] = x0[3]; r[4] = x1[0]; r[5] = x1[1]; r[6] = x1[2]; r[7] = x1[3]; }
                    const f32x4 v0 = acc[ai][bj][m][0], v1 = acc[ai][bj][m][1];
                    if (OUT_F32) { *(f32x4*)((float*)out + off) = (f32x4){r[0] * a + v0[0] * b, r[1] * a + v0[1] * b, r[2] * a + v0[2] * b, r[3] * a + v0[3] * b};
                        *(f32x4*)((float*)out + off + 4) = (f32x4){r[4] * a + v1[0] * b, r[5] * a + v1[1] * b, r[6] * a + v1[2] * b, r[7] * a + v1[3] * b}; }
                    else { u32x4 o; o.x = pk2(r[0] * a + v0[0] * b, r[1] * a + v0[1] * b); o.y = pk2(r[2] * a + v0[2] * b, r[3] * a + v0[3] * b);
                        o.z = pk2(r[4] * a + v1[0] * b, r[5] * a + v1[1] * b); o.w = pk2(r[6] * a + v1[2] * b, r[7] * a + v1[3] * b);
                        *(u32x4*)((bf16_t*)out + off) = o; } }
            }
    }
};
struct EpiF32 {
    static constexpr bool PERM = false;
    float* out; int ld;
    __device__ __forceinline__ void operator()(const AccT& acc, const pg8::Unit& u, int wr, int wc, int fr, int fq) const {
#pragma unroll
        for (int ai = 0; ai < 2; ++ai)
#pragma unroll
            for (int m = 0; m < 4; ++m) {
                const size_t rowoff = (size_t)(u.pm * 256 + ai * 128 + wr * 64 + m * 16 + fr) * ld + u.pn * 256 + wc * 32 + fq * 4;
#pragma unroll
                for (int bj = 0; bj < 2; ++bj)
#pragma unroll
                    for (int n = 0; n < 2; ++n) *(f32x4*)(out + rowoff + bj * 128 + n * 16) = acc[ai][bj][m][n];
            }
    }
};
__device__ __forceinline__ void rope4(const f32x4 x1, const f32x4 x2, const f32x4 t01, const f32x4 t23, float sc, u32x2& lo, u32x2& hi) {
    const float c0 = t01[0], s0 = t01[1], c1 = t01[2], s1 = t01[3], c2 = t23[0], s2 = t23[1], c3 = t23[2], s3 = t23[3];
    const float l0 = (x1[0] * c0 - x2[0] * s0) * sc, l1 = (x1[1] * c1 - x2[1] * s1) * sc, l2 = (x1[2] * c2 - x2[2] * s2) * sc, l3 = (x1[3] * c3 - x2[3] * s3) * sc;
    const float h0 = (x2[0] * c0 + x1[0] * s0) * sc, h1 = (x2[1] * c1 + x1[1] * s1) * sc, h2 = (x2[2] * c2 + x1[2] * s2) * sc, h3 = (x2[3] * c3 + x1[3] * s3) * sc;
    lo.x = pk2(l0, l1); lo.y = pk2(l2, l3); hi.x = pk2(h0, h1); hi.y = pk2(h2, h3);
}
struct EpiWin {
    static constexpr bool PERM = true;
    bf16_t *CQ, *CKV, *KR, *GL, *QN, *KCR, *VCR, *KS, *KW; float* SSQ; const float* tab128; const float* tab64;
    __device__ __forceinline__ void operator()(const AccT& acc, const pg8::Unit& u, int wr, int wc, int fr, int fq) const {
        const int c8 = wc * 32 + fq * 8;
#pragma unroll
        for (int bj = 0; bj < 2; ++bj) {
            const int blk = 2 * u.pn + bj;
            if (blk == 23) continue;
#pragma unroll
            for (int ai = 0; ai < 2; ++ai)
#pragma unroll
                for (int m = 0; m < 4; ++m) {
                    const int row = u.pm * 256 + ai * 128 + wr * 64 + m * 16 + fr;
                    const f32x4 v0 = acc[ai][bj][m][0], v1 = acc[ai][bj][m][1];
                    u32x4 raw; raw.x = pk2(v0[0], v0[1]); raw.y = pk2(v0[2], v0[3]); raw.z = pk2(v1[0], v1[1]); raw.w = pk2(v1[2], v1[3]);
                    if (blk < 6) {
                        bf16_t* dst = (blk < 4) ? CQ + (size_t)row * 512 + blk * 128 + c8 : CKV + (size_t)row * 256 + (blk - 4) * 128 + c8;
                        *(u32x4*)dst = raw;
                        float s = (v0[0] * v0[0] + v0[1] * v0[1]) + (v0[2] * v0[2] + v0[3] * v0[3]) + (v1[0] * v1[0] + v1[1] * v1[1]) + (v1[2] * v1[2] + v1[3] * v1[3]);
                        s += __shfl_xor(s, 16); s += __shfl_xor(s, 32);
                        if (fq == 0) SSQ[(size_t)row * 24 + blk * 4 + wc] = s;
                    } else if (blk == 6) {
                        if (wc < 2) { const int i = wc * 4 + fq; const f32x4* tp = (const f32x4*)(tab64 + ((size_t)row * 32 + 4 * i) * 2);
                            u32x2 lo, hi; rope4(v0, v1, tp[0], tp[1], 1.f, lo, hi);
                            *(u32x2*)(KR + (size_t)row * 64 + 4 * i) = lo; *(u32x2*)(KR + (size_t)row * 64 + 32 + 4 * i) = hi; }
                        else if (wc == 2) { *(u32x4*)(GL + (size_t)row * 32 + fq * 8) = raw; }
                    } else if (blk == 17 || blk == 18) {
                        *(u32x4*)(VCR + ((size_t)(blk - 17) * M + row) * 128 + c8) = raw;
                    } else {
                        const int i = wc * 4 + fq; const f32x4* tp = (const f32x4*)(tab128 + ((size_t)row * 64 + 4 * i) * 2);
                        bf16_t* base; float sc = 1.f;
                        if (blk <= 14) { base = QN + ((size_t)(blk - 7) * M + row) * 128; sc = C2N; }
                        else if (blk <= 16) base = KCR + ((size_t)(blk - 15) * M + row) * 128;
                        else if (blk <= 20) base = KS + ((size_t)(blk - 19) * M + row) * 128;
                        else base = KW + ((size_t)(blk - 21) * M + row) * 128;
                        u32x2 lo, hi; rope4(v0, v1, tp[0], tp[1], sc, lo, hi);
                        *(u32x2*)(base + 4 * i) = lo; *(u32x2*)(base + 64 + 4 * i) = hi;
                    }
                }
        }
    }
};
__device__ __forceinline__ float ssq_sum16(const float* p) { const f32x4 a = *(const f32x4*)p, b = *(const f32x4*)(p + 4), c = *(const f32x4*)(p + 8), d = *(const f32x4*)(p + 12);
    return ((a[0] + a[1]) + (a[2] + a[3])) + ((b[0] + b[1]) + (b[2] + b[3])) + ((c[0] + c[1]) + (c[2] + c[3])) + ((d[0] + d[1]) + (d[2] + d[3])); }
__device__ __forceinline__ float ssq_sum8(const float* p) { const f32x4 a = *(const f32x4*)p, b = *(const f32x4*)(p + 4);
    return ((a[0] + a[1]) + (a[2] + a[3])) + ((b[0] + b[1]) + (b[2] + b[3])); }
struct EpiQup {
    static constexpr bool PERM = true;
    bf16_t* QM; const float* SSQ; const float* tab64;
    __device__ __forceinline__ void operator()(const AccT& acc, const pg8::Unit& u, int wr, int wc, int fr, int fq) const {
        const int c8 = wc * 32 + fq * 8;
#pragma unroll
        for (int ai = 0; ai < 2; ++ai)
#pragma unroll
            for (int m = 0; m < 4; ++m) {
                const int row = u.pm * 256 + ai * 128 + wr * 64 + m * 16 + fr;
                const float rs = C2M / sqrtf(ssq_sum16(SSQ + (size_t)row * 24) * (1.f / 512.f) + RMS_EPS);
#pragma unroll
                for (int bj = 0; bj < 2; ++bj) {
                    const int blk = 2 * u.pn + bj;
                    const f32x4 v0 = acc[ai][bj][m][0] * rs, v1 = acc[ai][bj][m][1] * rs;
                    if (blk < 8) { u32x4 raw; raw.x = pk2(v0[0], v0[1]); raw.y = pk2(v0[2], v0[3]); raw.z = pk2(v1[0], v1[1]); raw.w = pk2(v1[2], v1[3]);
                        *(u32x4*)(QM + ((size_t)blk * M + row) * 192 + c8) = raw; }
                    else { const int head = 2 * (blk - 8) + (wc >> 1), i = (wc & 1) * 4 + fq; const f32x4* tp = (const f32x4*)(tab64 + ((size_t)row * 32 + 4 * i) * 2);
                        u32x2 lo, hi; rope4(v0, v1, tp[0], tp[1], 1.f, lo, hi);
                        bf16_t* base = QM + ((size_t)head * M + row) * 192 + 128;
                        *(u32x2*)(base + 4 * i) = lo; *(u32x2*)(base + 32 + 4 * i) = hi; }
                }
            }
    }
};
struct EpiKn {
    static constexpr bool PERM = true;
    bf16_t* KN; const float* SSQ;
    __device__ __forceinline__ void operator()(const AccT& acc, const pg8::Unit& u, int wr, int wc, int fr, int fq) const {
        const int c8 = wc * 32 + fq * 8;
#pragma unroll
        for (int ai = 0; ai < 2; ++ai)
#pragma unroll
            for (int m = 0; m < 4; ++m) {
                const int row = u.pm * 256 + ai * 128 + wr * 64 + m * 16 + fr;
                const float rs = 1.f / sqrtf(ssq_sum8(SSQ + (size_t)row * 24 + 16) * (1.f / 256.f) + RMS_EPS);
#pragma unroll
                for (int bj = 0; bj < 2; ++bj) {
                    const int blk = 2 * u.pn + bj;
                    const f32x4 v0 = acc[ai][bj][m][0] * rs, v1 = acc[ai][bj][m][1] * rs;
                    u32x4 raw; raw.x = pk2(v0[0], v0[1]); raw.y = pk2(v0[2], v0[3]); raw.z = pk2(v1[0], v1[1]); raw.w = pk2(v1[2], v1[3]);
                    *(u32x4*)(KN + ((size_t)blk * M + row) * 128 + c8) = raw;
                }
            }
    }
};
struct EpiColBf16 {
    static constexpr bool PERM = true;
    bf16_t* out; int ld; const float* SSQ;
    __device__ __forceinline__ void operator()(const AccT& acc, const pg8::Unit& u, int wr, int wc, int fr, int fq) const {
#pragma unroll
        for (int bj = 0; bj < 2; ++bj) {
            const int col = u.pn * 256 + bj * 128 + wc * 32 + fq * 8;
            float cs[8];
#pragma unroll
            for (int j = 0; j < 8; ++j) cs[j] = SSQ ? 1.f / sqrtf(ssq_sum8(SSQ + (size_t)(col + j) * 24 + 16) * (1.f / 256.f) + RMS_EPS) : 1.f;
#pragma unroll
            for (int ai = 0; ai < 2; ++ai)
#pragma unroll
                for (int m = 0; m < 4; ++m) {
                    const int row = u.pm * 256 + ai * 128 + wr * 64 + m * 16 + fr;
                    const f32x4 v0 = acc[ai][bj][m][0], v1 = acc[ai][bj][m][1];
                    u32x2 ra, rb; ra.x = pk2(v0[0] * cs[0], v0[1] * cs[1]); ra.y = pk2(v0[2] * cs[2], v0[3] * cs[3]); rb.x = pk2(v1[0] * cs[4], v1[1] * cs[5]); rb.y = pk2(v1[2] * cs[6], v1[3] * cs[7]);
                    bf16_t* gp = out + (size_t)row * ld + (col & ~15);
                    *(u32x2*)(gp + ((col & 8) ? 4 : 0)) = ra; *(u32x2*)(gp + ((col & 8) ? 12 : 8)) = rb;
                }
        }
    }
};

__device__ __forceinline__ int perm128_d(int p) { const int i = p >> 3, j = p & 7; return (j < 4) ? 4 * i + j : 64 + 4 * i + (j - 4); }
__device__ __forceinline__ int perm64_d(int p) { const int i = p >> 3, j = p & 7; return (j < 4) ? 4 * i + j : 32 + 4 * i + (j - 4); }
enum { MAP_PLAIN = 0, MAP_GU = 1, MAP_WIN = 2, MAP_WVN = 3, MAP_UQ = 4, MAP_UKV0 = 5, MAP_UKV1 = 6 };
template <int MODE> __device__ __forceinline__ int map_col(int n, int& which) {
    which = 0;
    if (MODE == MAP_PLAIN) return n;
    if (MODE == MAP_GU) { const int pn = n >> 8, r = n & 255; which = (r < 128) ? 0 : 1; return 128 * pn + (r & 127); }
    if (MODE == MAP_WIN) { const int blk = n >> 7, p = n & 127; int col = -1;
        if (blk < 4) col = 128 * blk + p;
        else if (blk < 6) col = 512 + 128 * (blk - 4) + p;
        else if (blk == 6) { if (p < 64) col = 768 + perm64_d(p); else if (p < 88) col = 3392 + (p - 64); }
        else if (blk <= 14) col = 832 + 128 * (blk - 7) + perm128_d(p);
        else if (blk <= 16) col = 1856 + 128 * (blk - 15) + perm128_d(p);
        else if (blk <= 18) col = 2112 + 128 * (blk - 17) + p;
        else if (blk <= 20) col = 2368 + 128 * (blk - 19) + perm128_d(p);
        else if (blk <= 22) col = 2880 + 128 * (blk - 21) + perm128_d(p);
        return col; }
    if (MODE == MAP_WVN) { const int blk = n >> 7, p = n & 127; return (blk < 2) ? 2624 + 128 * blk + p : 3136 + 128 * (blk - 2) + p; }
    if (MODE == MAP_UQ) { const int blk = n >> 7, p = n & 127; if (blk < 8) return 192 * blk + p; const int head = 2 * (blk - 8) + (p >> 6); return 192 * head + 128 + perm64_d(p & 63); }
    if (MODE == MAP_UKV0) return 256 * (n >> 7) + (n & 127);
    return 256 * (n >> 7) + 128 + (n & 127);
}
template <int MODE>
__device__ __forceinline__ void transpose_job(const float* src0, const float* src1, int ld, const float* ks, int K, int NR, bf16_t* WT, LAS float* scr, int gw, int NGW, int lane) {
    const int nblk = NR / 32, items = (K / 64) * nblk;
    for (int it = gw; it < items; it += 2 * NGW) {
        const int it2 = it + NGW; const bool has2 = it2 < items;
        const int kbA = it / nblk, nbA = it % nblk, k0A = 64 * kbA, n0A = 32 * nbA;
        const int itb = has2 ? it2 : it; const int kbB = itb / nblk, nbB = itb % nblk, k0B = 64 * kbB, n0B = 32 * nbB;
        int whichA, whichB; const int colA = map_col<MODE>(n0A + (lane & 31), whichA), colB = map_col<MODE>(n0B + (lane & 31), whichB);
        const float* spA = (whichA ? src1 : src0) + (colA >= 0 ? colA : 0); const float* spB = (whichB ? src1 : src0) + (colB >= 0 ? colB : 0);
        float va[32], vb[32];
#pragma unroll
        for (int i = 0; i < 32; ++i) { const int kk = 2 * i + (lane >> 5); va[i] = spA[(size_t)(k0A + kk) * ld]; }
#pragma unroll
        for (int i = 0; i < 32; ++i) { const int kk = 2 * i + (lane >> 5); vb[i] = spB[(size_t)(k0B + kk) * ld]; }
#pragma unroll
        for (int i = 0; i < 32; ++i) { const int kk = 2 * i + (lane >> 5); float v = va[i]; if (ks) v *= ks[k0A + kk]; if (colA < 0) v = 0.f; scr[kk * 33 + (lane & 31)] = v; }
#pragma unroll
        for (int i = 0; i < 32; ++i) { const int kk = 2 * i + (lane >> 5); float v = vb[i]; if (ks) v *= ks[k0B + kk]; if (colB < 0) v = 0.f; scr[2112 + kk * 33 + (lane & 31)] = v; }
        asm volatile("s_waitcnt lgkmcnt(0)" ::: "memory");
        const int c = lane & 7;
#pragma unroll
        for (int j = 0; j < 4; ++j) { const int n = (lane >> 3) + 8 * j; const LAS float* s = scr + (8 * c) * 33 + n;
            u32x4 o; o.x = pk2(s[0 * 33], s[1 * 33]); o.y = pk2(s[2 * 33], s[3 * 33]); o.z = pk2(s[4 * 33], s[5 * 33]); o.w = pk2(s[6 * 33], s[7 * 33]);
            *(u32x4*)(WT + (size_t)(n0A + n) * K + k0A + 8 * c) = o; }
        if (has2) {
#pragma unroll
            for (int j = 0; j < 4; ++j) { const int n = (lane >> 3) + 8 * j; const LAS float* s = scr + 2112 + (8 * c) * 33 + n;
                u32x4 o; o.x = pk2(s[0 * 33], s[1 * 33]); o.y = pk2(s[2 * 33], s[3 * 33]); o.z = pk2(s[4 * 33], s[5 * 33]); o.w = pk2(s[6 * 33], s[7 * 33]);
                *(u32x4*)(WT + (size_t)(n0B + n) * K + k0B + 8 * c) = o; } }
        asm volatile("s_waitcnt lgkmcnt(0)" ::: "memory");
    }
}

__device__ __forceinline__ void ln_row(const float* xin, float* xout, bf16_t* xb, const f32x4 (&gq)[8], const f32x4 (&bq)[8], int lane) {
    const f32x4* xr = (const f32x4*)xin + lane;
    f32x4 v[8]; float s = 0.f;
#pragma unroll
    for (int j = 0; j < 8; ++j) { v[j] = xr[64 * j]; s += (v[j][0] + v[j][1]) + (v[j][2] + v[j][3]); }
    const float mean = wave_sum(s) * (1.f / DM); float s2 = 0.f;
#pragma unroll
    for (int j = 0; j < 8; ++j) { v[j] = v[j] - mean; s2 += (v[j][0] * v[j][0] + v[j][1] * v[j][1]) + (v[j][2] * v[j][2] + v[j][3] * v[j][3]); }
    const float rstd = 1.f / sqrtf(wave_sum(s2) * (1.f / DM) + LN_EPS);
#pragma unroll
    for (int j = 0; j < 8; ++j) { const f32x4 gg = gq[j], bb = bq[j];
        const f32x4 y = v[j] * rstd * gg + bb;
        ((f32x4*)xout)[64 * j + lane] = y;
        if (xb) { u32x2 w; w.x = pk2(y[0], y[1]); w.y = pk2(y[2], y[3]); ((u32x2*)xb)[64 * j + lane] = w; } }
}

__device__ __forceinline__ void ln_load_gb(f32x4 (&gq)[8], f32x4 (&bq)[8], const float* g, const float* b, int lane) {
#pragma unroll
    for (int j = 0; j < 4; ++j) { const int e0 = 8 * lane + 512 * j; gq[2 * j] = *(const f32x4*)(g + e0); gq[2 * j + 1] = *(const f32x4*)(g + e0 + 4); bq[2 * j] = *(const f32x4*)(b + e0); bq[2 * j + 1] = *(const f32x4*)(b + e0 + 4); }
}
template <bool OUT_F32>
__device__ __forceinline__ void ln_row_b(const u32x4 (&xw)[4], void* xout, const f32x4 (&gq)[8], const f32x4 (&bq)[8], int lane) {
    float v[32]; float s = 0.f;
#pragma unroll
    for (int j = 0; j < 4; ++j) { const u32x4 w = xw[j];
        v[8 * j + 0] = __uint_as_float(w.x << 16); v[8 * j + 1] = __uint_as_float(w.x & 0xffff0000u); v[8 * j + 2] = __uint_as_float(w.y << 16); v[8 * j + 3] = __uint_as_float(w.y & 0xffff0000u);
        v[8 * j + 4] = __uint_as_float(w.z << 16); v[8 * j + 5] = __uint_as_float(w.z & 0xffff0000u); v[8 * j + 6] = __uint_as_float(w.w << 16); v[8 * j + 7] = __uint_as_float(w.w & 0xffff0000u); }
#pragma unroll
    for (int i = 0; i < 32; ++i) s += v[i];
    const float mean = wave_sum(s) * (1.f / DM); float s2 = 0.f;
#pragma unroll
    for (int i = 0; i < 32; ++i) { v[i] -= mean; s2 += v[i] * v[i]; }
    const float rstd = 1.f / sqrtf(wave_sum(s2) * (1.f / DM) + LN_EPS);
#pragma unroll
    for (int j = 0; j < 4; ++j) { const int e0 = 8 * lane + 512 * j;
        const f32x4 g0 = gq[2 * j], g1 = gq[2 * j + 1], b0 = bq[2 * j], b1 = bq[2 * j + 1];
        float y[8];
#pragma unroll
        for (int k = 0; k < 4; ++k) { y[k] = v[8 * j + k] * rstd * g0[k] + b0[k]; y[4 + k] = v[8 * j + 4 + k] * rstd * g1[k] + b1[k]; }
        if (OUT_F32) { *(f32x4*)((float*)xout + e0) = (f32x4){y[0], y[1], y[2], y[3]}; *(f32x4*)((float*)xout + e0 + 4) = (f32x4){y[4], y[5], y[6], y[7]}; }
        else { u32x4 w; w.x = pk2(y[0], y[1]); w.y = pk2(y[2], y[3]); w.z = pk2(y[4], y[5]); w.w = pk2(y[6], y[7]); *(u32x4*)((bf16_t*)xout + e0) = w; } }
}
__device__ __forceinline__ int crow(int r, int hi) { return (r & 3) + 8 * (r >> 2) + 4 * hi; }
constexpr int VRS = 144;

struct TileSrc { const GAS bf16_t* K; const GAS bf16_t* KX; const GAS bf16_t* VT; int ldv; };

template <int KRS, bool HAS_X>
struct TileRegs { u32x4 k0, k1, kx, v0, v1; };

template <int KRS, bool HAS_X>
__device__ __forceinline__ void tile_load(TileRegs<KRS, HAS_X>& R, const TileSrc& s, int t, int tid) {
    const GAS bf16_t* kp = s.K + (size_t)t * 64 * 128 + tid * 8;
    R.k0 = *(const GAS u32x4*)kp; R.k1 = *(const GAS u32x4*)(kp + 4096);
    if (HAS_X) R.kx = *(const GAS u32x4*)(s.KX + (size_t)t * 64 * 64 + tid * 8);
    const int d = tid >> 3, ch = tid & 7;
    const GAS bf16_t* vp = s.VT + (size_t)d * s.ldv + t * 64 + ch * 8;
    R.v0 = *(const GAS u32x4*)vp; R.v1 = *(const GAS u32x4*)(vp + (size_t)64 * s.ldv);
}
template <int KRS, bool HAS_X>
__device__ __forceinline__ void tile_store(const TileRegs<KRS, HAS_X>& R, LAS unsigned char* buf, int tid) {
    { const int row = tid >> 4, col = tid & 15; *(LAS u32x4*)(buf + row * KRS + col * 16) = R.k0; *(LAS u32x4*)(buf + (row + 32) * KRS + col * 16) = R.k1; }
    if (HAS_X) { const int row = tid >> 3, col = tid & 7; *(LAS u32x4*)(buf + row * KRS + 256 + col * 16) = R.kx; }
    { const int d = tid >> 3, ch = tid & 7; LAS unsigned char* vb = buf + 64 * KRS + d * VRS + ch * 16;
      *(LAS u32x4*)(vb) = R.v0; *(LAS u32x4*)(vb + 64 * VRS) = R.v1; }
}
template <int KRS, bool HAS_X, bool MIDSTORE, class Body>
__device__ __forceinline__ void flash_loop(LAS unsigned char* lds, const TileSrc& src, int tb, int te, int tid, Body&& body) {
    constexpr int BUFB = 64 * KRS + 128 * VRS;
    if (tb >= te) return;
    TileRegs<KRS, HAS_X> R;
    tile_load<KRS, HAS_X>(R, src, tb, tid); tile_store<KRS, HAS_X>(R, lds, tid);
    if (tb + 1 < te) tile_load<KRS, HAS_X>(R, src, tb + 1, tid);
    __syncthreads();
    for (int t = tb; t < te; ++t) {
        const int cur = (t - tb) & 1;
        if (t + 1 < te) tile_store<KRS, HAS_X>(R, lds + (cur ^ 1) * BUFB, tid);
        if (t + 2 < te) tile_load<KRS, HAS_X>(R, src, t + 2, tid);
        body(t, (const LAS unsigned char*)(lds + cur * BUFB), []() __attribute__((always_inline)) {});
        __syncthreads();
    }
}
template <int NKS, int KRS>
__device__ __forceinline__ void qk_tile(f32x16& p0, f32x16& p1, const LAS unsigned char* Kt, const bf16x8 (&qf)[NKS], int r32, int hi) {
    const LAS unsigned char* kb = Kt + r32 * KRS + hi * 16;
#pragma unroll
    for (int r = 0; r < 16; ++r) { p0[r] = 0.f; p1[r] = 0.f; }
    bf16x8 a0[3], a1[3];
    a0[0] = *(const LAS bf16x8*)(kb); a1[0] = *(const LAS bf16x8*)(kb + 32 * KRS);
    a0[1] = *(const LAS bf16x8*)(kb + 32); a1[1] = *(const LAS bf16x8*)(kb + 32 * KRS + 32);
    __builtin_amdgcn_sched_barrier(0);
#pragma unroll
    for (int ks = 0; ks < NKS; ++ks) {
        if (ks + 2 < NKS) { a0[(ks + 2) % 3] = *(const LAS bf16x8*)(kb + (ks + 2) * 32); a1[(ks + 2) % 3] = *(const LAS bf16x8*)(kb + 32 * KRS + (ks + 2) * 32); }
        p0 = __builtin_amdgcn_mfma_f32_32x32x16_bf16(a0[ks % 3], qf[ks], p0, 0, 0, 0);
        p1 = __builtin_amdgcn_mfma_f32_32x32x16_bf16(a1[ks % 3], qf[ks], p1, 0, 0, 0);
        __builtin_amdgcn_sched_barrier(0);
    }
}
__device__ __forceinline__ void pv_tile(f32x16 (&o)[4], const f32x16& p0, const f32x16& p1, const LAS unsigned char* Vt, int r32, int hi) {
    bf16x8 pa[4];
#pragma unroll
    for (int s = 0; s < 4; ++s) { const int b = 8 * (s & 1); u32x4 w;
        if (s < 2) { w.x = pk2(p0[b], p0[b + 1]); w.y = pk2(p0[b + 2], p0[b + 3]); w.z = pk2(p0[b + 4], p0[b + 5]); w.w = pk2(p0[b + 6], p0[b + 7]); }
        else { w.x = pk2(p1[b], p1[b + 1]); w.y = pk2(p1[b + 2], p1[b + 3]); w.z = pk2(p1[b + 4], p1[b + 5]); w.w = pk2(p1[b + 6], p1[b + 7]); }
        pa[s] = __builtin_bit_cast(bf16x8, w); }
    const LAS unsigned char* vb2 = Vt + r32 * VRS + hi * 16;
    bf16x8 vf[4];
#define PV_LD(i_) do { vf[(i_) & 3] = *(const LAS bf16x8*)(vb2 + ((i_) & 3) * 32 * VRS + ((i_) >> 2) * 32); } while (0)
    PV_LD(0); PV_LD(1); PV_LD(2);
    __builtin_amdgcn_sched_barrier(0);
#pragma unroll
    for (int i = 0; i < 16; ++i) {
        if (i + 3 < 16) PV_LD(i + 3);
        o[i & 3] = __builtin_amdgcn_mfma_f32_32x32x16_bf16(pa[i >> 2], vf[i & 3], o[i & 3], 0, 0, 0);
        __builtin_amdgcn_sched_barrier(0);
    }
#undef PV_LD
}
template <bool WITH_O>
__device__ __forceinline__ void softmax_step(float& m, float& l, f32x16 (&o)[4], f32x16& p0, f32x16& p1, LAS float* wsf, int r32, int hi) {
    float mx = fmaxf(p0[0], p1[0]);
#pragma unroll
    for (int r = 1; r < 16; ++r) mx = fmaxf(mx, fmaxf(p0[r], p1[r]));
    mx = fmaxf(mx, __shfl_xor(mx, 32));
    const bool grow = __any(mx > m + 8.f);
    const float mnew = grow ? fmaxf(m, mx) : m;
    const float f = grow ? __builtin_amdgcn_exp2f(m - mnew) : 1.f;
    m = mnew;
    float s = 0.f;
#pragma unroll
    for (int r = 0; r < 16; ++r) { p0[r] = __builtin_amdgcn_exp2f(p0[r] - mnew); p1[r] = __builtin_amdgcn_exp2f(p1[r] - mnew); s += p0[r] + p1[r]; }
    l = l * f + s;
    if (WITH_O) {
        if (grow) {
            if (hi == 0) wsf[r32] = f;
            asm volatile("s_waitcnt lgkmcnt(0)" ::: "memory");
#pragma unroll
            for (int r = 0; r < 16; ++r) { const float fr = wsf[crow(r, hi)];
#pragma unroll
                for (int db = 0; db < 4; ++db) o[db][r] *= fr; }
        }
    }
}
__device__ __forceinline__ void row_factors(float (&fr)[16], float fac, LAS float* wsf, int r32, int hi) {
    if (hi == 0) wsf[r32] = fac;
    asm volatile("s_waitcnt lgkmcnt(0)" ::: "memory");
#pragma unroll
    for (int r = 0; r < 16; ++r) fr[r] = wsf[crow(r, hi)];
    asm volatile("s_waitcnt lgkmcnt(0)" ::: "memory");
}

constexpr int KRS_MLA = 400, KRS_NSA = 272;
struct AttnPtrs { unsigned char* ws; const float* gate_b; };
#define OPQ_WS(name) GAS unsigned char* name = (GAS unsigned char*)P.ws; asm volatile("" : "+s"(name))
#define WSP(T, base, off) ((GAS T*)((base) + (off)))

__device__ __forceinline__ void mla_unit(int h, int qb, LAS unsigned char* lds, LAS float* wsf, const AttnPtrs& P) {
    int tid = threadIdx.x; asm volatile("" : "+v"(tid)); const int lane = tid & 63, w = __builtin_amdgcn_readfirstlane(tid >> 6), r32 = lane & 31, hi = lane >> 5;
    const int qrow = qb * 256 + w * 32 + r32;
    bf16x8 qf[12];
    OPQ_WS(wsl);
    { const GAS bf16_t* qp = WSP(const bf16_t, wsl, WS_QM) + ((size_t)h * M + qrow) * 192 + 8 * hi;
#pragma unroll
      for (int ks = 0; ks < 12; ++ks) qf[ks] = *(const GAS bf16x8*)(qp + 16 * ks); }
    asm volatile("s_waitcnt vmcnt(0)" ::: "memory");
#pragma unroll
    for (int ks = 0; ks < 12; ++ks) asm volatile("" : "+v"(qf[ks]));
    float m = -1e30f, l = 0.f; f32x16 o[4];
#pragma unroll
    for (int db = 0; db < 4; ++db)
#pragma unroll
        for (int r = 0; r < 16; ++r) o[db][r] = 0.f;
    TileSrc src{WSP(const bf16_t, wsl, WS_KN) + (size_t)h * M * 128, WSP(const bf16_t, wsl, WS_KR), WSP(const bf16_t, wsl, WS_VT) + (size_t)h * 128 * M, M};
    const int qmin = qb * 256 + w * 32;
    flash_loop<KRS_MLA, true, true>(lds, src, 0, 4 * qb + 4, tid, [&](int t, const LAS unsigned char* buf, auto&& mid) __attribute__((always_inline)) {
        const bool act = 64 * t <= qmin + 31;
        f32x16 p0, p1;
        if (act) {
            qk_tile<12, KRS_MLA>(p0, p1, buf, qf, r32, hi);
            if (64 * t + 63 > qmin) {
#pragma unroll
                for (int r = 0; r < 16; ++r) { const int key = 64 * t + crow(r, hi); if (key > qrow) p0[r] = -INFINITY; if (key + 32 > qrow) p1[r] = -INFINITY; }
            }
            softmax_step<true>(m, l, o, p0, p1, wsf, r32, hi);
        }
        mid();
        if (act) pv_tile(o, p0, p1, buf + 64 * KRS_MLA, r32, hi);
    });
    const float lt = l + __shfl_xor(l, 32);
    float fr[16]; row_factors(fr, 1.f / fmaxf(lt, 1e-30f), wsf, r32, hi);
    OPQ_WS(wso);
#pragma unroll
    for (int r = 0; r < 16; ++r) { GAS bf16_t* op = WSP(bf16_t, wso, WS_XB) + (size_t)(qb * 256 + w * 32 + crow(r, hi)) * DM + h * 128 + r32;
#pragma unroll
        for (int db = 0; db < 4; ++db) op[32 * db] = (bf16_t)(pk2(o[db][r] * fr[r], 0.f) & 0xffffu); }
}

constexpr int IMP_OFF = 2 * (64 * KRS_NSA + 128 * VRS);
constexpr int IMP_RS = 257;
constexpr int SEL_OFF = IMP_OFF + 64 * IMP_RS * 4;
constexpr int UNI_OFF = SEL_OFF + 64 * 8 * 4;
constexpr int WSF_OFF = 143360;

__device__ __forceinline__ unsigned range_mask(int lo, int hi, int k) {
    const int a = lo > 32 * k ? lo : 32 * k, b = hi < 32 * k + 31 ? hi : 32 * k + 31;
    if (a > b) return 0u; const int n = b - a + 1; const unsigned mk = (n >= 32) ? 0xffffffffu : ((1u << n) - 1u); return mk << (a - 32 * k);
}
template <int MODE>
__device__ __forceinline__ void nsa_finish(const f32x16 (&o)[4], float fac, LAS float* wsf, unsigned char* wsb0, int t0, int w, int hk, int tid, int r32, int hi) {
    float fr[16]; row_factors(fr, fac, wsf, r32, hi);
    GAS unsigned char* wsb = (GAS unsigned char*)wsb0; asm volatile("" : "+s"(wsb));
    GAS f32x4* ap = (GAS f32x4*)(WSP(float, wsb, WS_OACC) + (size_t)blockIdx.x * 32768 + (size_t)tid * 64);
    GAS bf16_t* OMIX = WSP(bf16_t, wsb, WS_XB);
#pragma unroll
    for (int db = 0; db < 4; ++db) {
#pragma unroll
        for (int r4 = 0; r4 < 4; ++r4) {
            f32x4 v = {o[db][4 * r4] * fr[4 * r4], o[db][4 * r4 + 1] * fr[4 * r4 + 1], o[db][4 * r4 + 2] * fr[4 * r4 + 2], o[db][4 * r4 + 3] * fr[4 * r4 + 3]};
            if (MODE >= 1) v += ap[db * 4 + r4];
            if (MODE <= 1) ap[db * 4 + r4] = v;
            else {
#pragma unroll
                for (int k = 0; k < 4; ++k) { const int row = crow(4 * r4 + k, hi), tok = t0 + 8 * w + (row >> 2), head = 4 * hk + (row & 3);
                    OMIX[(size_t)tok * DM + 1024 + head * 128 + 32 * db + r32] = (bf16_t)(pk2(v[k], 0.f) & 0xffffu); }
            }
        }
        asm volatile("" ::: "memory");
    }
}
__device__ __forceinline__ float gate_val(const AttnPtrs& P, int tok, int br, int head) {
    OPQ_WS(wsg);
    const float x = bf2f(WSP(const bf16_t, wsg, WS_GL)[(size_t)tok * 32 + br * 8 + head]) + P.gate_b[br * 8 + head];
    return 1.f / (1.f + __builtin_amdgcn_exp2f(-x * 1.4426950408889634f));
}

__device__ __forceinline__ void nsa_unit(int hk, int T, LAS unsigned char* lds, LAS float* wsf, const AttnPtrs& P) {
    int tid = threadIdx.x; asm volatile("" : "+v"(tid)); const int lane = tid & 63, w = __builtin_amdgcn_readfirstlane(tid >> 6), r32 = lane & 31, hi = lane >> 5;
    const int t0 = 64 * T, qi = r32 >> 2, g = r32 & 3, tq = t0 + 8 * w + qi, head = 4 * hk + g;
    LAS float* imp = (LAS float*)(lds + IMP_OFF);
    LAS unsigned* sel = (LAS unsigned*)(lds + SEL_OFF);
    LAS unsigned* uni = (LAS unsigned*)(lds + UNI_OFF);
    bf16x8 qf[8];
    { OPQ_WS(wsq); const GAS bf16_t* qp = WSP(const bf16_t, wsq, WS_QN) + ((size_t)head * M + tq) * 128 + 8 * hi;
#pragma unroll
      for (int ks = 0; ks < 8; ++ks) qf[ks] = *(const GAS bf16x8*)(qp + 16 * ks); }
    asm volatile("s_waitcnt vmcnt(0)" ::: "memory");
#pragma unroll
    for (int ks = 0; ks < 8; ++ks) asm volatile("" : "+v"(qf[ks]));
    const float gate_c = gate_val(P, tq, 0, head), gate_s = gate_val(P, tq, 1, head), gate_w = gate_val(P, tq, 2, head);
    f32x16 o[4];
#define ZERO_O() do { _Pragma("unroll") for (int db = 0; db < 4; ++db) _Pragma("unroll") for (int r = 0; r < 16; ++r) o[db][r] = 0.f; } while (0)
    const int cmaxT = (t0 + 63 >= 31) ? ((t0 + 63 - 31) >> 4) : -1;
    const int NTc = cmaxT >= 0 ? (cmaxT >> 6) + 1 : 0;
    const int mycmax = (tq >= 31) ? ((tq - 31) >> 4) : -1;
    OPQ_WS(wsc);
    TileSrc csrc{WSP(const bf16_t, wsc, WS_KC) + (size_t)hk * 1024 * 128, nullptr, WSP(const bf16_t, wsc, WS_KC) + 2 * 1024 * 128 + (size_t)hk * 128 * 1024, 1024};
    float m = -1e30f, l = 0.f;
    flash_loop<KRS_NSA, false, false>(lds, csrc, 0, NTc, tid, [&](int t, const LAS unsigned char* buf, auto&& mid) __attribute__((always_inline)) {
        f32x16 p0, p1;
        qk_tile<8, KRS_NSA>(p0, p1, buf, qf, r32, hi);
#pragma unroll
        for (int r = 0; r < 16; ++r) { const int c = 64 * t + crow(r, hi); if (c > mycmax) p0[r] = -INFINITY; if (c + 32 > mycmax) p1[r] = -INFINITY; }
        softmax_step<false>(m, l, o, p0, p1, wsf, r32, hi);
    });
    const float invl = 1.f / fmaxf(l + __shfl_xor(l, 32), 1e-30f);
    for (int i = tid; i < 64 * IMP_RS; i += NTHREADS) imp[i] = 0.f;
    __syncthreads();
    ZERO_O();
    flash_loop<KRS_NSA, false, false>(lds, csrc, 0, NTc, tid, [&](int t, const LAS unsigned char* buf, auto&& mid) __attribute__((always_inline)) {
        f32x16 p0, p1;
        qk_tile<8, KRS_NSA>(p0, p1, buf, qf, r32, hi);
#pragma unroll
        for (int r = 0; r < 16; ++r) { const int c = 64 * t + crow(r, hi);
            p0[r] = (c > mycmax) ? 0.f : __builtin_amdgcn_exp2f(p0[r] - m) * invl;
            p1[r] = (c + 32 > mycmax) ? 0.f : __builtin_amdgcn_exp2f(p1[r] - m) * invl; }
        float A[8], B[8];
#pragma unroll
        for (int a = 0; a < 4; ++a) {
            A[a] = 2.f * (p0[4 * a] + p0[4 * a + 1] + p0[4 * a + 2]) + p0[4 * a + 3]; B[a] = p0[4 * a + 3];
            A[4 + a] = 2.f * (p1[4 * a] + p1[4 * a + 1] + p1[4 * a + 2]) + p1[4 * a + 3]; B[4 + a] = p1[4 * a + 3]; }
#pragma unroll
        for (int a = 0; a < 8; ++a) {
            A[a] += __int_as_float(__builtin_amdgcn_mov_dpp(__float_as_int(A[a]), 0xB1, 0xF, 0xF, true)); A[a] += __int_as_float(__builtin_amdgcn_mov_dpp(__float_as_int(A[a]), 0x4E, 0xF, 0xF, true));
            B[a] += __int_as_float(__builtin_amdgcn_mov_dpp(__float_as_int(B[a]), 0xB1, 0xF, 0xF, true)); B[a] += __int_as_float(__builtin_amdgcn_mov_dpp(__float_as_int(B[a]), 0x4E, 0xF, 0xF, true)); }
        LAS float* ir = imp + (8 * w + qi) * IMP_RS + 16 * t + hi;
        if (g == 0) {
#pragma unroll
            for (int a = 0; a < 8; ++a) ir[2 * (a & 3) + 8 * (a >> 2)] += A[a];
        }
        asm volatile("s_waitcnt lgkmcnt(0)" ::: "memory");
        if (g == 0) {
#pragma unroll
            for (int a = 0; a < 8; ++a) ir[2 * (a & 3) + 8 * (a >> 2) + 1] += B[a];
        }
        asm volatile("s_waitcnt lgkmcnt(0)" ::: "memory");
        pv_tile(o, p0, p1, buf + 64 * KRS_NSA, r32, hi);
    });
    nsa_finish<0>(o, gate_c, wsf, P.ws, t0, w, hk, tid, r32, hi);
    {
        const int nforced = (T == 0) ? 1 : (T == 1) ? 2 : 3, npick = 16 - nforced, ncand = T - 2 > 0 ? T - 2 : 0;
        unsigned uniword = 0u;
        for (int q = 0; q < 8; ++q) {
            unsigned myword = 0u;
            if (lane < 8) { myword = range_mask(0, 0, lane) | range_mask(T, T, lane); if (T >= 1) myword |= range_mask(T - 1, T - 1, lane); }
            if (ncand <= npick) { if (lane < 8 && ncand > 0) myword |= range_mask(1, T - 2, lane); }
            else {
                const LAS float* irow = imp + (8 * w + q) * IMP_RS;
                unsigned k0 = 0u, k1 = 0u, k2 = 0u, k3 = 0u;
                { int j = lane; if (j >= 1 && j <= T - 2) k0 = __float_as_uint(irow[j]) + 1u; j += 64; if (j <= T - 2) k1 = __float_as_uint(irow[j]) + 1u;
                  j += 64; if (j <= T - 2) k2 = __float_as_uint(irow[j]) + 1u; j += 64; if (j <= T - 2) k3 = __float_as_uint(irow[j]) + 1u; }
                unsigned prefix = 0u;
                for (int bit = 31; bit >= 0; --bit) {
                    const unsigned cand = prefix | (1u << bit);
                    const int cnt = __popcll(__ballot(k0 >= cand)) + __popcll(__ballot(k1 >= cand)) + __popcll(__ballot(k2 >= cand)) + __popcll(__ballot(k3 >= cand));
                    if (cnt >= npick) prefix = cand;
                }
                const unsigned long long g0 = __ballot(k0 > prefix), g1 = __ballot(k1 > prefix), g2 = __ballot(k2 > prefix), g3 = __ballot(k3 > prefix);
                const unsigned long long e0 = __ballot(k0 == prefix), e1 = __ballot(k1 == prefix), e2 = __ballot(k2 == prefix), e3 = __ballot(k3 == prefix);
                const int need = npick - (__popcll(g0) + __popcll(g1) + __popcll(g2) + __popcll(g3));
                const unsigned long long ltm = (lane == 0) ? 0ull : ((~0ull) >> (64 - lane));
                int base = 0;
                const bool c0 = ((e0 >> lane) & 1ull) && (base + __popcll(e0 & ltm) < need); base += __popcll(e0);
                const bool c1 = ((e1 >> lane) & 1ull) && (base + __popcll(e1 & ltm) < need); base += __popcll(e1);
                const bool c2 = ((e2 >> lane) & 1ull) && (base + __popcll(e2 & ltm) < need); base += __popcll(e2);
                const bool c3 = ((e3 >> lane) & 1ull) && (base + __popcll(e3 & ltm) < need);
                const unsigned long long s0 = g0 | __ballot(c0), s1 = g1 | __ballot(c1), s2 = g2 | __ballot(c2), s3 = g3 | __ballot(c3);
                const unsigned long long sm = (lane >> 1) == 0 ? s0 : (lane >> 1) == 1 ? s1 : (lane >> 1) == 2 ? s2 : s3;
                if (lane < 8) myword |= (lane & 1) ? (unsigned)(sm >> 32) : (unsigned)sm;
            }
            if (lane < 8) { sel[(8 * w + q) * 8 + lane] = myword; uniword |= myword; }
        }
        if (lane < 8) uni[w * 8 + lane] = uniword;
        asm volatile("s_waitcnt lgkmcnt(0)" ::: "memory");
    }
    {
        OPQ_WS(wss);
        TileSrc ssrc{WSP(const bf16_t, wss, WS_KS) + (size_t)hk * M * 128, nullptr, WSP(const bf16_t, wss, WS_VTN) + (size_t)(hk * 128) * M, M};
        m = -1e30f; l = 0.f; ZERO_O();
        flash_loop<KRS_NSA, false, true>(lds, ssrc, 0, T + 1, tid, [&](int j, const LAS unsigned char* buf, auto&& mid) __attribute__((always_inline)) {
            const unsigned uw = __builtin_amdgcn_readfirstlane(uni[w * 8 + (j >> 5)]);
            const bool act = ((uw >> (j & 31)) & 1u) != 0u;
            f32x16 p0, p1;
            if (act) {
                qk_tile<8, KRS_NSA>(p0, p1, buf, qf, r32, hi);
                const unsigned mw = sel[(8 * w + qi) * 8 + (j >> 5)];
                const bool mine = (mw >> (j & 31)) & 1u;
#pragma unroll
                for (int r = 0; r < 16; ++r) { const int key = 64 * j + crow(r, hi);
                    if (!mine || key > tq) p0[r] = -INFINITY; if (!mine || key + 32 > tq) p1[r] = -INFINITY; }
                softmax_step<true>(m, l, o, p0, p1, wsf, r32, hi);
            }
            mid();
            if (act) pv_tile(o, p0, p1, buf + 64 * KRS_NSA, r32, hi);
        });
        const float lt = l + __shfl_xor(l, 32);
        nsa_finish<1>(o, gate_s / fmaxf(lt, 1e-30f), wsf, P.ws, t0, w, hk, tid, r32, hi);
    }
    {
        OPQ_WS(wsw);
        TileSrc wsrc{WSP(const bf16_t, wsw, WS_KW) + (size_t)hk * M * 128, nullptr, WSP(const bf16_t, wsw, WS_VTN) + (size_t)(256 + hk * 128) * M, M};
        m = -1e30f; l = 0.f; ZERO_O();
        flash_loop<KRS_NSA, false, true>(lds, wsrc, T >= 8 ? T - 8 : 0, T + 1, tid, [&](int j, const LAS unsigned char* buf, auto&& mid) __attribute__((always_inline)) {
            f32x16 p0, p1;
            qk_tile<8, KRS_NSA>(p0, p1, buf, qf, r32, hi);
            if (j == T || j == T - 8) {
#pragma unroll
                for (int r = 0; r < 16; ++r) { const int key = 64 * j + crow(r, hi);
                    if (key > tq || key <= tq - 512) p0[r] = -INFINITY; if (key + 32 > tq || key + 32 <= tq - 512) p1[r] = -INFINITY; }
            }
            softmax_step<true>(m, l, o, p0, p1, wsf, r32, hi);
            mid();
            pv_tile(o, p0, p1, buf + 64 * KRS_NSA, r32, hi);
        });
        const float lt = l + __shfl_xor(l, 32);
        nsa_finish<2>(o, gate_w / fmaxf(lt, 1e-30f), wsf, P.ws, t0, w, hk, tid, r32, hi);
    }
#undef ZERO_O
}

struct Args { const float* in[26]; float* out; unsigned char* ws; int ph_lo, ph_hi; };
constexpr int N_PHASES = 13;
#ifndef PROBE_REP7
#define PROBE_REP7 1
#endif
#ifndef PROBE_REP1
#define PROBE_REP1 1
#endif

__global__ void __launch_bounds__(NTHREADS) mega_fwd(Args args) {
    extern __shared__ __attribute__((aligned(16))) unsigned char lds_raw[];
    LAS unsigned char* lds = (LAS unsigned char*)lds_raw;
    cg::grid_group grid = cg::this_grid();
    const int G = gridDim.x, bx = blockIdx.x;
#define PHASE_IDS int tid = threadIdx.x; asm volatile("" : "+v"(tid)); const int lane = tid & 63, wave = __builtin_amdgcn_readfirstlane(tid >> 6); \
    const int gw = bx * NWAVES + wave, NGW = G * NWAVES; const int gtid = bx * NTHREADS + tid, NGT = G * NTHREADS; LAS float* scr = (LAS float*)(lds + wave * 17408); \
    (void)lane; (void)gw; (void)NGW; (void)gtid; (void)NGT; (void)scr
    unsigned char* ws = args.ws;
    float* out = args.out;
    bf16_t* WGU = (bf16_t*)(ws + WS_WGU); bf16_t* WD = (bf16_t*)(ws + WS_WD); bf16_t* WIN = (bf16_t*)(ws + WS_WIN); bf16_t* WVN = (bf16_t*)(ws + WS_WVN);
    bf16_t* WUQ = (bf16_t*)(ws + WS_WUQ); bf16_t* WKN = (bf16_t*)(ws + WS_WKN); bf16_t* WVM = (bf16_t*)(ws + WS_WVM); bf16_t* W1K = (bf16_t*)(ws + WS_W1K);
    bf16_t* W1V = (bf16_t*)(ws + WS_W1V); bf16_t* WOUT = (bf16_t*)(ws + WS_WOUT);
    float* TAB128 = (float*)(ws + WS_TAB128); float* TAB64 = (float*)(ws + WS_TAB64); float* SSQ = (float*)(ws + WS_SSQ); float* CBIAS = (float*)(ws + WS_MISC);
    float* HCP = (float*)(ws + WS_HCP); bf16_t* KC = (bf16_t*)(ws + WS_KC); bf16_t* VCT = KC + 2 * 1024 * 128;
    bf16_t* XB = (bf16_t*)(ws + WS_XB); bf16_t* H = (bf16_t*)(ws + WS_H);
    float* PRE3 = (float*)(ws + 384 * MiB);
    bf16_t* D0 = (bf16_t*)out; bf16_t* D1 = D0 + (size_t)M * DM;
    bf16_t* CQ = (bf16_t*)(ws + WS_CQ); bf16_t* CKV = (bf16_t*)(ws + WS_CKV); bf16_t* KR = (bf16_t*)(ws + WS_KR); bf16_t* GL = (bf16_t*)(ws + WS_GL);
    bf16_t* QN = (bf16_t*)(ws + WS_QN); bf16_t* KCR = (bf16_t*)(ws + WS_KCR); bf16_t* VCR = (bf16_t*)(ws + WS_VCR); bf16_t* KS = (bf16_t*)(ws + WS_KS);
    bf16_t* KW = (bf16_t*)(ws + WS_KW); bf16_t* VTN = (bf16_t*)(ws + WS_VTN); bf16_t* QM = (bf16_t*)(ws + WS_QM); bf16_t* KN = (bf16_t*)(ws + WS_KN);
    bf16_t* VT = (bf16_t*)(ws + WS_VT); float* OACC = (float*)(ws + WS_OACC);
    const int lo = args.ph_lo, hi_ph = args.ph_hi;
    unsigned* barctr = (unsigned*)(ws + WS_MISC + 65536); unsigned epoch = 0u;
    grid.sync();
#ifndef ONLY_PHASE
#define ONLY_PHASE -1
#endif
#define IN(k) ((ONLY_PHASE < 0 || ONLY_PHASE == (k)) && lo <= (k) && (k) < hi_ph)
#define SEAM(k) do { if (IN(k) && IN((k) + 1)) { \
        asm volatile("s_waitcnt vmcnt(0)" ::: "memory"); __syncthreads(); epoch += (unsigned)G; \
        if (threadIdx.x == 0) { __builtin_amdgcn_fence(__ATOMIC_RELEASE, "agent"); asm volatile("s_waitcnt vmcnt(0)" ::: "memory"); \
            __hip_atomic_fetch_add(barctr, 1u, __ATOMIC_RELAXED, __HIP_MEMORY_SCOPE_AGENT); \
            while (__hip_atomic_load(barctr, __ATOMIC_RELAXED, __HIP_MEMORY_SCOPE_AGENT) < epoch) __builtin_amdgcn_s_sleep(2); \
            __builtin_amdgcn_fence(__ATOMIC_ACQUIRE, "agent"); asm volatile("s_waitcnt vmcnt(0)" ::: "memory"); } \
        __syncthreads(); } } while (0)

    if (IN(0)) {
        PHASE_IDS;
        transpose_job<MAP_GU>(args.in[1], args.in[2], DFF, nullptr, DM, 2 * DFF, WGU, scr, gw, NGW, lane);
        transpose_job<MAP_PLAIN>(args.in[3], args.in[3], DM, nullptr, DFF, DM, WD, scr, gw, NGW, lane);
        transpose_job<MAP_WIN>(args.in[6], args.in[6], 3416, nullptr, DM, 3072, WIN, scr, gw, NGW, lane);
        transpose_job<MAP_WVN>(args.in[6], args.in[6], 3416, nullptr, DM, 512, WVN, scr, gw, NGW, lane);
        transpose_job<MAP_UQ>(args.in[8], args.in[8], 1536, args.in[7], 512, 1536, WUQ, scr, gw, NGW, lane);
        transpose_job<MAP_UKV0>(args.in[10], args.in[10], 2048, args.in[9], 256, 1024, WKN, scr, gw, NGW, lane);
        transpose_job<MAP_UKV1>(args.in[10], args.in[10], 2048, args.in[9], 256, 1024, WVM, scr, gw, NGW, lane);
        transpose_job<MAP_PLAIN>(args.in[13], args.in[13], 256, nullptr, 4096, 256, W1K, scr, gw, NGW, lane);
        transpose_job<MAP_PLAIN>(args.in[16], args.in[16], 256, nullptr, 4096, 256, W1V, scr, gw, NGW, lane);
        transpose_job<MAP_PLAIN>(args.in[18], args.in[18], DM, nullptr, DM, DM, WOUT, scr, gw, NGW, lane);
        { const float* x = args.in[0];
          const size_t nvec = (size_t)M * DM / 8;
          for (size_t i = gtid; i < nvec; i += (size_t)4 * NGT) {
              f32x4 a[4], b[4];
#pragma unroll
              for (int k = 0; k < 4; ++k) { const size_t ii = i + (size_t)k * NGT; if (ii < nvec) { a[k] = ((const f32x4*)x)[2 * ii]; b[k] = ((const f32x4*)x)[2 * ii + 1]; } }
#pragma unroll
              for (int k = 0; k < 4; ++k) { const size_t ii = i + (size_t)k * NGT; if (ii < nvec) {
                  u32x4 w; w.x = pk2(a[k][0], a[k][1]); w.y = pk2(a[k][2], a[k][3]); w.z = pk2(b[k][0], b[k][1]); w.w = pk2(b[k][2], b[k][3]); ((u32x4*)XB)[ii] = w; } }
          } }
        for (int i = gtid; i < M * 96; i += NGT) {
            int pos, f; double base; float* dst;
            if (i < M * 64) { pos = i >> 6; f = i & 63; base = 0.8659643233600653; dst = TAB128 + 2 * (size_t)i; }
            else { const int k = i - M * 64; pos = k >> 5; f = k & 31; base = 0.7498942093324558; dst = TAB64 + 2 * (size_t)k; }
            double inv = 1.0; for (int e = 0; e < f; ++e) inv *= base;
            const double ang = (double)pos * inv;
            const double kq = __builtin_rint(ang * 0.6366197723675814);
            double y = __builtin_fma(-kq, 1.5707963267948966, ang); y = __builtin_fma(-kq, 6.123233995736766e-17, y);
            const double y2 = y * y;
            double sn = -1.0 / 39916800.0; sn = sn * y2 + 1.0 / 362880.0; sn = sn * y2 - 1.0 / 5040.0; sn = sn * y2 + 1.0 / 120.0; sn = sn * y2 - 1.0 / 6.0; sn = sn * y2 * y + y;
            double cs = 1.0 / 479001600.0; cs = cs * y2 - 1.0 / 3628800.0; cs = cs * y2 + 1.0 / 40320.0; cs = cs * y2 - 1.0 / 720.0; cs = cs * y2 + 1.0 / 24.0; cs = cs * y2 - 0.5; cs = cs * y2 + 1.0;
            const int qd = ((int)((long long)kq & 3));
            double c, s; if (qd == 0) { c = cs; s = sn; } else if (qd == 1) { c = -sn; s = cs; } else if (qd == 2) { c = -cs; s = -sn; } else { c = sn; s = -cs; }
            dst[0] = (float)c; dst[1] = (float)s;
        }
        for (int item = bx; item < 256; item += G) {
            const int kv = item >> 7, n = 2 * (item & 127) + (tid & 1), k0 = (tid >> 1) * 16;
            const float* pe = args.in[kv ? 15 : 12]; const float* w1 = args.in[kv ? 16 : 13];
            float sacc = 0.f;
#pragma unroll
            for (int k = 0; k < 16; ++k) sacc += pe[k0 + k] * w1[(size_t)(k0 + k) * 256 + n];
            LAS float* red = (LAS float*)lds;
            __syncthreads(); red[tid] = sacc; __syncthreads();
            for (int st = 256; st >= 2; st >>= 1) { if (tid < st) red[tid] += red[tid + st]; __syncthreads(); }
            if (tid < 2) CBIAS[kv * 256 + 2 * (item & 127) + tid] = red[tid];
            __syncthreads();
        }
    }
    SEAM(0);
    if (IN(1)) for (int rep1 = 0; rep1 < PROBE_REP1; ++rep1) { pg8::Gemm g{XB, WGU, DM, DM, DM}; pg8::StaticOrder S; S.init(64, 44, G, bx); EpiSwiglu E{H}; pg8::gemm_phase(lds, g, S, E); }
    SEAM(1);
    if (IN(2)) { pg8::Gemm g{H, WD, DFF, DFF, DFF}; pg8::StaticOrder S; S.init(64, 8, G, bx); EpiResidB<false> E{args.in[0], D0, ALPHA, 0.5f}; pg8::gemm_phase(lds, g, S, E); }
    SEAM(2);
    if (IN(3)) {
        PHASE_IDS;
        { f32x4 gq[8], bq[8]; ln_load_gb(gq, bq, args.in[4], args.in[5], lane);
          for (int r = gw; r < M; r += 2 * NGW) { const int r2 = r + NGW; u32x4 xa[4], xb2[4];
#pragma unroll
              for (int j = 0; j < 4; ++j) { xa[j] = *(const u32x4*)(D0 + (size_t)r * DM + 8 * lane + 512 * j); if (r2 < M) xb2[j] = *(const u32x4*)(D0 + (size_t)r2 * DM + 8 * lane + 512 * j); }
              ln_row_b<false>(xa, D1 + (size_t)r * DM, gq, bq, lane); if (r2 < M) ln_row_b<false>(xb2, D1 + (size_t)r2 * DM, gq, bq, lane); } }
        transpose_job<MAP_GU>(args.in[21], args.in[22], DFF, nullptr, DM, 2 * DFF, WGU, scr, gw, NGW, lane);
        transpose_job<MAP_PLAIN>(args.in[23], args.in[23], DM, nullptr, DFF, DM, WD, scr, gw, NGW, lane);
    }
    SEAM(3);
    if (IN(4)) {
        { pg8::Gemm g{D1, WIN, DM, DM, DM}; pg8::StaticOrder S; S.init(64, 12, G, bx);
          EpiWin E{CQ, CKV, KR, GL, QN, KCR, VCR, KS, KW, SSQ, TAB128, TAB64}; pg8::gemm_phase(lds, g, S, E); }
        { pg8::Gemm g{WVN, D1, DM, DM, DM}; pg8::StaticOrder S; S.init(2, 64, G, bx); EpiColBf16 E{VTN, M, nullptr}; pg8::gemm_phase(lds, g, S, E); }
    }
    SEAM(4);
    if (IN(5)) {
        int off = 0;
        for (int job = 0; job < 16; ++job) { const int kv = job >> 3, hk = (job >> 2) & 1, sp = job & 3;
            pg8::Gemm g{(kv ? VCR : KCR) + (size_t)hk * M * 128 + sp * 1024, (kv ? W1V : W1K) + sp * 1024, 2048, 4096, 1024};
            pg8::StaticOrder S; S.init(4, 1, G, (bx + G - (off % G)) % G); EpiF32 E{HCP + (size_t)job * 1024 * 256, 256}; pg8::gemm_phase(lds, g, S, E); off += 4; }
        { pg8::Gemm g{CQ, WUQ, 512, 512, 512}; pg8::StaticOrder S; S.init(64, 6, G, (bx + G - (off % G)) % G); EpiQup E{QM, SSQ, TAB64}; pg8::gemm_phase(lds, g, S, E); off += 384; }
        { pg8::Gemm g{CKV, WKN, 256, 256, 256}; pg8::StaticOrder S; S.init(64, 4, G, (bx + G - (off % G)) % G); EpiKn E{KN, SSQ}; pg8::gemm_phase(lds, g, S, E); off += 256; }
        { pg8::Gemm g{WVM, CKV, 256, 256, 256}; pg8::StaticOrder S; S.init(4, 64, G, (bx + G - (off % G)) % G); EpiColBf16 E{VT, M, SSQ}; pg8::gemm_phase(lds, g, S, E); }
    }
    SEAM(5);
    if (IN(6)) {
        PHASE_IDS;
        LAS float* hid = (LAS float*)lds;
        for (int item = bx; item < 256; item += G) {
            const int kv = item >> 7, hk = (item >> 6) & 1, c0 = 16 * (item & 63);
            const float* hp = HCP + (size_t)((kv * 2 + hk) * 4) * 1024 * 256;
#pragma unroll
            for (int e = 0; e < 8; ++e) { const int idx = tid + 512 * e, c = idx >> 8, n = idx & 255; const size_t o = (size_t)(c0 + c) * 256 + n;
                float s = hp[o] + hp[o + 262144] + hp[o + 524288] + hp[o + 786432] + CBIAS[kv * 256 + n];
                const float u = 0.7978845608028654f * (s + 0.044715f * s * s * s);
                const float e2 = __builtin_amdgcn_exp2f(2.f * u * 1.4426950408889634f);
                const float th = 1.f - 2.f / (e2 + 1.f);
                hid[idx] = 0.5f * s * (1.f + th); }
            __syncthreads();
            const int d = tid & 127, cg4 = tid >> 7; const float* w2 = args.in[kv ? 17 : 14];
            float a0 = 0.f, a1 = 0.f, a2 = 0.f, a3 = 0.f;
#pragma unroll 16
            for (int n = 0; n < 256; ++n) { const float wv = w2[n * 128 + d]; a0 += hid[(4 * cg4) * 256 + n] * wv; a1 += hid[(4 * cg4 + 1) * 256 + n] * wv; a2 += hid[(4 * cg4 + 2) * 256 + n] * wv; a3 += hid[(4 * cg4 + 3) * 256 + n] * wv; }
            float av[4] = {a0, a1, a2, a3};
#pragma unroll
            for (int j = 0; j < 4; ++j) { const int c = c0 + 4 * cg4 + j; const float v = (c == 1023) ? 0.f : av[j]; const bf16_t b = (bf16_t)(pk2(v, 0.f) & 0xffffu);
                if (kv == 0) KC[((size_t)hk * 1024 + c) * 128 + d] = b; else { const int cpos = (c & ~15) | (c & 3) | ((c & 4) << 1) | ((c & 8) >> 1); VCT[((size_t)hk * 128 + d) * 1024 + cpos] = b; } }
            __syncthreads();
        }
    }
    SEAM(6);
    if (IN(7)) {
        PHASE_IDS;
        AttnPtrs P{ws, args.in[11]};
        LAS float* wsf = (LAS float*)(lds + WSF_OFF) + wave * 32;
        for (int rep7 = 0; rep7 < PROBE_REP7; ++rep7)
        for (int c = bx; c < 256; c += G) {
            const int x = c & 7, y = c >> 3;
#ifndef NO_NSA
            { const int hk = x & 1, pair = (x >> 1) * 32 + y;
#pragma unroll 1
              for (int rep = 0; rep < 2; ++rep) nsa_unit(hk, rep ? pair : 255 - pair, lds, wsf, P); }
#endif
#ifndef NO_MLA
            { const int h = x, pair = y;
#pragma unroll 1
              for (int rep = 0; rep < 2; ++rep) mla_unit(h, rep ? pair : 63 - pair, lds, wsf, P); }
#endif
        }
    }
    SEAM(7);
    if (IN(8)) { pg8::Gemm g{XB, WOUT, DM, DM, DM}; pg8::StaticOrder S; S.init(64, 8, G, bx); EpiResidB<true> E{D1, D0, ALPHA, 1.0f}; pg8::gemm_phase(lds, g, S, E); }
    SEAM(8);
    if (IN(9)) { PHASE_IDS; f32x4 gq[8], bq[8]; ln_load_gb(gq, bq, args.in[19], args.in[20], lane); for (int r = gw; r < M; r += 2 * NGW) { const int r2 = r + NGW; u32x4 xa[4], xb2[4];
#pragma unroll
            for (int j = 0; j < 4; ++j) { xa[j] = *(const u32x4*)(D0 + (size_t)r * DM + 8 * lane + 512 * j); if (r2 < M) xb2[j] = *(const u32x4*)(D0 + (size_t)r2 * DM + 8 * lane + 512 * j); }
            ln_row_b<false>(xa, D1 + (size_t)r * DM, gq, bq, lane); if (r2 < M) ln_row_b<false>(xb2, D1 + (size_t)r2 * DM, gq, bq, lane); } }
    SEAM(9);
    if (IN(10)) { pg8::Gemm g{D1, WGU, DM, DM, DM}; pg8::StaticOrder S; S.init(64, 44, G, bx); EpiSwiglu E{H}; pg8::gemm_phase(lds, g, S, E); }
    SEAM(10);
    if (IN(11)) { pg8::Gemm g{H, WD, DFF, DFF, DFF}; pg8::StaticOrder S; S.init(64, 8, G, bx); EpiResidB<true, true> E{D1, PRE3, ALPHA, 0.5f}; pg8::gemm_phase(lds, g, S, E); }
    SEAM(11);
    if (IN(12)) { PHASE_IDS; f32x4 gq[8], bq[8];
#pragma unroll
        for (int j = 0; j < 8; ++j) { gq[j] = ((const f32x4*)args.in[24])[64 * j + lane]; bq[j] = ((const f32x4*)args.in[25])[64 * j + lane]; }
        for (int r = gw; r < M; r += NGW) ln_row(PRE3 + (size_t)r * DM, out + (size_t)r * DM, nullptr, gq, bq, lane); }
#undef IN
#undef SEAM
}

#ifndef MK_PER_PHASE
#define MK_PER_PHASE 0
#endif
extern "C" void kernel_launch(void* const* d_in, const int* in_sizes, int n_in, void* d_out, int out_size, void* d_ws, size_t ws_size, hipStream_t stream) {
    static int grid = 0;
    if (grid == 0) {
        if (n_in != 26 || out_size != M * DM || ws_size < 512 * MiB) { fprintf(stderr, "kernel_launch: unexpected shapes (n_in %d out %d ws %zu)\n", n_in, out_size, ws_size); grid = -1; return; }
        int dev = 0, cus = 0, per_cu = 0;
        hipGetDevice(&dev); hipDeviceGetAttribute(&cus, hipDeviceAttributeMultiprocessorCount, dev);
        hipFuncSetAttribute((const void*)mega_fwd, hipFuncAttributeMaxDynamicSharedMemorySize, LDS_BYTES);
        if (hipOccupancyMaxActiveBlocksPerMultiprocessor(&per_cu, (const void*)mega_fwd, NTHREADS, LDS_BYTES) != hipSuccess || per_cu < 1) per_cu = 1;
        (void)hipGetLastError();
        grid = cus * per_cu;
    }
    if (grid < 0) return;
    Args a{};
    for (int i = 0; i < 26; ++i) a.in[i] = (const float*)d_in[i];
    a.out = (float*)d_out; a.ws = (unsigned char*)d_ws;
#if MK_PER_PHASE
    for (int p = 0; p < N_PHASES; ++p) { a.ph_lo = p; a.ph_hi = p + 1; void* kargs[] = {&a};
        hipError_t e = hipLaunchCooperativeKernel((const void*)mega_fwd, dim3(grid), dim3(NTHREADS), kargs, LDS_BYTES, stream);
        if (e != hipSuccess) { fprintf(stderr, "launch failed: %s\n", hipGetErrorString(e)); break; } }
#else
    (void)hipMemsetAsync((unsigned char*)d_ws + WS_MISC + 65536, 0, 256, stream);
    a.ph_lo = 0; a.ph_hi = N_PHASES; void* kargs[] = {&a};
    hipError_t e = hipLaunchCooperativeKernel((const void*)mega_fwd, dim3(grid), dim3(NTHREADS), kargs, LDS_BYTES, stream);
    if (e != hipSuccess) fprintf(stderr, "cooperative launch failed: %s (grid %d)\n", hipGetErrorString(e), grid);
#endif
}
```

```cpp
#include <hip/hip_runtime.h>
#include <hip/hip_cooperative_groups.h>
#include <cstdio>
#include <cstdint>
namespace cg = cooperative_groups;

#define LAS __attribute__((address_space(3)))
#define GAS __attribute__((address_space(1)))
typedef unsigned short bf16_t;
typedef short bf16x8 __attribute__((ext_vector_type(8)));
typedef short s16x4 __attribute__((ext_vector_type(4)));
typedef float f32x2 __attribute__((ext_vector_type(2)));
typedef float f32x4 __attribute__((ext_vector_type(4)));
typedef float f32x16 __attribute__((ext_vector_type(16)));
typedef unsigned u32x4 __attribute__((ext_vector_type(4)));
typedef unsigned u32x2 __attribute__((ext_vector_type(2)));
typedef __bf16 bf16x2_t __attribute__((ext_vector_type(2)));

constexpr int M = 16384, DM = 2048, DFF = 5632;
constexpr float ALPHA = 1.189207115002721f;
constexpr float LN_EPS = 1e-5f, RMS_EPS = 1e-6f;
constexpr float C2M = 0.10411754627697264f;
constexpr float C2N = 0.12751743082459868f;
constexpr int NTHREADS = 512, NWAVES = 8;
constexpr int LDS_BYTES = 147456;

constexpr size_t MiB = 1u << 20;
constexpr size_t WS_WGU = 0, WS_WD = 44 * MiB, WS_WIN = 66 * MiB, WS_WVN = 78 * MiB, WS_WUQ = 80 * MiB, WS_WKN = 82 * MiB,
                 WS_WVM = 83 * MiB, WS_W1K = 84 * MiB, WS_W1V = 86 * MiB, WS_WOUT = 88 * MiB, WS_TAB128 = 96 * MiB, WS_TAB64 = 104 * MiB,
                 WS_SSQ = 108 * MiB, WS_MISC = 110 * MiB, WS_HCP = 111 * MiB, WS_KC = 127 * MiB, WS_XB = 128 * MiB, WS_R = 192 * MiB;
constexpr size_t WS_H = WS_R;
constexpr size_t WS_CQ = 192 * MiB, WS_CKV = 208 * MiB, WS_KR = 216 * MiB, WS_GL = 218 * MiB, WS_QN = 220 * MiB, WS_KCR = 252 * MiB,
                 WS_VCR = 260 * MiB, WS_KS = 268 * MiB, WS_KW = 276 * MiB, WS_VTN = 284 * MiB, WS_QM = 300 * MiB, WS_KN = 348 * MiB,
                 WS_VT = 380 * MiB, WS_OACC = 412 * MiB, WS_END = 460 * MiB;

__device__ __forceinline__ unsigned pk2(float lo, float hi) { f32x2 v = {lo, hi}; bf16x2_t b = __builtin_convertvector(v, bf16x2_t); return __builtin_bit_cast(unsigned, b); }
__device__ __forceinline__ float bf2f(unsigned short h) { return __uint_as_float(((unsigned)h) << 16); }
__device__ __forceinline__ int get_tid0() { return (int)threadIdx.x; }
__device__ __forceinline__ float wave_sum(float v) {
#pragma unroll
    for (int o = 1; o < 64; o <<= 1) v += __shfl_xor(v, o);
    return v;
}

namespace pg8 {
constexpr int BM = 256, BK = 64, HALF = 128, HTB = HALF * BK * 2, STAGE_BYTES = 8 * HTB, NXCD = 8, WGM = 8;
__host__ __device__ __forceinline__ int lds_byte(int r, int c) { const int st = (r >> 4) * 2 + (c >> 5), rr = r & 15, cc = c & 31, ob = rr * 64 + cc * 2; return st * 1024 + (ob ^ (((ob >> 9) & 1) << 5)); }
__host__ __device__ __forceinline__ void stage_rc(int b, int& R, int& C) { const int st = b / 1024, sb = b % 1024, swz = sb ^ (((sb >> 9) & 1) << 5); R = (st >> 1) * 16 + swz / 64; C = (st & 1) * 32 + (swz % 64) / 2; }
__host__ __device__ __forceinline__ int perm32(int rho) { const int n = rho >> 4, i = rho & 15; return 8 * (i >> 2) + 4 * n + (i & 3); }

struct Unit { int pm, pn; };
struct Gemm { const bf16_t* A; const bf16_t* Bt; int lda, ldb, K; };

struct StaticOrder {
    int nM, nN, nwg, G, c;
    __device__ __forceinline__ void init(int nM_, int nN_, int G_, int c_) { nM = nM_; nN = nN_; nwg = nM * nN; G = G_; c = c_; }
    __device__ __forceinline__ bool next(int i, Unit& u) const {
        const long L = (long)i * G + c; if (L >= nwg) return false;
        int wgid = (int)L; { const int q = nwg / NXCD, r = nwg % NXCD, xcd = wgid % NXCD, off = wgid / NXCD; wgid = (xcd < r ? xcd * (q + 1) : r * (q + 1) + (xcd - r) * q) + off; }
        const int nig = WGM * nN, gid = wgid / nig, fm = gid * WGM, gsz = (nM - fm) < WGM ? (nM - fm) : WGM;
        u.pm = fm + ((wgid % nig) % gsz); u.pn = (wgid % nig) / gsz; return true;
    }
};

template <class Epi>
__device__ __forceinline__ void gemm_phase(LAS unsigned char* lds, const Gemm g, const StaticOrder& S, const Epi& E) {
    int tid = threadIdx.x; asm volatile("" : "+v"(tid)); const int wid = __builtin_amdgcn_readfirstlane(tid >> 6), lane = tid & 63, wr = wid >> 2, wc = wid & 3, fr = lane & 15, fq = lane >> 4;
    const int K = g.K, nt = K / BK;
    unsigned voffA[2], voffB[2];
#pragma unroll
    for (int i = 0; i < 2; ++i) { int R, C; stage_rc(tid * 16 + i * 8192, R, C); const int Rb = Epi::PERM ? ((R & ~31) + perm32(R & 31)) : R;
        voffA[i] = (unsigned)(R * g.lda + C) * 2u; voffB[i] = (unsigned)(Rb * g.ldb + C) * 2u; }
    const size_t kstep = (size_t)(BK * 2);
    const size_t hstepA = (size_t)HALF * g.lda * 2, hstepB = (size_t)HALF * g.ldb * 2;
    const size_t tstepA = 2 * hstepA, tstepB = 2 * hstepB;
    const unsigned ldsw = (unsigned)wid * 1024u;
    const int aoff = lds_byte(wr * 64 + fr, fq * 8), boff = lds_byte(wc * 32 + fr, fq * 8);
#define PG8_SA(b, h) (((b) * 2 + (h)) * HTB)
#define PG8_SB(b, h) ((4 + (b) * 2 + (h)) * HTB)
#define PG8_STAGE(bufoff, gbase, voff) do { _Pragma("unroll") for (int _i = 0; _i < 2; ++_i) \
        __builtin_amdgcn_global_load_lds((const unsigned*)((const char*)(gbase) + (voff)[_i]), (LAS unsigned*)(lds + (bufoff) + ldsw + _i * 8192), 16, 0, 0); } while (0)
#define PG8_LDA(dst, b, h) do { _Pragma("unroll") for (int m = 0; m < 4; ++m) _Pragma("unroll") for (int k = 0; k < 2; ++k) dst[m][k] = *(const LAS bf16x8*)(lds + PG8_SA(b, h) + aoff + m * 2048 + k * 1024); } while (0)
#define PG8_LDB(dst, b, h) do { _Pragma("unroll") for (int n = 0; n < 2; ++n) _Pragma("unroll") for (int k = 0; k < 2; ++k) dst[n][k] = *(const LAS bf16x8*)(lds + PG8_SB(b, h) + boff + n * 2048 + k * 1024); } while (0)
#define PG8_MMA(ai, bj, At, Bt) do { __builtin_amdgcn_s_setprio(1); _Pragma("unroll") for (int m = 0; m < 4; ++m) _Pragma("unroll") for (int n = 0; n < 2; ++n) _Pragma("unroll") for (int k = 0; k < 2; ++k) \
        acc[ai][bj][m][n] = __builtin_amdgcn_mfma_f32_16x16x32_bf16(Bt[n][k], At[m][k], acc[ai][bj][m][n], 0, 0, 0); __builtin_amdgcn_s_setprio(0); } while (0)
#define PG8_WAIT_V(n) asm volatile("s_waitcnt vmcnt(" #n ")" ::: "memory")
#define PG8_WAIT_L(n) asm volatile("s_waitcnt lgkmcnt(" #n ")" ::: "memory")
#define PG8_BAR __builtin_amdgcn_s_barrier()
#define PG8_SCHED __builtin_amdgcn_sched_barrier(0)
    Unit cur, nxt; int ui = 0;
    if (!S.next(0, cur)) return;
    f32x4 acc[2][2][4][2];
#pragma unroll
    for (int a = 0; a < 2; ++a)
#pragma unroll
        for (int b = 0; b < 2; ++b)
#pragma unroll
            for (int m = 0; m < 4; ++m)
#pragma unroll
                for (int n = 0; n < 2; ++n) acc[a][b][m][n] = (f32x4){0.f, 0.f, 0.f, 0.f};
    bf16x8 At[4][2], B0[2][2], B1[2][2];
    const char* cA = (const char*)g.A + (size_t)cur.pm * tstepA; const char* cB = (const char*)g.Bt + (size_t)cur.pn * tstepB;
    PG8_STAGE(PG8_SB(0, 0), cB, voffB); PG8_STAGE(PG8_SB(0, 1), cB + hstepB, voffB); PG8_STAGE(PG8_SA(0, 0), cA, voffA); PG8_STAGE(PG8_SA(0, 1), cA + hstepA, voffA);
    if (wr == 1) PG8_BAR;
    PG8_WAIT_V(2); PG8_BAR;
    PG8_STAGE(PG8_SB(1, 0), cB + kstep, voffB); PG8_STAGE(PG8_SA(1, 0), cA + kstep, voffA); PG8_STAGE(PG8_SB(1, 1), cB + hstepB + kstep, voffB);
    PG8_WAIT_V(6); PG8_BAR;
    for (;;) {
        const bool has_next = S.next(ui + 1, nxt);
        const char* nA = has_next ? (const char*)g.A + (size_t)nxt.pm * tstepA : cA; const char* nB = has_next ? (const char*)g.Bt + (size_t)nxt.pn * tstepB : cB;
        for (int t = 0; t < nt; t += 2) {
            const bool last = (t == nt - 2);
            const char* a1 = cA + (size_t)(t + 1) * kstep;
            const char* a2 = last ? nA : cA + (size_t)(t + 2) * kstep; const char* b2 = last ? nB : cB + (size_t)(t + 2) * kstep;
            const char* a3 = a2 + kstep; const char* b3 = b2 + kstep;
            PG8_LDB(B0, 0, 0); PG8_LDB(B1, 0, 1); PG8_SCHED; PG8_LDA(At, 0, 0); PG8_STAGE(PG8_SA(1, 1), a1 + hstepA, voffA);
            PG8_WAIT_V(8); PG8_WAIT_L(0); PG8_BAR; PG8_MMA(0, 0, At, B0); PG8_MMA(0, 1, At, B1); PG8_BAR; PG8_SCHED;
            PG8_LDA(At, 0, 1); PG8_STAGE(PG8_SB(0, 0), b2, voffB); PG8_STAGE(PG8_SB(0, 1), b2 + hstepB, voffB); PG8_STAGE(PG8_SA(0, 0), a2, voffA);
            PG8_WAIT_V(8); PG8_WAIT_L(0); PG8_BAR; PG8_MMA(1, 0, At, B0); PG8_MMA(1, 1, At, B1); PG8_BAR; PG8_SCHED;
            PG8_LDB(B0, 1, 0); PG8_LDB(B1, 1, 1); PG8_SCHED; PG8_LDA(At, 1, 0); PG8_STAGE(PG8_SA(0, 1), a2 + hstepA, voffA);
            PG8_WAIT_V(8); PG8_WAIT_L(0); PG8_BAR; PG8_MMA(0, 0, At, B0); PG8_MMA(0, 1, At, B1); PG8_BAR; PG8_SCHED;
            PG8_LDA(At, 1, 1); PG8_STAGE(PG8_SB(1, 0), b3, voffB); PG8_STAGE(PG8_SB(1, 1), b3 + hstepB, voffB); PG8_STAGE(PG8_SA(1, 0), a3, voffA);
            PG8_WAIT_V(8); PG8_WAIT_L(0); PG8_BAR; PG8_MMA(1, 0, At, B0); PG8_MMA(1, 1, At, B1); PG8_BAR; PG8_SCHED;
        }
        if (wr == 0) PG8_BAR;
        E(acc, cur, wr, wc, fr, fq);
        if (!has_next) break;
#pragma unroll
        for (int a = 0; a < 2; ++a)
#pragma unroll
            for (int b = 0; b < 2; ++b)
#pragma unroll
                for (int m = 0; m < 4; ++m)
#pragma unroll
                    for (int n = 0; n < 2; ++n) acc[a][b][m][n] = (f32x4){0.f, 0.f, 0.f, 0.f};
        cur = nxt; cA = nA; cB = nB; ++ui;
        if (wr == 1) PG8_BAR;
    }
    PG8_WAIT_V(0);
    PG8_BAR;
#undef PG8_SA
#undef PG8_SB
#undef PG8_STAGE
#undef PG8_LDA
#undef PG8_LDB
#undef PG8_MMA
#undef PG8_WAIT_V
#undef PG8_WAIT_L
#undef PG8_BAR
#undef PG8_SCHED
}
}

typedef f32x4 AccT[2][2][4][2];

struct EpiSwiglu {
    static constexpr bool PERM = true;
    bf16_t* H;
    __device__ __forceinline__ void operator()(const AccT& acc, const pg8::Unit& u, int wr, int wc, int fr, int fq) const {
        const int col = u.pn * 128 + wc * 32 + fq * 8;
#pragma unroll
        for (int ai = 0; ai < 2; ++ai)
#pragma unroll
            for (int m = 0; m < 4; ++m) {
                const int row = u.pm * 256 + ai * 128 + wr * 64 + m * 16 + fr;
                float o[8];
#pragma unroll
                for (int n = 0; n < 2; ++n)
#pragma unroll
                    for (int j = 0; j < 4; ++j) { const float gt = acc[ai][0][m][n][j], up = acc[ai][1][m][n][j];
                        const float sg = gt * __builtin_amdgcn_rcpf(1.f + __builtin_amdgcn_exp2f(-gt * 1.4426950408889634f)); o[n * 4 + j] = sg * up; }
                u32x4 w; w.x = pk2(o[0], o[1]); w.y = pk2(o[2], o[3]); w.z = pk2(o[4], o[5]); w.w = pk2(o[6], o[7]);
                *(u32x4*)(H + (size_t)row * DFF + col) = w;
            }
    }
};
struct EpiResid {
    static constexpr bool PERM = false;
    const float* res; float* out; float a, b;
    __device__ __forceinline__ void operator()(const AccT& acc, const pg8::Unit& u, int wr, int wc, int fr, int fq) const {
#pragma unroll
        for (int ai = 0; ai < 2; ++ai)
#pragma unroll
            for (int m = 0; m < 4; ++m) {
                const size_t rowoff = (size_t)(u.pm * 256 + ai * 128 + wr * 64 + m * 16 + fr) * DM + u.pn * 256 + wc * 32 + fq * 4;
#pragma unroll
                for (int bj = 0; bj < 2; ++bj)
#pragma unroll
                    for (int n = 0; n < 2; ++n) { const size_t off = rowoff + bj * 128 + n * 16; const f32x4 r = *(const f32x4*)(res + off);
                        *(f32x4*)(out + off) = r * a + acc[ai][bj][m][n] * b; }
            }
    }
};
template <bool RES_BF16, bool OUT_F32 = false>
struct EpiResidB {
    static constexpr bool PERM = true;
    const void* res; void* out; float a, b;
    __device__ __forceinline__ void operator()(const AccT& acc, const pg8::Unit& u, int wr, int wc, int fr, int fq) const {
#pragma unroll
        for (int ai = 0; ai < 2; ++ai)
#pragma unroll
            for (int m = 0; m < 4; ++m) {
                const size_t rowoff = (size_t)(u.pm * 256 + ai * 128 + wr * 64 + m * 16 + fr) * DM + u.pn * 256 + wc * 32 + fq * 8;
#pragma unroll
                for (int bj = 0; bj < 2; ++bj) { const size_t off = rowoff + bj * 128; float r[8];
                    if (RES_BF16) { const u32x4 w = *(const u32x4*)((const bf16_t*)res + off);
                        r[0] = __uint_as_float(w.x << 16); r[1] = __uint_as_float(w.x & 0xffff0000u); r[2] = __uint_as_float(w.y << 16); r[3] = __uint_as_float(w.y & 0xffff0000u);
                        r[4] = __uint_as_float(w.z << 16); r[5] = __uint_as_float(w.z & 0xffff0000u); r[6] = __uint_as_float(w.w << 16); r[7] = __uint_as_float(w.w & 0xffff0000u); }
                    else { const f32x4 x0 = *(const f32x4*)((const float*)res + off), x1 = *(const f32x4*)((const float*)res + off + 4);
                        r[0] = x0[0]; r[1] = x0[1]; r[2] = x0[2]; r[3] = x0[3]; r[4] = x1[0]; r[5] = x1[1]; r[6] = x1[2]; r[7] = x1[3]; }
                    const f32x4 v0 = acc[ai][bj][m][0], v1 = acc[ai][bj][m][1];
                    if (OUT_F32) { *(f32x4*)((float*)out + off) = (f32x4){r[0] * a + v0[0] * b, r[1] * a + v0[1] * b, r[2] * a + v0[2] * b, r[3] * a + v0[3] * b};
                        *(f32x4*)((float*)out + off + 4) = (f32x4){r[4] * a + v1[0] * b, r[5] * a + v1[1] * b, r[6] * a + v1[2] * b, r[7] * a + v1[3] * b}; }
                    else { u32x4 o; o.x = pk2(r[0] * a + v0[0] * b, r[1] * a + v0[1] * b); o.y = pk2(r[2] * a + v0[2] * b, r[3] * a + v0[3] * b);
                        o.z = pk2(r[4] * a + v1[0] * b, r[5] * a + v1[1] * b); o.w = pk2(r[6] * a + v1[2] * b, r[7] * a + v1[3] * b);
                        *(u32x4*)((bf16_t*)out + off) = o; } }
            }
    }
};
struct EpiF32 {
    static constexpr bool PERM = false;
    float* out; int ld;
    __device__ __forceinline__ void operator()(const AccT& acc, const pg8::Unit& u, int wr, int wc, int fr, int fq) const {
#pragma unroll
        for (int ai = 0; ai < 2; ++ai)
#pragma unroll
            for (int m = 0; m < 4; ++m) {
                const size_t rowoff = (size_t)(u.pm * 256 + ai * 128 + wr * 64 + m * 16 + fr) * ld + u.pn * 256 + wc * 32 + fq * 4;
#pragma unroll
                for (int bj = 0; bj < 2; ++bj)
#pragma unroll
                    for (int n = 0; n < 2; ++n) *(f32x4*)(out + rowoff + bj * 128 + n * 16) = acc[ai][bj][m][n];
            }
    }
};
__device__ __forceinline__ void rope4(const f32x4 x1, const f32x4 x2, const f32x4 t01, const f32x4 t23, float sc, u32x2& lo, u32x2& hi) {
    const float c0 = t01[0], s0 = t01[1], c1 = t01[2], s1 = t01[3], c2 = t23[0], s2 = t23[1], c3 = t23[2], s3 = t23[3];
    const float l0 = (x1[0] * c0 - x2[0] * s0) * sc, l1 = (x1[1] * c1 - x2[1] * s1) * sc, l2 = (x1[2] * c2 - x2[2] * s2) * sc, l3 = (x1[3] * c3 - x2[3] * s3) * sc;
    const float h0 = (x2[0] * c0 + x1[0] * s0) * sc, h1 = (x2[1] * c1 + x1[1] * s1) * sc, h2 = (x2[2] * c2 + x1[2] * s2) * sc, h3 = (x2[3] * c3 + x1[3] * s3) * sc;
    lo.x = pk2(l0, l1); lo.y = pk2(l2, l3); hi.x = pk2(h0, h1); hi.y = pk2(h2, h3);
}
struct EpiWin {
    static constexpr bool PERM = true;
    bf16_t *CQ, *CKV, *KR, *GL, *QN, *KCR, *VCR, *KS, *KW; float* SSQ; const float* tab128; const float* tab64;
    __device__ __forceinline__ void operator()(const AccT& acc, const pg8::Unit& u, int wr, int wc, int fr, int fq) const {
        const int c8 = wc * 32 + fq * 8;
#pragma unroll
        for (int bj = 0; bj < 2; ++bj) {
            const int blk = 2 * u.pn + bj;
            if (blk == 23) continue;
#pragma unroll
            for (int ai = 0; ai < 2; ++ai)
#pragma unroll
                for (int m = 0; m < 4; ++m) {
                    const int row = u.pm * 256 + ai * 128 + wr * 64 + m * 16 + fr;
                    const f32x4 v0 = acc[ai][bj][m][0], v1 = acc[ai][bj][m][1];
                    u32x4 raw; raw.x = pk2(v0[0], v0[1]); raw.y = pk2(v0[2], v0[3]); raw.z = pk2(v1[0], v1[1]); raw.w = pk2(v1[2], v1[3]);
                    if (blk < 6) {
                        bf16_t* dst = (blk < 4) ? CQ + (size_t)row * 512 + blk * 128 + c8 : CKV + (size_t)row * 256 + (blk - 4) * 128 + c8;
                        *(u32x4*)dst = raw;
                        float s = (v0[0] * v0[0] + v0[1] * v0[1]) + (v0[2] * v0[2] + v0[3] * v0[3]) + (v1[0] * v1[0] + v1[1] * v1[1]) + (v1[2] * v1[2] + v1[3] * v1[3]);
                        s += __shfl_xor(s, 16); s += __shfl_xor(s, 32);
                        if (fq == 0) SSQ[(size_t)row * 24 + blk * 4 + wc] = s;
                    } else if (blk == 6) {
                        if (wc < 2) { const int i = wc * 4 + fq; const f32x4* tp = (const f32x4*)(tab64 + ((size_t)row * 32 + 4 * i) * 2);
                            u32x2 lo, hi; rope4(v0, v1, tp[0], tp[1], 1.f, lo, hi);
                            *(u32x2*)(KR + (size_t)row * 64 + 4 * i) = lo; *(u32x2*)(KR + (size_t)row * 64 + 32 + 4 * i) = hi; }
                        else if (wc == 2) { *(u32x4*)(GL + (size_t)row * 32 + fq * 8) = raw; }
                    } else if (blk == 17 || blk == 18) {
                        *(u32x4*)(VCR + ((size_t)(blk - 17) * M + row) * 128 + c8) = raw;
                    } else {
                        const int i = wc * 4 + fq; const f32x4* tp = (const f32x4*)(tab128 + ((size_t)row * 64 + 4 * i) * 2);
                        bf16_t* base; float sc = 1.f;
                        if (blk <= 14) { base = QN + ((size_t)(blk - 7) * M + row) * 128; sc = C2N; }
                        else if (blk <= 16) base = KCR + ((size_t)(blk - 15) * M + row) * 128;
                        else if (blk <= 20) base = KS + ((size_t)(blk - 19) * M + row) * 128;
                        else base = KW + ((size_t)(blk - 21) * M + row) * 128;
                        u32x2 lo, hi; rope4(v0, v1, tp[0], tp[1], sc, lo, hi);
                        *(u32x2*)(base + 4 * i) = lo; *(u32x2*)(base + 64 + 4 * i) = hi;
                    }
                }
        }
    }
};
__device__ __forceinline__ float ssq_sum16(const float* p) { const f32x4 a = *(const f32x4*)p, b = *(const f32x4*)(p + 4), c = *(const f32x4*)(p + 8), d = *(const f32x4*)(p + 12);
    return ((a[0] + a[1]) + (a[2] + a[3])) + ((b[0] + b[1]) + (b[2] + b[3])) + ((c[0] + c[1]) + (c[2] + c[3])) + ((d[0] + d[1]) + (d[2] + d[3])); }
__device__ __forceinline__ float ssq_sum8(const float* p) { const f32x4 a = *(const f32x4*)p, b = *(const f32x4*)(p + 4);
    return ((a[0] + a[1]) + (a[2] + a[3])) + ((b[0] + b[1]) + (b[2] + b[3])); }
struct EpiQup {
    static constexpr bool PERM = true;
    bf16_t* QM; const float* SSQ; const float* tab64;
    __device__ __forceinline__ void operator()(const AccT& acc, const pg8::Unit& u, int wr, int wc, int fr, int fq) const {
        const int c8 = wc * 32 + fq * 8;
#pragma unroll
        for (int ai = 0; ai < 2; ++ai)
#pragma unroll
            for (int m = 0; m < 4; ++m) {
                const int row = u.pm * 256 + ai * 128 + wr * 64 + m * 16 + fr;
                const float rs = C2M / sqrtf(ssq_sum16(SSQ + (size_t)row * 24) * (1.f / 512.f) + RMS_EPS);
#pragma unroll
                for (int bj = 0; bj < 2; ++bj) {
                    const int blk = 2 * u.pn + bj;
                    const f32x4 v0 = acc[ai][bj][m][0] * rs, v1 = acc[ai][bj][m][1] * rs;
                    if (blk < 8) { u32x4 raw; raw.x = pk2(v0[0], v0[1]); raw.y = pk2(v0[2], v0[3]); raw.z = pk2(v1[0], v1[1]); raw.w = pk2(v1[2], v1[3]);
                        *(u32x4*)(QM + ((size_t)blk * M + row) * 192 + c8) = raw; }
                    else { const int head = 2 * (blk - 8) + (wc >> 1), i = (wc & 1) * 4 + fq; const f32x4* tp = (const f32x4*)(tab64 + ((size_t)row * 32 + 4 * i) * 2);
                        u32x2 lo, hi; rope4(v0, v1, tp[0], tp[1], 1.f, lo, hi);
                        bf16_t* base = QM + ((size_t)head * M + row) * 192 + 128;
                        *(u32x2*)(base + 4 * i) = lo; *(u32x2*)(base + 32 + 4 * i) = hi; }
                }
            }
    }
};
struct EpiKn {
    static constexpr bool PERM = true;
    bf16_t* KN; const float* SSQ;
    __device__ __forceinline__ void operator()(const AccT& acc, const pg8::Unit& u, int wr, int wc, int fr, int fq) const {
        const int c8 = wc * 32 + fq * 8;
#pragma unroll
        for (int ai = 0; ai < 2; ++ai)
#pragma unroll
            for (int m = 0; m < 4; ++m) {
                const int row = u.pm * 256 + ai * 128 + wr * 64 + m * 16 + fr;
                const float rs = 1.f / sqrtf(ssq_sum8(SSQ + (size_t)row * 24 + 16) * (1.f / 256.f) + RMS_EPS);
#pragma unroll
                for (int bj = 0; bj < 2; ++bj) {
                    const int blk = 2 * u.pn + bj;
                    const f32x4 v0 = acc[ai][bj][m][0] * rs, v1 = acc[ai][bj][m][1] * rs;
                    u32x4 raw; raw.x = pk2(v0[0], v0[1]); raw.y = pk2(v0[2], v0[3]); raw.z = pk2(v1[0], v1[1]); raw.w = pk2(v1[2], v1[3]);
                    *(u32x4*)(KN + ((size_t)blk * M + row) * 128 + c8) = raw;
                }
            }
    }
};
struct EpiColBf16 {
    static constexpr bool PERM = true;
    bf16_t* out; int ld; const float* SSQ;
    __device__ __forceinline__ void operator()(const AccT& acc, const pg8::Unit& u, int wr, int wc, int fr, int fq) const {
#pragma unroll
        for (int bj = 0; bj < 2; ++bj) {
            const int col = u.pn * 256 + bj * 128 + wc * 32 + fq * 8;
            float cs[8];
#pragma unroll
            for (int j = 0; j < 8; ++j) cs[j] = SSQ ? 1.f / sqrtf(ssq_sum8(SSQ + (size_t)(col + j) * 24 + 16) * (1.f / 256.f) + RMS_EPS) : 1.f;
#pragma unroll
            for (int ai = 0; ai < 2; ++ai)
#pragma unroll
                for (int m = 0; m < 4; ++m) {
                    const int row = u.pm * 256 + ai * 128 + wr * 64 + m * 16 + fr;
                    const f32x4 v0 = acc[ai][bj][m][0], v1 = acc[ai][bj][m][1];
                    u32x2 ra, rb; ra.x = pk2(v0[0] * cs[0], v0[1] * cs[1]); ra.y = pk2(v0[2] * cs[2], v0[3] * cs[3]); rb.x = pk2(v1[0] * cs[4], v1[1] * cs[5]); rb.y = pk2(v1[2] * cs[6], v1[3] * cs[7]);
                    bf16_t* gp = out + (size_t)row * ld + (col & ~15);
                    *(u32x2*)(gp + ((col & 8) ? 4 : 0)) = ra; *(u32x2*)(gp + ((col & 8) ? 12 : 8)) = rb;
                }
        }
    }
};

__device__ __forceinline__ int perm128_d(int p) { const int i = p >> 3, j = p & 7; return (j < 4) ? 4 * i + j : 64 + 4 * i + (j - 4); }
__device__ __forceinline__ int perm64_d(int p) { const int i = p >> 3, j = p & 7; return (j < 4) ? 4 * i + j : 32 + 4 * i + (j - 4); }
enum { MAP_PLAIN = 0, MAP_GU = 1, MAP_WIN = 2, MAP_WVN = 3, MAP_UQ = 4, MAP_UKV0 = 5, MAP_UKV1 = 6 };
template <int MODE> __device__ __forceinline__ int map_col(int n, int& which) {
    which = 0;
    if (MODE == MAP_PLAIN) return n;
    if (MODE == MAP_GU) { const int pn = n >> 8, r = n & 255; which = (r < 128) ? 0 : 1; return 128 * pn + (r & 127); }
    if (MODE == MAP_WIN) { const int blk = n >> 7, p = n & 127; int col = -1;
        if (blk < 4) col = 128 * blk + p;
        else if (blk < 6) col = 512 + 128 * (blk - 4) + p;
        else if (blk == 6) { if (p < 64) col = 768 + perm64_d(p); else if (p < 88) col = 3392 + (p - 64); }
        else if (blk <= 14) col = 832 + 128 * (blk - 7) + perm128_d(p);
        else if (blk <= 16) col = 1856 + 128 * (blk - 15) + perm128_d(p);
        else if (blk <= 18) col = 2112 + 128 * (blk - 17) + p;
        else if (blk <= 20) col = 2368 + 128 * (blk - 19) + perm128_d(p);
        else if (blk <= 22) col = 2880 + 128 * (blk - 21) + perm128_d(p);
        return col; }
    if (MODE == MAP_WVN) { const int blk = n >> 7, p = n & 127; return (blk < 2) ? 2624 + 128 * blk + p : 3136 + 128 * (blk - 2) + p; }
    if (MODE == MAP_UQ) { const int blk = n >> 7, p = n & 127; if (blk < 8) return 192 * blk + p; const int head = 2 * (blk - 8) + (p >> 6); return 192 * head + 128 + perm64_d(p & 63); }
    if (MODE == MAP_UKV0) return 256 * (n >> 7) + (n & 127);
    return 256 * (n >> 7) + 128 + (n & 127);
}
template <int MODE>
__device__ __forceinline__ void transpose_job(const float* src0, const float* src1, int ld, const float* ks, int K, int NR, bf16_t* WT, LAS float* scr, int gw, int NGW, int lane) {
    const int nblk = NR / 32, items = (K / 64) * nblk;
    for (int it = gw; it < items; it += 2 * NGW) {
        const int it2 = it + NGW; const bool has2 = it2 < items;
        const int kbA = it / nblk, nbA = it % nblk, k0A = 64 * kbA, n0A = 32 * nbA;
        const int itb = has2 ? it2 : it; const int kbB = itb / nblk, nbB = itb % nblk, k0B = 64 * kbB, n0B = 32 * nbB;
        int whichA, whichB; const int colA = map_col<MODE>(n0A + (lane & 31), whichA), colB = map_col<MODE>(n0B + (lane & 31), whichB);
        const float* spA = (whichA ? src1 : src0) + (colA >= 0 ? colA : 0); const float* spB = (whichB ? src1 : src0) + (colB >= 0 ? colB : 0);
        float va[32], vb[32];
#pragma unroll
        for (int i = 0; i < 32; ++i) { const int kk = 2 * i + (lane >> 5); va[i] = spA[(size_t)(k0A + kk) * ld]; }
#pragma unroll
        for (int i = 0; i < 32; ++i) { const int kk = 2 * i + (lane >> 5); vb[i] = spB[(size_t)(k0B + kk) * ld]; }
#pragma unroll
        for (int i = 0; i < 32; ++i) { const int kk = 2 * i + (lane >> 5); float v = va[i]; if (ks) v *= ks[k0A + kk]; if (colA < 0) v = 0.f; scr[kk * 33 + (lane & 31)] = v; }
#pragma unroll
        for (int i = 0; i < 32; ++i) { const int kk = 2 * i + (lane >> 5); float v = vb[i]; if (ks) v *= ks[k0B + kk]; if (colB < 0) v = 0.f; scr[2112 + kk * 33 + (lane & 31)] = v; }
        asm volatile("s_waitcnt lgkmcnt(0)" ::: "memory");
        const int c = lane & 7;
#pragma unroll
        for (int j = 0; j < 4; ++j) { const int n = (lane >> 3) + 8 * j; const LAS float* s = scr + (8 * c) * 33 + n;
            u32x4 o; o.x = pk2(s[0 * 33], s[1 * 33]); o.y = pk2(s[2 * 33], s[3 * 33]); o.z = pk2(s[4 * 33], s[5 * 33]); o.w = pk2(s[6 * 33], s[7 * 33]);
            *(u32x4*)(WT + (size_t)(n0A + n) * K + k0A + 8 * c) = o; }
        if (has2) {
#pragma unroll
            for (int j = 0; j < 4; ++j) { const int n = (lane >> 3) + 8 * j; const LAS float* s = scr + 2112 + (8 * c) * 33 + n;
                u32x4 o; o.x = pk2(s[0 * 33], s[1 * 33]); o.y = pk2(s[2 * 33], s[3 * 33]); o.z = pk2(s[4 * 33], s[5 * 33]); o.w = pk2(s[6 * 33], s[7 * 33]);
                *(u32x4*)(WT + (size_t)(n0B + n) * K + k0B + 8 * c) = o; } }
        asm volatile("s_waitcnt lgkmcnt(0)" ::: "memory");
    }
}

__device__ __forceinline__ void ln_row(const float* xin, float* xout, bf16_t* xb, const f32x4 (&gq)[8], const f32x4 (&bq)[8], int lane) {
    const f32x4* xr = (const f32x4*)xin + lane;
    f32x4 v[8]; float s = 0.f;
#pragma unroll
    for (int j = 0; j < 8; ++j) { v[j] = xr[64 * j]; s += (v[j][0] + v[j][1]) + (v[j][2] + v[j][3]); }
    const float mean = wave_sum(s) * (1.f / DM); float s2 = 0.f;
#pragma unroll
    for (int j = 0; j < 8; ++j) { v[j] = v[j] - mean; s2 += (v[j][0] * v[j][0] + v[j][1] * v[j][1]) + (v[j][2] * v[j][2] + v[j][3] * v[j][3]); }
    const float rstd = 1.f / sqrtf(wave_sum(s2) * (1.f / DM) + LN_EPS);
#pragma unroll
    for (int j = 0; j < 8; ++j) { const f32x4 gg = gq[j], bb = bq[j];
        const f32x4 y = v[j] * rstd * gg + bb;
        ((f32x4*)xout)[64 * j + lane] = y;
        if (xb) { u32x2 w; w.x = pk2(y[0], y[1]); w.y = pk2(y[2], y[3]); ((u32x2*)xb)[64 * j + lane] = w; } }
}

__device__ __forceinline__ void ln_load_gb(f32x4 (&gq)[8], f32x4 (&bq)[8], const float* g, const float* b, int lane) {
#pragma unroll
    for (int j = 0; j < 4; ++j) { const int e0 = 8 * lane + 512 * j; gq[2 * j] = *(const f32x4*)(g + e0); gq[2 * j + 1] = *(const f32x4*)(g + e0 + 4); bq[2 * j] = *(const f32x4*)(b + e0); bq[2 * j + 1] = *(const f32x4*)(b + e0 + 4); }
}
template <bool OUT_F32>
__device__ __forceinline__ void ln_row_b(const u32x4 (&xw)[4], void* xout, const f32x4 (&gq)[8], const f32x4 (&bq)[8], int lane) {
    float v[32]; float s = 0.f;
#pragma unroll
    for (int j = 0; j < 4; ++j) { const u32x4 w = xw[j];
        v[8 * j + 0] = __uint_as_float(w.x << 16); v[8 * j + 1] = __uint_as_float(w.x & 0xffff0000u); v[8 * j + 2] = __uint_as_float(w.y << 16); v[8 * j + 3] = __uint_as_float(w.y & 0xffff0000u);
        v[8 * j + 4] = __uint_as_float(w.z << 16); v[8 * j + 5] = __uint_as_float(w.z & 0xffff0000u); v[8 * j + 6] = __uint_as_float(w.w << 16); v[8 * j + 7] = __uint_as_float(w.w & 0xffff0000u); }
#pragma unroll
    for (int i = 0; i < 32; ++i) s += v[i];
    const float mean = wave_sum(s) * (1.f / DM); float s2 = 0.f;
#pragma unroll
    for (int i = 0; i < 32; ++i) { v[i] -= mean; s2 += v[i] * v[i]; }
    const float rstd = 1.f / sqrtf(wave_sum(s2) * (1.f / DM) + LN_EPS);
#pragma unroll
    for (int j = 0; j < 4; ++j) { const int e0 = 8 * lane + 512 * j;
        const f32x4 g0 = gq[2 * j], g1 = gq[2 * j + 1], b0 = bq[2 * j], b1 = bq[2 * j + 1];
        float y[8];
#pragma unroll
        for (int k = 0; k < 4; ++k) { y[k] = v[8 * j + k] * rstd * g0[k] + b0[k]; y[4 + k] = v[8 * j + 4 + k] * rstd * g1[k] + b1[k]; }
        if (OUT_F32) { *(f32x4*)((float*)xout + e0) = (f32x4){y[0], y[1], y[2], y[3]}; *(f32x4*)((float*)xout + e0 + 4) = (f32x4){y[4], y[5], y[6], y[7]}; }
        else { u32x4 w; w.x = pk2(y[0], y[1]); w.y = pk2(y[2], y[3]); w.z = pk2(y[4], y[5]); w.w = pk2(y[6], y[7]); *(u32x4*)((bf16_t*)xout + e0) = w; } }
}
__device__ __forceinline__ int crow(int r, int hi) { return (r & 3) + 8 * (r >> 2) + 4 * hi; }
constexpr int VRS = 144;

struct TileSrc { const GAS bf16_t* K; const GAS bf16_t* KX; const GAS bf16_t* VT; int ldv; };

template <int KRS, bool HAS_X>
struct TileRegs { u32x4 k0, k1, kx, v0, v1; };

template <int KRS, bool HAS_X>
__device__ __forceinline__ void tile_load(TileRegs<KRS, HAS_X>& R, const TileSrc& s, int t, int tid) {
    const GAS bf16_t* kp = s.K + (size_t)t * 64 * 128 + tid * 8;
    R.k0 = *(const GAS u32x4*)kp; R.k1 = *(const GAS u32x4*)(kp + 4096);
    if (HAS_X) R.kx = *(const GAS u32x4*)(s.KX + (size_t)t * 64 * 64 + tid * 8);
    const int d = tid >> 3, ch = tid & 7;
    const GAS bf16_t* vp = s.VT + (size_t)d * s.ldv + t * 64 + ch * 8;
    R.v0 = *(const GAS u32x4*)vp; R.v1 = *(const GAS u32x4*)(vp + (size_t)64 * s.ldv);
}
template <int KRS, bool HAS_X>
__device__ __forceinline__ void tile_store(const TileRegs<KRS, HAS_X>& R, LAS unsigned char* buf, int tid) {
    { const int row = tid >> 4, col = tid & 15; *(LAS u32x4*)(buf + row * KRS + col * 16) = R.k0; *(LAS u32x4*)(buf + (row + 32) * KRS + col * 16) = R.k1; }
    if (HAS_X) { const int row = tid >> 3, col = tid & 7; *(LAS u32x4*)(buf + row * KRS + 256 + col * 16) = R.kx; }
    { const int d = tid >> 3, ch = tid & 7; LAS unsigned char* vb = buf + 64 * KRS + d * VRS + ch * 16;
      *(LAS u32x4*)(vb) = R.v0; *(LAS u32x4*)(vb + 64 * VRS) = R.v1; }
}
template <int KRS, bool HAS_X, bool MIDSTORE, class Body>
__device__ __forceinline__ void flash_loop(LAS unsigned char* lds, const TileSrc& src, int tb, int te, int tid, Body&& body) {
    constexpr int BUFB = 64 * KRS + 128 * VRS;
    if (tb >= te) return;
    TileRegs<KRS, HAS_X> R;
    { TileRegs<KRS, HAS_X> R0;
      tile_load<KRS, HAS_X>(R0, src, tb, tid); if (tb + 1 < te) tile_load<KRS, HAS_X>(R, src, tb + 1, tid);
      tile_store<KRS, HAS_X>(R0, lds, tid); }
    __syncthreads();
    for (int t = tb; t < te; ++t) {
        const int cur = (t - tb) & 1;
        if (t + 1 < te) tile_store<KRS, HAS_X>(R, lds + (cur ^ 1) * BUFB, tid);
        if (t + 2 < te) tile_load<KRS, HAS_X>(R, src, t + 2, tid);
        body(t, (const LAS unsigned char*)(lds + cur * BUFB), []() __attribute__((always_inline)) {});
        __syncthreads();
    }
}
template <int NKS, int KRS>
__device__ __forceinline__ void qk_tile(f32x16& p0, f32x16& p1, const LAS unsigned char* Kt, const bf16x8 (&qf)[NKS], int r32, int hi) {
    const LAS unsigned char* kb = Kt + r32 * KRS + hi * 16;
#pragma unroll
    for (int r = 0; r < 16; ++r) { p0[r] = 0.f; p1[r] = 0.f; }
    bf16x8 a0[3], a1[3];
    a0[0] = *(const LAS bf16x8*)(kb); a1[0] = *(const LAS bf16x8*)(kb + 32 * KRS);
    a0[1] = *(const LAS bf16x8*)(kb + 32); a1[1] = *(const LAS bf16x8*)(kb + 32 * KRS + 32);
    __builtin_amdgcn_sched_barrier(0);
#pragma unroll
    for (int ks = 0; ks < NKS; ++ks) {
        if (ks + 2 < NKS) { a0[(ks + 2) % 3] = *(const LAS bf16x8*)(kb + (ks + 2) * 32); a1[(ks + 2) % 3] = *(const LAS bf16x8*)(kb + 32 * KRS + (ks + 2) * 32); }
        p0 = __builtin_amdgcn_mfma_f32_32x32x16_bf16(a0[ks % 3], qf[ks], p0, 0, 0, 0);
        p1 = __builtin_amdgcn_mfma_f32_32x32x16_bf16(a1[ks % 3], qf[ks], p1, 0, 0, 0);
        __builtin_amdgcn_sched_barrier(0);
    }
}
__device__ __forceinline__ void pv_tile(f32x16 (&o)[4], const f32x16& p0, const f32x16& p1, const LAS unsigned char* Vt, int r32, int hi) {
    bf16x8 pa[4];
#pragma unroll
    for (int s = 0; s < 4; ++s) { const int b = 8 * (s & 1); u32x4 w;
        if (s < 2) { w.x = pk2(p0[b], p0[b + 1]); w.y = pk2(p0[b + 2], p0[b + 3]); w.z = pk2(p0[b + 4], p0[b + 5]); w.w = pk2(p0[b + 6], p0[b + 7]); }
        else { w.x = pk2(p1[b], p1[b + 1]); w.y = pk2(p1[b + 2], p1[b + 3]); w.z = pk2(p1[b + 4], p1[b + 5]); w.w = pk2(p1[b + 6], p1[b + 7]); }
        pa[s] = __builtin_bit_cast(bf16x8, w); }
    const LAS unsigned char* vb2 = Vt + r32 * VRS + hi * 16;
    bf16x8 vf[4];
#define PV_LD(i_) do { vf[(i_) & 3] = *(const LAS bf16x8*)(vb2 + ((i_) & 3) * 32 * VRS + ((i_) >> 2) * 32); } while (0)
    PV_LD(0); PV_LD(1); PV_LD(2);
    __builtin_amdgcn_sched_barrier(0);
#pragma unroll
    for (int i = 0; i < 16; ++i) {
        if (i + 3 < 16) PV_LD(i + 3);
        o[i & 3] = __builtin_amdgcn_mfma_f32_32x32x16_bf16(pa[i >> 2], vf[i & 3], o[i & 3], 0, 0, 0);
        __builtin_amdgcn_sched_barrier(0);
    }
#undef PV_LD
}
template <bool WITH_O>
__device__ __forceinline__ void softmax_step(float& m, float& l, f32x16 (&o)[4], f32x16& p0, f32x16& p1, LAS float* wsf, int r32, int hi) {
    float mx = fmaxf(p0[0], p1[0]);
#pragma unroll
    for (int r = 1; r < 16; ++r) mx = fmaxf(mx, fmaxf(p0[r], p1[r]));
    mx = fmaxf(mx, __shfl_xor(mx, 32));
    const bool grow = __any(mx > m + 8.f);
    const float mnew = grow ? fmaxf(m, mx) : m;
    const float f = grow ? __builtin_amdgcn_exp2f(m - mnew) : 1.f;
    m = mnew;
    float s = 0.f;
#pragma unroll
    for (int r = 0; r < 16; ++r) { p0[r] = __builtin_amdgcn_exp2f(p0[r] - mnew); p1[r] = __builtin_amdgcn_exp2f(p1[r] - mnew); s += p0[r] + p1[r]; }
    l = l * f + s;
    if (WITH_O) {
        if (grow) {
            if (hi == 0) wsf[r32] = f;
            asm volatile("s_waitcnt lgkmcnt(0)" ::: "memory");
#pragma unroll
            for (int r = 0; r < 16; ++r) { const float fr = wsf[crow(r, hi)];
#pragma unroll
                for (int db = 0; db < 4; ++db) o[db][r] *= fr; }
        }
    }
}
__device__ __forceinline__ void row_factors(float (&fr)[16], float fac, LAS float* wsf, int r32, int hi) {
    if (hi == 0) wsf[r32] = fac;
    asm volatile("s_waitcnt lgkmcnt(0)" ::: "memory");
#pragma unroll
    for (int r = 0; r < 16; ++r) fr[r] = wsf[crow(r, hi)];
    asm volatile("s_waitcnt lgkmcnt(0)" ::: "memory");
}

constexpr int KRS_MLA = 400, KRS_NSA = 272;
struct AttnPtrs { unsigned char* ws; const float* gate_b; };
#define OPQ_WS(name) GAS unsigned char* name = (GAS unsigned char*)P.ws; asm volatile("" : "+s"(name))
#define WSP(T, base, off) ((GAS T*)((base) + (off)))

__device__ __forceinline__ void mla_unit(int h, int qb, LAS unsigned char* lds, LAS float* wsf, const AttnPtrs& P) {
    int tid = threadIdx.x; asm volatile("" : "+v"(tid)); const int lane = tid & 63, w = __builtin_amdgcn_readfirstlane(tid >> 6), r32 = lane & 31, hi = lane >> 5;
    const int qrow = qb * 256 + w * 32 + r32;
    bf16x8 qf[12];
    OPQ_WS(wsl);
    { const GAS bf16_t* qp = WSP(const bf16_t, wsl, WS_QM) + ((size_t)h * M + qrow) * 192 + 8 * hi;
#pragma unroll
      for (int ks = 0; ks < 12; ++ks) qf[ks] = *(const GAS bf16x8*)(qp + 16 * ks); }
    asm volatile("s_waitcnt vmcnt(0)" ::: "memory");
#pragma unroll
    for (int ks = 0; ks < 12; ++ks) asm volatile("" : "+v"(qf[ks]));
    float m = -1e30f, l = 0.f; f32x16 o[4];
#pragma unroll
    for (int db = 0; db < 4; ++db)
#pragma unroll
        for (int r = 0; r < 16; ++r) o[db][r] = 0.f;
    TileSrc src{WSP(const bf16_t, wsl, WS_KN) + (size_t)h * M * 128, WSP(const bf16_t, wsl, WS_KR), WSP(const bf16_t, wsl, WS_VT) + (size_t)h * 128 * M, M};
    const int qmin = qb * 256 + w * 32;
    flash_loop<KRS_MLA, true, true>(lds, src, 0, 4 * qb + 4, tid, [&](int t, const LAS unsigned char* buf, auto&& mid) __attribute__((always_inline)) {
        const bool act = 64 * t <= qmin + 31;
        f32x16 p0, p1;
        if (act) {
            qk_tile<12, KRS_MLA>(p0, p1, buf, qf, r32, hi);
            if (64 * t + 63 > qmin) {
#pragma unroll
                for (int r = 0; r < 16; ++r) { const int key = 64 * t + crow(r, hi); if (key > qrow) p0[r] = -INFINITY; if (key + 32 > qrow) p1[r] = -INFINITY; }
            }
            softmax_step<true>(m, l, o, p0, p1, wsf, r32, hi);
        }
        mid();
        if (act) pv_tile(o, p0, p1, buf + 64 * KRS_MLA, r32, hi);
    });
    const float lt = l + __shfl_xor(l, 32);
    float fr[16]; row_factors(fr, 1.f / fmaxf(lt, 1e-30f), wsf, r32, hi);
    OPQ_WS(wso);
#pragma unroll
    for (int r = 0; r < 16; ++r) { GAS bf16_t* op = WSP(bf16_t, wso, WS_XB) + (size_t)(qb * 256 + w * 32 + crow(r, hi)) * DM + h * 128 + r32;
#pragma unroll
        for (int db = 0; db < 4; ++db) op[32 * db] = (bf16_t)(pk2(o[db][r] * fr[r], 0.f) & 0xffffu); }
}

constexpr int IMP_OFF = 2 * (64 * KRS_NSA + 128 * VRS);
constexpr int IMP_RS = 257;
constexpr int SEL_OFF = IMP_OFF + 64 * IMP_RS * 4;
constexpr int UNI_OFF = SEL_OFF + 64 * 8 * 4;
constexpr int WSF_OFF = 143360;

__device__ __forceinline__ unsigned range_mask(int lo, int hi, int k) {
    const int a = lo > 32 * k ? lo : 32 * k, b = hi < 32 * k + 31 ? hi : 32 * k + 31;
    if (a > b) return 0u; const int n = b - a + 1; const unsigned mk = (n >= 32) ? 0xffffffffu : ((1u << n) - 1u); return mk << (a - 32 * k);
}
template <int MODE>
__device__ __forceinline__ void nsa_finish(const f32x16 (&o)[4], float fac, LAS float* wsf, unsigned char* wsb0, int t0, int w, int hk, int tid, int r32, int hi) {
    float fr[16]; row_factors(fr, fac, wsf, r32, hi);
    GAS unsigned char* wsb = (GAS unsigned char*)wsb0; asm volatile("" : "+s"(wsb));
    GAS f32x4* ap = (GAS f32x4*)(WSP(float, wsb, WS_OACC) + (size_t)blockIdx.x * 32768 + (size_t)tid * 64);
    GAS bf16_t* OMIX = WSP(bf16_t, wsb, WS_XB);
#pragma unroll
    for (int db = 0; db < 4; ++db) {
#pragma unroll
        for (int r4 = 0; r4 < 4; ++r4) {
            f32x4 v = {o[db][4 * r4] * fr[4 * r4], o[db][4 * r4 + 1] * fr[4 * r4 + 1], o[db][4 * r4 + 2] * fr[4 * r4 + 2], o[db][4 * r4 + 3] * fr[4 * r4 + 3]};
            if (MODE >= 1) v += ap[db * 4 + r4];
            if (MODE <= 1) ap[db * 4 + r4] = v;
            else {
#pragma unroll
                for (int k = 0; k < 4; ++k) { const int row = crow(4 * r4 + k, hi), tok = t0 + 8 * w + (row >> 2), head = 4 * hk + (row & 3);
                    OMIX[(size_t)tok * DM + 1024 + head * 128 + 32 * db + r32] = (bf16_t)(pk2(v[k], 0.f) & 0xffffu); }
            }
        }
        asm volatile("" ::: "memory");
    }
}
__device__ __forceinline__ float gate_val(const AttnPtrs& P, int tok, int br, int head) {
    OPQ_WS(wsg);
    const float x = bf2f(WSP(const bf16_t, wsg, WS_GL)[(size_t)tok * 32 + br * 8 + head]) + P.gate_b[br * 8 + head];
    return 1.f / (1.f + __builtin_amdgcn_exp2f(-x * 1.4426950408889634f));
}

__device__ __forceinline__ void nsa_unit(int hk, int T, LAS unsigned char* lds, LAS float* wsf, const AttnPtrs& P) {
    int tid = threadIdx.x; asm volatile("" : "+v"(tid)); const int lane = tid & 63, w = __builtin_amdgcn_readfirstlane(tid >> 6), r32 = lane & 31, hi = lane >> 5;
    const int t0 = 64 * T, qi = r32 >> 2, g = r32 & 3, tq = t0 + 8 * w + qi, head = 4 * hk + g;
    LAS float* imp = (LAS float*)(lds + IMP_OFF);
    LAS unsigned* sel = (LAS unsigned*)(lds + SEL_OFF);
    LAS unsigned* uni = (LAS unsigned*)(lds + UNI_OFF);
    bf16x8 qf[8];
    { OPQ_WS(wsq); const GAS bf16_t* qp = WSP(const bf16_t, wsq, WS_QN) + ((size_t)head * M + tq) * 128 + 8 * hi;
#pragma unroll
      for (int ks = 0; ks < 8; ++ks) qf[ks] = *(const GAS bf16x8*)(qp + 16 * ks); }
    asm volatile("s_waitcnt vmcnt(0)" ::: "memory");
#pragma unroll
    for (int ks = 0; ks < 8; ++ks) asm volatile("" : "+v"(qf[ks]));
    const float gate_c = gate_val(P, tq, 0, head), gate_s = gate_val(P, tq, 1, head), gate_w = gate_val(P, tq, 2, head);
    f32x16 o[4];
#define ZERO_O() do { _Pragma("unroll") for (int db = 0; db < 4; ++db) _Pragma("unroll") for (int r = 0; r < 16; ++r) o[db][r] = 0.f; } while (0)
    const int cmaxT = (t0 + 63 >= 31) ? ((t0 + 63 - 31) >> 4) : -1;
    const int NTc = cmaxT >= 0 ? (cmaxT >> 6) + 1 : 0;
    const int mycmax = (tq >= 31) ? ((tq - 31) >> 4) : -1;
    OPQ_WS(wsc);
    TileSrc csrc{WSP(const bf16_t, wsc, WS_KC) + (size_t)hk * 1024 * 128, nullptr, WSP(const bf16_t, wsc, WS_KC) + 2 * 1024 * 128 + (size_t)hk * 128 * 1024, 1024};
    float m = -1e30f, l = 0.f;
    flash_loop<KRS_NSA, false, false>(lds, csrc, 0, NTc, tid, [&](int t, const LAS unsigned char* buf, auto&& mid) __attribute__((always_inline)) {
        f32x16 p0, p1;
        qk_tile<8, KRS_NSA>(p0, p1, buf, qf, r32, hi);
#pragma unroll
        for (int r = 0; r < 16; ++r) { const int c = 64 * t + crow(r, hi); if (c > mycmax) p0[r] = -INFINITY; if (c + 32 > mycmax) p1[r] = -INFINITY; }
        softmax_step<false>(m, l, o, p0, p1, wsf, r32, hi);
    });
    const float invl = 1.f / fmaxf(l + __shfl_xor(l, 32), 1e-30f);
    for (int i = tid; i < 64 * IMP_RS; i += NTHREADS) imp[i] = 0.f;
    __syncthreads();
    ZERO_O();
    flash_loop<KRS_NSA, false, false>(lds, csrc, 0, NTc, tid, [&](int t, const LAS unsigned char* buf, auto&& mid) __attribute__((always_inline)) {
        f32x16 p0, p1;
        qk_tile<8, KRS_NSA>(p0, p1, buf, qf, r32, hi);
#pragma unroll
        for (int r = 0; r < 16; ++r) { const int c = 64 * t + crow(r, hi);
            p0[r] = (c > mycmax) ? 0.f : __builtin_amdgcn_exp2f(p0[r] - m) * invl;
            p1[r] = (c + 32 > mycmax) ? 0.f : __builtin_amdgcn_exp2f(p1[r] - m) * invl; }
        float A[8], B[8];
#pragma unroll
        for (int a = 0; a < 4; ++a) {
            A[a] = 2.f * (p0[4 * a] + p0[4 * a + 1] + p0[4 * a + 2]) + p0[4 * a + 3]; B[a] = p0[4 * a + 3];
            A[4 + a] = 2.f * (p1[4 * a] + p1[4 * a + 1] + p1[4 * a + 2]) + p1[4 * a + 3]; B[4 + a] = p1[4 * a + 3]; }
#pragma unroll
        for (int a = 0; a < 8; ++a) {
            A[a] += __int_as_float(__builtin_amdgcn_mov_dpp(__float_as_int(A[a]), 0xB1, 0xF, 0xF, true)); A[a] += __int_as_float(__builtin_amdgcn_mov_dpp(__float_as_int(A[a]), 0x4E, 0xF, 0xF, true));
            B[a] += __int_as_float(__builtin_amdgcn_mov_dpp(__float_as_int(B[a]), 0xB1, 0xF, 0xF, true)); B[a] += __int_as_float(__builtin_amdgcn_mov_dpp(__float_as_int(B[a]), 0x4E, 0xF, 0xF, true)); }
        LAS float* ir = imp + (8 * w + qi) * IMP_RS + 16 * t + hi;
        if (g == 0) {
#pragma unroll
            for (int a = 0; a < 8; ++a) ir[2 * (a & 3) + 8 * (a >> 2)] += A[a];
        }
        asm volatile("s_waitcnt lgkmcnt(0)" ::: "memory");
        if (g == 0) {
#pragma unroll
            for (int a = 0; a < 8; ++a) ir[2 * (a & 3) + 8 * (a >> 2) + 1] += B[a];
        }
        asm volatile("s_waitcnt lgkmcnt(0)" ::: "memory");
        pv_tile(o, p0, p1, buf + 64 * KRS_NSA, r32, hi);
    });
    nsa_finish<0>(o, gate_c, wsf, P.ws, t0, w, hk, tid, r32, hi);
    {
        const int nforced = (T == 0) ? 1 : (T == 1) ? 2 : 3, npick = 16 - nforced, ncand = T - 2 > 0 ? T - 2 : 0;
        unsigned uniword = 0u;
        for (int q = 0; q < 8; ++q) {
            unsigned myword = 0u;
            if (lane < 8) { myword = range_mask(0, 0, lane) | range_mask(T, T, lane); if (T >= 1) myword |= range_mask(T - 1, T - 1, lane); }
            if (ncand <= npick) { if (lane < 8 && ncand > 0) myword |= range_mask(1, T - 2, lane); }
            else {
                const LAS float* irow = imp + (8 * w + q) * IMP_RS;
                unsigned k0 = 0u, k1 = 0u, k2 = 0u, k3 = 0u;
                { int j = lane; if (j >= 1 && j <= T - 2) k0 = __float_as_uint(irow[j]) + 1u; j += 64; if (j <= T - 2) k1 = __float_as_uint(irow[j]) + 1u;
                  j += 64; if (j <= T - 2) k2 = __float_as_uint(irow[j]) + 1u; j += 64; if (j <= T - 2) k3 = __float_as_uint(irow[j]) + 1u; }
                unsigned prefix = 0u;
                for (int bit = 31; bit >= 0; --bit) {
                    const unsigned cand = prefix | (1u << bit);
                    const int cnt = __popcll(__ballot(k0 >= cand)) + __popcll(__ballot(k1 >= cand)) + __popcll(__ballot(k2 >= cand)) + __popcll(__ballot(k3 >= cand));
                    if (cnt >= npick) prefix = cand;
                }
                const unsigned long long g0 = __ballot(k0 > prefix), g1 = __ballot(k1 > prefix), g2 = __ballot(k2 > prefix), g3 = __ballot(k3 > prefix);
                const unsigned long long e0 = __ballot(k0 == prefix), e1 = __ballot(k1 == prefix), e2 = __ballot(k2 == prefix), e3 = __ballot(k3 == prefix);
                const int need = npick - (__popcll(g0) + __popcll(g1) + __popcll(g2) + __popcll(g3));
                const unsigned long long ltm = (lane == 0) ? 0ull : ((~0ull) >> (64 - lane));
                int base = 0;
                const bool c0 = ((e0 >> lane) & 1ull) && (base + __popcll(e0 & ltm) < need); base += __popcll(e0);
                const bool c1 = ((e1 >> lane) & 1ull) && (base + __popcll(e1 & ltm) < need); base += __popcll(e1);
                const bool c2 = ((e2 >> lane) & 1ull) && (base + __popcll(e2 & ltm) < need); base += __popcll(e2);
                const bool c3 = ((e3 >> lane) & 1ull) && (base + __popcll(e3 & ltm) < need);
                const unsigned long long s0 = g0 | __ballot(c0), s1 = g1 | __ballot(c1), s2 = g2 | __ballot(c2), s3 = g3 | __ballot(c3);
                const unsigned long long sm = (lane >> 1) == 0 ? s0 : (lane >> 1) == 1 ? s1 : (lane >> 1) == 2 ? s2 : s3;
                if (lane < 8) myword |= (lane & 1) ? (unsigned)(sm >> 32) : (unsigned)sm;
            }
            if (lane < 8) { sel[(8 * w + q) * 8 + lane] = myword; uniword |= myword; }
        }
        if (lane < 8) uni[w * 8 + lane] = uniword;
        asm volatile("s_waitcnt lgkmcnt(0)" ::: "memory");
    }
    {
        OPQ_WS(wss);
        TileSrc ssrc{WSP(const bf16_t, wss, WS_KS) + (size_t)hk * M * 128, nullptr, WSP(const bf16_t, wss, WS_VTN) + (size_t)(hk * 128) * M, M};
        m = -1e30f; l = 0.f; ZERO_O();
        flash_loop<KRS_NSA, false, true>(lds, ssrc, 0, T + 1, tid, [&](int j, const LAS unsigned char* buf, auto&& mid) __attribute__((always_inline)) {
            const unsigned uw = __builtin_amdgcn_readfirstlane(uni[w * 8 + (j >> 5)]);
            const bool act = ((uw >> (j & 31)) & 1u) != 0u;
            f32x16 p0, p1;
            if (act) {
                qk_tile<8, KRS_NSA>(p0, p1, buf, qf, r32, hi);
                const unsigned mw = sel[(8 * w + qi) * 8 + (j >> 5)];
                const bool mine = (mw >> (j & 31)) & 1u;
#pragma unroll
                for (int r = 0; r < 16; ++r) { const int key = 64 * j + crow(r, hi);
                    if (!mine || key > tq) p0[r] = -INFINITY; if (!mine || key + 32 > tq) p1[r] = -INFINITY; }
                softmax_step<true>(m, l, o, p0, p1, wsf, r32, hi);
            }
            mid();
            if (act) pv_tile(o, p0, p1, buf + 64 * KRS_NSA, r32, hi);
        });
        const float lt = l + __shfl_xor(l, 32);
        nsa_finish<1>(o, gate_s / fmaxf(lt, 1e-30f), wsf, P.ws, t0, w, hk, tid, r32, hi);
    }
    {
        OPQ_WS(wsw);
        TileSrc wsrc{WSP(const bf16_t, wsw, WS_KW) + (size_t)hk * M * 128, nullptr, WSP(const bf16_t, wsw, WS_VTN) + (size_t)(256 + hk * 128) * M, M};
        m = -1e30f; l = 0.f; ZERO_O();
        flash_loop<KRS_NSA, false, true>(lds, wsrc, T >= 8 ? T - 8 : 0, T + 1, tid, [&](int j, const LAS unsigned char* buf, auto&& mid) __attribute__((always_inline)) {
            f32x16 p0, p1;
            qk_tile<8, KRS_NSA>(p0, p1, buf, qf, r32, hi);
            if (j == T || j == T - 8) {
#pragma unroll
                for (int r = 0; r < 16; ++r) { const int key = 64 * j + crow(r, hi);
                    if (key > tq || key <= tq - 512) p0[r] = -INFINITY; if (key + 32 > tq || key + 32 <= tq - 512) p1[r] = -INFINITY; }
            }
            softmax_step<true>(m, l, o, p0, p1, wsf, r32, hi);
            mid();
            pv_tile(o, p0, p1, buf + 64 * KRS_NSA, r32, hi);
        });
        const float lt = l + __shfl_xor(l, 32);
        nsa_finish<2>(o, gate_w / fmaxf(lt, 1e-30f), wsf, P.ws, t0, w, hk, tid, r32, hi);
    }
#undef ZERO_O
}

struct Args { const float* in[26]; float* out; unsigned char* ws; int ph_lo, ph_hi; };
constexpr int N_PHASES = 13;
#ifndef PROBE_REP7
#define PROBE_REP7 1
#endif
#ifndef PROBE_REP1
#define PROBE_REP1 1
#endif

__global__ void __launch_bounds__(NTHREADS) mega_fwd(Args args) {
    extern __shared__ __attribute__((aligned(16))) unsigned char lds_raw[];
    LAS unsigned char* lds = (LAS unsigned char*)lds_raw;
    cg::grid_group grid = cg::this_grid();
    const int G = gridDim.x, bx = blockIdx.x;
#define PHASE_IDS int tid = threadIdx.x; asm volatile("" : "+v"(tid)); const int lane = tid & 63, wave = __builtin_amdgcn_readfirstlane(tid >> 6); \
    const int gw = bx * NWAVES + wave, NGW = G * NWAVES; const int gtid = bx * NTHREADS + tid, NGT = G * NTHREADS; LAS float* scr = (LAS float*)(lds + wave * 17408); \
    (void)lane; (void)gw; (void)NGW; (void)gtid; (void)NGT; (void)scr
    unsigned char* ws = args.ws;
    float* out = args.out;
    bf16_t* WGU = (bf16_t*)(ws + WS_WGU); bf16_t* WD = (bf16_t*)(ws + WS_WD); bf16_t* WIN = (bf16_t*)(ws + WS_WIN); bf16_t* WVN = (bf16_t*)(ws + WS_WVN);
    bf16_t* WUQ = (bf16_t*)(ws + WS_WUQ); bf16_t* WKN = (bf16_t*)(ws + WS_WKN); bf16_t* WVM = (bf16_t*)(ws + WS_WVM); bf16_t* W1K = (bf16_t*)(ws + WS_W1K);
    bf16_t* W1V = (bf16_t*)(ws + WS_W1V); bf16_t* WOUT = (bf16_t*)(ws + WS_WOUT);
    float* TAB128 = (float*)(ws + WS_TAB128); float* TAB64 = (float*)(ws + WS_TAB64); float* SSQ = (float*)(ws + WS_SSQ); float* CBIAS = (float*)(ws + WS_MISC);
    float* HCP = (float*)(ws + WS_HCP); bf16_t* KC = (bf16_t*)(ws + WS_KC); bf16_t* VCT = KC + 2 * 1024 * 128;
    bf16_t* XB = (bf16_t*)(ws + WS_XB); bf16_t* H = (bf16_t*)(ws + WS_H);
    float* PRE3 = (float*)(ws + 384 * MiB);
    bf16_t* D0 = (bf16_t*)out; bf16_t* D1 = D0 + (size_t)M * DM;
    bf16_t* CQ = (bf16_t*)(ws + WS_CQ); bf16_t* CKV = (bf16_t*)(ws + WS_CKV); bf16_t* KR = (bf16_t*)(ws + WS_KR); bf16_t* GL = (bf16_t*)(ws + WS_GL);
    bf16_t* QN = (bf16_t*)(ws + WS_QN); bf16_t* KCR = (bf16_t*)(ws + WS_KCR); bf16_t* VCR = (bf16_t*)(ws + WS_VCR); bf16_t* KS = (bf16_t*)(ws + WS_KS);
    bf16_t* KW = (bf16_t*)(ws + WS_KW); bf16_t* VTN = (bf16_t*)(ws + WS_VTN); bf16_t* QM = (bf16_t*)(ws + WS_QM); bf16_t* KN = (bf16_t*)(ws + WS_KN);
    bf16_t* VT = (bf16_t*)(ws + WS_VT); float* OACC = (float*)(ws + WS_OACC);
    const int lo = args.ph_lo, hi_ph = args.ph_hi;
    unsigned* barctr = (unsigned*)(ws + WS_MISC + 65536); unsigned epoch = 0u;
    grid.sync();
#ifndef ONLY_PHASE
#define ONLY_PHASE -1
#endif
#define IN(k) ((ONLY_PHASE < 0 || ONLY_PHASE == (k)) && lo <= (k) && (k) < hi_ph)
#define SEAM(k) do { if (IN(k) && IN((k) + 1)) { \
        asm volatile("s_waitcnt vmcnt(0)" ::: "memory"); __syncthreads(); epoch += (unsigned)G; \
        if (threadIdx.x == 0) { __builtin_amdgcn_fence(__ATOMIC_RELEASE, "agent"); asm volatile("s_waitcnt vmcnt(0)" ::: "memory"); \
            __hip_atomic_fetch_add(barctr, 1u, __ATOMIC_RELAXED, __HIP_MEMORY_SCOPE_AGENT); \
            while (__hip_atomic_load(barctr, __ATOMIC_RELAXED, __HIP_MEMORY_SCOPE_AGENT) < epoch) __builtin_amdgcn_s_sleep(2); \
            __builtin_amdgcn_fence(__ATOMIC_ACQUIRE, "agent"); asm volatile("s_waitcnt vmcnt(0)" ::: "memory"); } \
        __syncthreads(); } } while (0)

    if (IN(0)) {
        PHASE_IDS;
        transpose_job<MAP_GU>(args.in[1], args.in[2], DFF, nullptr, DM, 2 * DFF, WGU, scr, gw, NGW, lane);
        transpose_job<MAP_PLAIN>(args.in[3], args.in[3], DM, nullptr, DFF, DM, WD, scr, gw, NGW, lane);
        transpose_job<MAP_WIN>(args.in[6], args.in[6], 3416, nullptr, DM, 3072, WIN, scr, gw, NGW, lane);
        transpose_job<MAP_WVN>(args.in[6], args.in[6], 3416, nullptr, DM, 512, WVN, scr, gw, NGW, lane);
        transpose_job<MAP_UQ>(args.in[8], args.in[8], 1536, args.in[7], 512, 1536, WUQ, scr, gw, NGW, lane);
        transpose_job<MAP_UKV0>(args.in[10], args.in[10], 2048, args.in[9], 256, 1024, WKN, scr, gw, NGW, lane);
        transpose_job<MAP_UKV1>(args.in[10], args.in[10], 2048, args.in[9], 256, 1024, WVM, scr, gw, NGW, lane);
        transpose_job<MAP_PLAIN>(args.in[13], args.in[13], 256, nullptr, 4096, 256, W1K, scr, gw, NGW, lane);
        transpose_job<MAP_PLAIN>(args.in[16], args.in[16], 256, nullptr, 4096, 256, W1V, scr, gw, NGW, lane);
        transpose_job<MAP_PLAIN>(args.in[18], args.in[18], DM, nullptr, DM, DM, WOUT, scr, gw, NGW, lane);
        { const float* x = args.in[0];
          const size_t nvec = (size_t)M * DM / 8;
          for (size_t i = gtid; i < nvec; i += (size_t)4 * NGT) {
              f32x4 a[4], b[4];
#pragma unroll
              for (int k = 0; k < 4; ++k) { const size_t ii = i + (size_t)k * NGT; if (ii < nvec) { a[k] = ((const f32x4*)x)[2 * ii]; b[k] = ((const f32x4*)x)[2 * ii + 1]; } }
#pragma unroll
              for (int k = 0; k < 4; ++k) { const size_t ii = i + (size_t)k * NGT; if (ii < nvec) {
                  u32x4 w; w.x = pk2(a[k][0], a[k][1]); w.y = pk2(a[k][2], a[k][3]); w.z = pk2(b[k][0], b[k][1]); w.w = pk2(b[k][2], b[k][3]); ((u32x4*)XB)[ii] = w; } }
          } }
        for (int i = gtid; i < M * 96; i += NGT) {
            int pos, f; double base; float* dst;
            if (i < M * 64) { pos = i >> 6; f = i & 63; base = 0.8659643233600653; dst = TAB128 + 2 * (size_t)i; }
            else { const int k = i - M * 64; pos = k >> 5; f = k & 31; base = 0.7498942093324558; dst = TAB64 + 2 * (size_t)k; }
            double inv = 1.0; for (int e = 0; e < f; ++e) inv *= base;
            const double ang = (double)pos * inv;
            const double kq = __builtin_rint(ang * 0.6366197723675814);
            double y = __builtin_fma(-kq, 1.5707963267948966, ang); y = __builtin_fma(-kq, 6.123233995736766e-17, y);
            const double y2 = y * y;
            double sn = -1.0 / 39916800.0; sn = sn * y2 + 1.0 / 362880.0; sn = sn * y2 - 1.0 / 5040.0; sn = sn * y2 + 1.0 / 120.0; sn = sn * y2 - 1.0 / 6.0; sn = sn * y2 * y + y;
            double cs = 1.0 / 479001600.0; cs = cs * y2 - 1.0 / 3628800.0; cs = cs * y2 + 1.0 / 40320.0; cs = cs * y2 - 1.0 / 720.0; cs = cs * y2 + 1.0 / 24.0; cs = cs * y2 - 0.5; cs = cs * y2 + 1.0;
            const int qd = ((int)((long long)kq & 3));
            double c, s; if (qd == 0) { c = cs; s = sn; } else if (qd == 1) { c = -sn; s = cs; } else if (qd == 2) { c = -cs; s = -sn; } else { c = sn; s = -cs; }
            dst[0] = (float)c; dst[1] = (float)s;
        }
        for (int item = bx; item < 256; item += G) {
            const int kv = item >> 7, n = 2 * (item & 127) + (tid & 1), k0 = (tid >> 1) * 16;
            const float* pe = args.in[kv ? 15 : 12]; const float* w1 = args.in[kv ? 16 : 13];
            float sacc = 0.f;
#pragma unroll
            for (int k = 0; k < 16; ++k) sacc += pe[k0 + k] * w1[(size_t)(k0 + k) * 256 + n];
            LAS float* red = (LAS float*)lds;
            __syncthreads(); red[tid] = sacc; __syncthreads();
            for (int st = 256; st >= 2; st >>= 1) { if (tid < st) red[tid] += red[tid + st]; __syncthreads(); }
            if (tid < 2) CBIAS[kv * 256 + 2 * (item & 127) + tid] = red[tid];
            __syncthreads();
        }
    }
    SEAM(0);
    if (IN(1)) for (int rep1 = 0; rep1 < PROBE_REP1; ++rep1) { pg8::Gemm g{XB, WGU, DM, DM, DM}; pg8::StaticOrder S; S.init(64, 44, G, bx); EpiSwiglu E{H}; pg8::gemm_phase(lds, g, S, E); }
    SEAM(1);
    if (IN(2)) { pg8::Gemm g{H, WD, DFF, DFF, DFF}; pg8::StaticOrder S; S.init(64, 8, G, bx); EpiResidB<false> E{args.in[0], D0, ALPHA, 0.5f}; pg8::gemm_phase(lds, g, S, E); }
    SEAM(2);
    if (IN(3)) {
        PHASE_IDS;
        { f32x4 gq[8], bq[8]; ln_load_gb(gq, bq, args.in[4], args.in[5], lane);
          for (int r = gw; r < M; r += 2 * NGW) { const int r2 = r + NGW; u32x4 xa[4], xb2[4];
#pragma unroll
              for (int j = 0; j < 4; ++j) { xa[j] = *(const u32x4*)(D0 + (size_t)r * DM + 8 * lane + 512 * j); if (r2 < M) xb2[j] = *(const u32x4*)(D0 + (size_t)r2 * DM + 8 * lane + 512 * j); }
              ln_row_b<false>(xa, D1 + (size_t)r * DM, gq, bq, lane); if (r2 < M) ln_row_b<false>(xb2, D1 + (size_t)r2 * DM, gq, bq, lane); } }
        transpose_job<MAP_GU>(args.in[21], args.in[22], DFF, nullptr, DM, 2 * DFF, WGU, scr, gw, NGW, lane);
        transpose_job<MAP_PLAIN>(args.in[23], args.in[23], DM, nullptr, DFF, DM, WD, scr, gw, NGW, lane);
    }
    SEAM(3);
    if (IN(4)) {
        { pg8::Gemm g{D1, WIN, DM, DM, DM}; pg8::StaticOrder S; S.init(64, 12, G, bx);
          EpiWin E{CQ, CKV, KR, GL, QN, KCR, VCR, KS, KW, SSQ, TAB128, TAB64}; pg8::gemm_phase(lds, g, S, E); }
        { pg8::Gemm g{WVN, D1, DM, DM, DM}; pg8::StaticOrder S; S.init(2, 64, G, bx); EpiColBf16 E{VTN, M, nullptr}; pg8::gemm_phase(lds, g, S, E); }
    }
    SEAM(4);
    if (IN(5)) {
        int off = 0;
        for (int job = 0; job < 16; ++job) { const int kv = job >> 3, hk = (job >> 2) & 1, sp = job & 3;
            pg8::Gemm g{(kv ? VCR : KCR) + (size_t)hk * M * 128 + sp * 1024, (kv ? W1V : W1K) + sp * 1024, 2048, 4096, 1024};
            pg8::StaticOrder S; S.init(4, 1, G, (bx + G - (off % G)) % G); EpiF32 E{HCP + (size_t)job * 1024 * 256, 256}; pg8::gemm_phase(lds, g, S, E); off += 4; }
        { pg8::Gemm g{CQ, WUQ, 512, 512, 512}; pg8::StaticOrder S; S.init(64, 6, G, (bx + G - (off % G)) % G); EpiQup E{QM, SSQ, TAB64}; pg8::gemm_phase(lds, g, S, E); off += 384; }
        { pg8::Gemm g{CKV, WKN, 256, 256, 256}; pg8::StaticOrder S; S.init(64, 4, G, (bx + G - (off % G)) % G); EpiKn E{KN, SSQ}; pg8::gemm_phase(lds, g, S, E); off += 256; }
        { pg8::Gemm g{WVM, CKV, 256, 256, 256}; pg8::StaticOrder S; S.init(4, 64, G, (bx + G - (off % G)) % G); EpiColBf16 E{VT, M, SSQ}; pg8::gemm_phase(lds, g, S, E); }
    }
    SEAM(5);
    if (IN(6)) {
        PHASE_IDS;
        LAS float* hid = (LAS float*)lds;
        for (int item = bx; item < 256; item += G) {
            const int kv = item >> 7, hk = (item >> 6) & 1, c0 = 16 * (item & 63);
            const float* hp = HCP + (size_t)((kv * 2 + hk) * 4) * 1024 * 256;
#pragma unroll
            for (int e = 0; e < 8; ++e) { const int idx = tid + 512 * e, c = idx >> 8, n = idx & 255; const size_t o = (size_t)(c0 + c) * 256 + n;
                float s = hp[o] + hp[o + 262144] + hp[o + 524288] + hp[o + 786432] + CBIAS[kv * 256 + n];
                const float u = 0.7978845608028654f * (s + 0.044715f * s * s * s);
                const float e2 = __builtin_amdgcn_exp2f(2.f * u * 1.4426950408889634f);
                const float th = 1.f - 2.f / (e2 + 1.f);
                hid[idx] = 0.5f * s * (1.f + th); }
            __syncthreads();
            const int d = tid & 127, cg4 = tid >> 7; const float* w2 = args.in[kv ? 17 : 14];
            float a0 = 0.f, a1 = 0.f, a2 = 0.f, a3 = 0.f;
#pragma unroll 16
            for (int n = 0; n < 256; ++n) { const float wv = w2[n * 128 + d]; a0 += hid[(4 * cg4) * 256 + n] * wv; a1 += hid[(4 * cg4 + 1) * 256 + n] * wv; a2 += hid[(4 * cg4 + 2) * 256 + n] * wv; a3 += hid[(4 * cg4 + 3) * 256 + n] * wv; }
            float av[4] = {a0, a1, a2, a3};
#pragma unroll
            for (int j = 0; j < 4; ++j) { const int c = c0 + 4 * cg4 + j; const float v = (c == 1023) ? 0.f : av[j]; const bf16_t b = (bf16_t)(pk2(v, 0.f) & 0xffffu);
                if (kv == 0) KC[((size_t)hk * 1024 + c) * 128 + d] = b; else { const int cpos = (c & ~15) | (c & 3) | ((c & 4) << 1) | ((c & 8) >> 1); VCT[((size_t)hk * 128 + d) * 1024 + cpos] = b; } }
            __syncthreads();
        }
    }
    SEAM(6);
    if (IN(7)) {
        PHASE_IDS;
        AttnPtrs P{ws, args.in[11]};
        LAS float* wsf = (LAS float*)(lds + WSF_OFF) + wave * 32;
        for (int rep7 = 0; rep7 < PROBE_REP7; ++rep7)
        for (int c = bx; c < 256; c += G) {
            const int x = c & 7, y = c >> 3;
#ifndef NO_NSA
            { const int hk = x & 1, pair = (x >> 1) * 32 + y;
#pragma unroll 1
              for (int rep = 0; rep < 2; ++rep) nsa_unit(hk, rep ? pair : 255 - pair, lds, wsf, P); }
#endif
#ifndef NO_MLA
            { const int h = x, pair = y;
#pragma unroll 1
              for (int rep = 0; rep < 2; ++rep) mla_unit(h, rep ? pair : 63 - pair, lds, wsf, P); }
#endif
        }
    }
    SEAM(7);
    if (IN(8)) { pg8::Gemm g{XB, WOUT, DM, DM, DM}; pg8::StaticOrder S; S.init(64, 8, G, bx); EpiResidB<true> E{D1, D0, ALPHA, 1.0f}; pg8::gemm_phase(lds, g, S, E); }
    SEAM(8);
    if (IN(9)) { PHASE_IDS; f32x4 gq[8], bq[8]; ln_load_gb(gq, bq, args.in[19], args.in[20], lane); for (int r = gw; r < M; r += 2 * NGW) { const int r2 = r + NGW; u32x4 xa[4], xb2[4];
#pragma unroll
            for (int j = 0; j < 4; ++j) { xa[j] = *(const u32x4*)(D0 + (size_t)r * DM + 8 * lane + 512 * j); if (r2 < M) xb2[j] = *(const u32x4*)(D0 + (size_t)r2 * DM + 8 * lane + 512 * j); }
            ln_row_b<false>(xa, D1 + (size_t)r * DM, gq, bq, lane); if (r2 < M) ln_row_b<false>(xb2, D1 + (size_t)r2 * DM, gq, bq, lane); } }
    SEAM(9);
    if (IN(10)) { pg8::Gemm g{D1, WGU, DM, DM, DM}; pg8::StaticOrder S; S.init(64, 44, G, bx); EpiSwiglu E{H}; pg8::gemm_phase(lds, g, S, E); }
    SEAM(10);
    if (IN(11)) { pg8::Gemm g{H, WD, DFF, DFF, DFF}; pg8::StaticOrder S; S.init(64, 8, G, bx); EpiResidB<true, true> E{D1, PRE3, ALPHA, 0.5f}; pg8::gemm_phase(lds, g, S, E); }
    SEAM(11);
    if (IN(12)) { PHASE_IDS; f32x4 gq[8], bq[8];
#pragma unroll
        for (int j = 0; j < 8; ++j) { gq[j] = ((const f32x4*)args.in[24])[64 * j + lane]; bq[j] = ((const f32x4*)args.in[25])[64 * j + lane]; }
        for (int r = gw; r < M; r += NGW) ln_row(PRE3 + (size_t)r * DM, out + (size_t)r * DM, nullptr, gq, bq, lane); }
#undef IN
#undef SEAM
}

#ifndef MK_PER_PHASE
#define MK_PER_PHASE 0
#endif
extern "C" void kernel_launch(void* const* d_in, const int* in_sizes, int n_in, void* d_out, int out_size, void* d_ws, size_t ws_size, hipStream_t stream) {
    static int grid = 0;
    if (grid == 0) {
        if (n_in != 26 || out_size != M * DM || ws_size < 512 * MiB) { fprintf(stderr, "kernel_launch: unexpected shapes (n_in %d out %d ws %zu)\n", n_in, out_size, ws_size); grid = -1; return; }
        int dev = 0, cus = 0, per_cu = 0;
        hipGetDevice(&dev); hipDeviceGetAttribute(&cus, hipDeviceAttributeMultiprocessorCount, dev);
        hipFuncSetAttribute((const void*)mega_fwd, hipFuncAttributeMaxDynamicSharedMemorySize, LDS_BYTES);
        if (hipOccupancyMaxActiveBlocksPerMultiprocessor(&per_cu, (const void*)mega_fwd, NTHREADS, LDS_BYTES) != hipSuccess || per_cu < 1) per_cu = 1;
        (void)hipGetLastError();
        grid = cus * per_cu;
    }
    if (grid < 0) return;
    Args a{};
    for (int i = 0; i < 26; ++i) a.in[i] = (const float*)d_in[i];
    a.out = (float*)d_out; a.ws = (unsigned char*)d_ws;
#if MK_PER_PHASE
    for (int p = 0; p < N_PHASES; ++p) { a.ph_lo = p; a.ph_hi = p + 1; void* kargs[] = {&a};
        hipError_t e = hipLaunchCooperativeKernel((const void*)mega_fwd, dim3(grid), dim3(NTHREADS), kargs, LDS_BYTES, stream);
        if (e != hipSuccess) { fprintf(stderr, "launch failed: %s\n", hipGetErrorString(e)); break; } }
#else
    (void)hipMemsetAsync((unsigned char*)d_ws + WS_MISC + 65536, 0, 256, stream);
    a.ph_lo = 0; a.ph_hi = N_PHASES; void* kargs[] = {&a};
    hipError_t e = hipLaunchCooperativeKernel((const void*)mega_fwd, dim3(grid), dim3(NTHREADS), kargs, LDS_BYTES, stream);
    if (e != hipSuccess) fprintf(stderr, "cooperative launch failed: %s (grid %d)\n", hipGetErrorString(e), grid);
#endif
}
```

```cpp
#include <hip/hip_runtime.h>
#include <hip/hip_cooperative_groups.h>
#include <cstdio>
#include <cstdint>
namespace cg = cooperative_groups;

#define LAS __attribute__((address_space(3)))
#define GAS __attribute__((address_space(1)))
typedef unsigned short bf16_t;
typedef short bf16x8 __attribute__((ext_vector_type(8)));
typedef short s16x4 __attribute__((ext_vector_type(4)));
typedef float f32x2 __attribute__((ext_vector_type(2)));
typedef float f32x4 __attribute__((ext_vector_type(4)));
typedef float f32x16 __attribute__((ext_vector_type(16)));
typedef unsigned u32x4 __attribute__((ext_vector_type(4)));
typedef unsigned u32x2 __attribute__((ext_vector_type(2)));
typedef __bf16 bf16x2_t __attribute__((ext_vector_type(2)));

constexpr int M = 16384, DM = 2048, DFF = 5632;
constexpr float ALPHA = 1.189207115002721f;
constexpr float LN_EPS = 1e-5f, RMS_EPS = 1e-6f;
constexpr float C2M = 0.10411754627697264f;
constexpr float C2N = 0.12751743082459868f;
constexpr int NTHREADS = 512, NWAVES = 8;
constexpr int LDS_BYTES = 147456;

constexpr size_t MiB = 1u << 20;
constexpr size_t WS_WGU = 0, WS_WD = 44 * MiB, WS_WIN = 66 * MiB, WS_WVN = 78 * MiB, WS_WUQ = 80 * MiB, WS_WKN = 82 * MiB,
                 WS_WVM = 83 * MiB, WS_W1K = 84 * MiB, WS_W1V = 86 * MiB, WS_WOUT = 88 * MiB, WS_TAB128 = 96 * MiB, WS_TAB64 = 104 * MiB,
                 WS_SSQ = 108 * MiB, WS_MISC = 110 * MiB, WS_HCP = 111 * MiB, WS_KC = 127 * MiB, WS_XB = 128 * MiB, WS_R = 192 * MiB;
constexpr size_t WS_H = WS_R;
constexpr size_t WS_CQ = 192 * MiB, WS_CKV = 208 * MiB, WS_KR = 216 * MiB, WS_GL = 218 * MiB, WS_QN = 220 * MiB, WS_KCR = 252 * MiB,
                 WS_VCR = 260 * MiB, WS_KS = 268 * MiB, WS_KW = 276 * MiB, WS_VTN = 284 * MiB, WS_QM = 300 * MiB, WS_KN = 348 * MiB,
                 WS_VT = 380 * MiB, WS_OACC = 412 * MiB, WS_END = 460 * MiB;

__device__ __forceinline__ unsigned pk2(float lo, float hi) { f32x2 v = {lo, hi}; bf16x2_t b = __builtin_convertvector(v, bf16x2_t); return __builtin_bit_cast(unsigned, b); }
__device__ __forceinline__ float bf2f(unsigned short h) { return __uint_as_float(((unsigned)h) << 16); }
__device__ __forceinline__ int get_tid0() { return (int)threadIdx.x; }
__device__ __forceinline__ float wave_sum(float v) {
#pragma unroll
    for (int o = 1; o < 64; o <<= 1) v += __shfl_xor(v, o);
    return v;
}

namespace pg8 {
constexpr int BM = 256, BK = 64, HALF = 128, HTB = HALF * BK * 2, STAGE_BYTES = 8 * HTB, NXCD = 8, WGM = 8;
__host__ __device__ __forceinline__ int lds_byte(int r, int c) { const int st = (r >> 4) * 2 + (c >> 5), rr = r & 15, cc = c & 31, ob = rr * 64 + cc * 2; return st * 1024 + (ob ^ (((ob >> 9) & 1) << 5)); }
__host__ __device__ __forceinline__ void stage_rc(int b, int& R, int& C) { const int st = b / 1024, sb = b % 1024, swz = sb ^ (((sb >> 9) & 1) << 5); R = (st >> 1) * 16 + swz / 64; C = (st & 1) * 32 + (swz % 64) / 2; }
__host__ __device__ __forceinline__ int perm32(int rho) { const int n = rho >> 4, i = rho & 15; return 8 * (i >> 2) + 4 * n + (i & 3); }

struct Unit { int pm, pn; };
struct Gemm { const bf16_t* A; const bf16_t* Bt; int lda, ldb, K; };

struct StaticOrder {
    int nM, nN, nwg, G, c;
    __device__ __forceinline__ void init(int nM_, int nN_, int G_, int c_) { nM = nM_; nN = nN_; nwg = nM * nN; G = G_; c = c_; }
    __device__ __forceinline__ bool next(int i, Unit& u) const {
        const long L = (long)i * G + c; if (L >= nwg) return false;
        int wgid = (int)L; { const int q = nwg / NXCD, r = nwg % NXCD, xcd = wgid % NXCD, off = wgid / NXCD; wgid = (xcd < r ? xcd * (q + 1) : r * (q + 1) + (xcd - r) * q) + off; }
        const int nig = WGM * nN, gid = wgid / nig, fm = gid * WGM, gsz = (nM - fm) < WGM ? (nM - fm) : WGM;
        u.pm = fm + ((wgid % nig) % gsz); u.pn = (wgid % nig) / gsz; return true;
    }
};

template <class Epi>
__device__ __forceinline__ void gemm_phase(LAS unsigned char* lds, const Gemm g, const StaticOrder& S, const Epi& E) {
    int tid = threadIdx.x; asm volatile("" : "+v"(tid)); const int wid = __builtin_amdgcn_readfirstlane(tid >> 6), lane = tid & 63, wr = wid >> 2, wc = wid & 3, fr = lane & 15, fq = lane >> 4;
    const int K = g.K, nt = K / BK;
    unsigned voffA[2], voffB[2];
#pragma unroll
    for (int i = 0; i < 2; ++i) { int R, C; stage_rc(tid * 16 + i * 8192, R, C); const int Rb = Epi::PERM ? ((R & ~31) + perm32(R & 31)) : R;
        voffA[i] = (unsigned)(R * g.lda + C) * 2u; voffB[i] = (unsigned)(Rb * g.ldb + C) * 2u; }
    const size_t kstep = (size_t)(BK * 2);
    const size_t hstepA = (size_t)HALF * g.lda * 2, hstepB = (size_t)HALF * g.ldb * 2;
    const size_t tstepA = 2 * hstepA, tstepB = 2 * hstepB;
    const unsigned ldsw = (unsigned)wid * 1024u;
    const int aoff = lds_byte(wr * 64 + fr, fq * 8), boff = lds_byte(wc * 32 + fr, fq * 8);
#define PG8_SA(b, h) (((b) * 2 + (h)) * HTB)
#define PG8_SB(b, h) ((4 + (b) * 2 + (h)) * HTB)
#define PG8_STAGE(bufoff, gbase, voff) do { _Pragma("unroll") for (int _i = 0; _i < 2; ++_i) \
        __builtin_amdgcn_global_load_lds((const unsigned*)((const char*)(gbase) + (voff)[_i]), (LAS unsigned*)(lds + (bufoff) + ldsw + _i * 8192), 16, 0, 0); } while (0)
#define PG8_LDA(dst, b, h) do { _Pragma("unroll") for (int m = 0; m < 4; ++m) _Pragma("unroll") for (int k = 0; k < 2; ++k) dst[m][k] = *(const LAS bf16x8*)(lds + PG8_SA(b, h) + aoff + m * 2048 + k * 1024); } while (0)
#define PG8_LDB(dst, b, h) do { _Pragma("unroll") for (int n = 0; n < 2; ++n) _Pragma("unroll") for (int k = 0; k < 2; ++k) dst[n][k] = *(const LAS bf16x8*)(lds + PG8_SB(b, h) + boff + n * 2048 + k * 1024); } while (0)
#define PG8_MMA(ai, bj, At, Bt) do { __builtin_amdgcn_s_setprio(1); _Pragma("unroll") for (int m = 0; m < 4; ++m) _Pragma("unroll") for (int n = 0; n < 2; ++n) _Pragma("unroll") for (int k = 0; k < 2; ++k) \
        acc[ai][bj][m][n] = __builtin_amdgcn_mfma_f32_16x16x32_bf16(Bt[n][k], At[m][k], acc[ai][bj][m][n], 0, 0, 0); __builtin_amdgcn_s_setprio(0); } while (0)
#define PG8_WAIT_V(n) asm volatile("s_waitcnt vmcnt(" #n ")" ::: "memory")
#define PG8_WAIT_L(n) asm volatile("s_waitcnt lgkmcnt(" #n ")" ::: "memory")
#define PG8_BAR __builtin_amdgcn_s_barrier()
#define PG8_SCHED __builtin_amdgcn_sched_barrier(0)
    Unit cur, nxt; int ui = 0;
    if (!S.next(0, cur)) return;
    f32x4 acc[2][2][4][2];
#pragma unroll
    for (int a = 0; a < 2; ++a)
#pragma unroll
        for (int b = 0; b < 2; ++b)
#pragma unroll
            for (int m = 0; m < 4; ++m)
#pragma unroll
                for (int n = 0; n < 2; ++n) acc[a][b][m][n] = (f32x4){0.f, 0.f, 0.f, 0.f};
    bf16x8 At[4][2], B0[2][2], B1[2][2];
    const char* cA = (const char*)g.A + (size_t)cur.pm * tstepA; const char* cB = (const char*)g.Bt + (size_t)cur.pn * tstepB;
    PG8_STAGE(PG8_SB(0, 0), cB, voffB); PG8_STAGE(PG8_SB(0, 1), cB + hstepB, voffB); PG8_STAGE(PG8_SA(0, 0), cA, voffA); PG8_STAGE(PG8_SA(0, 1), cA + hstepA, voffA);
    if (wr == 1) PG8_BAR;
    PG8_WAIT_V(2); PG8_BAR;
    PG8_STAGE(PG8_SB(1, 0), cB + kstep, voffB); PG8_STAGE(PG8_SA(1, 0), cA + kstep, voffA); PG8_STAGE(PG8_SB(1, 1), cB + hstepB + kstep, voffB);
    PG8_WAIT_V(6); PG8_BAR;
    for (;;) {
        const bool has_next = S.next(ui + 1, nxt);
        const char* nA = has_next ? (const char*)g.A + (size_t)nxt.pm * tstepA : cA; const char* nB = has_next ? (const char*)g.Bt + (size_t)nxt.pn * tstepB : cB;
        for (int t = 0; t < nt; t += 2) {
            const bool last = (t == nt - 2);
            const char* a1 = cA + (size_t)(t + 1) * kstep;
            const char* a2 = last ? nA : cA + (size_t)(t + 2) * kstep; const char* b2 = last ? nB : cB + (size_t)(t + 2) * kstep;
            const char* a3 = a2 + kstep; const char* b3 = b2 + kstep;
            PG8_LDB(B0, 0, 0); PG8_LDB(B1, 0, 1); PG8_SCHED; PG8_LDA(At, 0, 0); PG8_STAGE(PG8_SA(1, 1), a1 + hstepA, voffA);
            PG8_WAIT_V(8); PG8_WAIT_L(0); PG8_BAR; PG8_MMA(0, 0, At, B0); PG8_MMA(0, 1, At, B1); PG8_BAR; PG8_SCHED;
            PG8_LDA(At, 0, 1); PG8_STAGE(PG8_SB(0, 0), b2, voffB); PG8_STAGE(PG8_SB(0, 1), b2 + hstepB, voffB); PG8_STAGE(PG8_SA(0, 0), a2, voffA);
            PG8_WAIT_V(8); PG8_WAIT_L(0); PG8_BAR; PG8_MMA(1, 0, At, B0); PG8_MMA(1, 1, At, B1); PG8_BAR; PG8_SCHED;
            PG8_LDB(B0, 1, 0); PG8_LDB(B1, 1, 1); PG8_SCHED; PG8_LDA(At, 1, 0); PG8_STAGE(PG8_SA(0, 1), a2 + hstepA, voffA);
            PG8_WAIT_V(8); PG8_WAIT_L(0); PG8_BAR; PG8_MMA(0, 0, At, B0); PG8_MMA(0, 1, At, B1); PG8_BAR; PG8_SCHED;
            PG8_LDA(At, 1, 1); PG8_STAGE(PG8_SB(1, 0), b3, voffB); PG8_STAGE(PG8_SB(1, 1), b3 + hstepB, voffB); PG8_STAGE(PG8_SA(1, 0), a3, voffA);
            PG8_WAIT_V(8); PG8_WAIT_L(0); PG8_BAR; PG8_MMA(1, 0, At, B0); PG8_MMA(1, 1, At, B1); PG8_BAR; PG8_SCHED;
        }
        if (wr == 0) PG8_BAR;
        E(acc, cur, wr, wc, fr, fq);
        if (!has_next) break;
#pragma unroll
        for (int a = 0; a < 2; ++a)
#pragma unroll
            for (int b = 0; b < 2; ++b)
#pragma unroll
                for (int m = 0; m < 4; ++m)
#pragma unroll
                    for (int n = 0; n < 2; ++n) acc[a][b][m][n] = (f32x4){0.f, 0.f, 0.f, 0.f};
        cur = nxt; cA = nA; cB = nB; ++ui;
        if (wr == 1) PG8_BAR;
    }
    PG8_WAIT_V(0);
    PG8_BAR;
#undef PG8_SA
#undef PG8_SB
#undef PG8_STAGE
#undef PG8_LDA
#undef PG8_LDB
#undef PG8_MMA
#undef PG8_WAIT_V
#undef PG8_WAIT_L
#undef PG8_BAR
#undef PG8_SCHED
}
}

typedef f32x4 AccT[2][2][4][2];

struct EpiSwiglu {
    static constexpr bool PERM = true;
    bf16_t* H;
    __device__ __forceinline__ void operator()(const AccT& acc, const pg8::Unit& u, int wr, int wc, int fr, int fq) const {
        const int col = u.pn * 128 + wc * 32 + fq * 8;
#pragma unroll
        for (int ai = 0; ai < 2; ++ai)
#pragma unroll
            for (int m = 0; m < 4; ++m) {
                const int row = u.pm * 256 + ai * 128 + wr * 64 + m * 16 + fr;
                float o[8];
#pragma unroll
                for (int n = 0; n < 2; ++n)
#pragma unroll
                    for (int j = 0; j < 4; ++j) { const float gt = acc[ai][0][m][n][j], up = acc[ai][1][m][n][j];
                        const float sg = gt * __builtin_amdgcn_rcpf(1.f + __builtin_amdgcn_exp2f(-gt * 1.4426950408889634f)); o[n * 4 + j] = sg * up; }
                u32x4 w; w.x = pk2(o[0], o[1]); w.y = pk2(o[2], o[3]); w.z = pk2(o[4], o[5]); w.w = pk2(o[6], o[7]);
                *(u32x4*)(H + (size_t)row * DFF + col) = w;
            }
    }
};
struct EpiResid {
    static constexpr bool PERM = false;
    const float* res; float* out; float a, b;
    __device__ __forceinline__ void operator()(const AccT& acc, const pg8::Unit& u, int wr, int wc, int fr, int fq) const {
#pragma unroll
        for (int ai = 0; ai < 2; ++ai)
#pragma unroll
            for (int m = 0; m < 4; ++m) {
                const size_t rowoff = (size_t)(u.pm * 256 + ai * 128 + wr * 64 + m * 16 + fr) * DM + u.pn * 256 + wc * 32 + fq * 4;
#pragma unroll
                for (int bj = 0; bj < 2; ++bj)
#pragma unroll
                    for (int n = 0; n < 2; ++n) { const size_t off = rowoff + bj * 128 + n * 16; const f32x4 r = *(const f32x4*)(res + off);
                        *(f32x4*)(out + off) = r * a + acc[ai][bj][m][n] * b; }
            }
    }
};
template <bool RES_BF16, bool OUT_F32 = false>
struct EpiResidB {
    static constexpr bool PERM = true;
    const void* res; void* out; float a, b;
    __device__ __forceinline__ void operator()(const AccT& acc, const pg8::Unit& u, int wr, int wc, int fr, int fq) const {
#pragma unroll
        for (int ai = 0; ai < 2; ++ai)
#pragma unroll
            for (int m = 0; m < 4; ++m) {
                const size_t rowoff = (size_t)(u.pm * 256 + ai * 128 + wr * 64 + m * 16 + fr) * DM + u.pn * 256 + wc * 32 + fq * 8;
#pragma unroll
                for (int bj = 0; bj < 2; ++bj) { const size_t off = rowoff + bj * 128; float r[8];
                    if (RES_BF16) { const u32x4 w = *(const u32x4*)((const bf16_t*)res + off);
                        r[0] = __uint_as_float(w.x << 16); r[1] = __uint_as_float(w.x & 0xffff0000u); r[2] = __uint_as_float(w.y << 16); r[3] = __uint_as_float(w.y & 0xffff0000u);
                        r[4] = __uint_as_float(w.z << 16); r[5] = __uint_as_float(w.z & 0xffff0000u); r[6] = __uint_as_float(w.w << 16); r[7] = __uint_as_float(w.w & 0xffff0000u); }
                    else { const f32x4 x0 = *(const f32x4*)((const float*)res + off), x1 = *(const f32x4*)((const float*)res + off + 4);
                        r[0] = x0[0]; r[1] = x0[1]; r[2] = x0[2]; r[3] = x0[3]; r[4] = x1[0]; r[5] = x1[1]; r[6] = x1[2]; r[7] = x1[3]; }
                    const f32x4 v0 = acc[ai][bj][m][0], v1 = acc[ai][bj][m][1];
                    if (OUT_F32) { *(f32x4*)((float*)out + off) = (f32x4){r[0] * a + v0[0] * b, r[1] * a + v0[1] * b, r[2] * a + v0[2] * b, r[3] * a + v0[3] * b};
                        *(f32x4*)((float*)out + off + 4) = (f32x4){r[4] * a + v1[0] * b, r[5] * a + v1[1] * b, r[6] * a + v1[2] * b, r[7] * a + v1[3] * b}; }
                    else { u32x4 o; o.x = pk2(r[0] * a + v0[0] * b, r[1] * a + v0[1] * b); o.y = pk2(r[2] * a + v0[2] * b, r[3] * a + v0[3] * b);
                        o.z = pk2(r[4] * a + v1[0] * b, r[5] * a + v1[1] * b); o.w = pk2(r[6] * a + v1[2] * b, r[7] * a + v1[3] * b);
                        *(u32x4*)((bf16_t*)out + off) = o; } }
            }
    }
};
struct EpiF32 {
    static constexpr bool PERM = false;
    float* out; int ld;
    __device__ __forceinline__ void operator()(const AccT& acc, const pg8::Unit& u, int wr, int wc, int fr, int fq) const {
#pragma unroll
        for (int ai = 0; ai < 2; ++ai)
#pragma unroll
            for (int m = 0; m < 4; ++m) {
                const size_t rowoff = (size_t)(u.pm * 256 + ai * 128 + wr * 64 + m * 16 + fr) * ld + u.pn * 256 + wc * 32 + fq * 4;
#pragma unroll
                for (int bj = 0; bj < 2; ++bj)
#pragma unroll
                    for (int n = 0; n < 2; ++n) *(f32x4*)(out + rowoff + bj * 128 + n * 16) = acc[ai][bj][m][n];
            }
    }
};
__device__ __forceinline__ void rope4(const f32x4 x1, const f32x4 x2, const f32x4 t01, const f32x4 t23, float sc, u32x2& lo, u32x2& hi) {
    const float c0 = t01[0], s0 = t01[1], c1 = t01[2], s1 = t01[3], c2 = t23[0], s2 = t23[1], c3 = t23[2], s3 = t23[3];
    const float l0 = (x1[0] * c0 - x2[0] * s0) * sc, l1 = (x1[1] * c1 - x2[1] * s1) * sc, l2 = (x1[2] * c2 - x2[2] * s2) * sc, l3 = (x1[3] * c3 - x2[3] * s3) * sc;
    const float h0 = (x2[0] * c0 + x1[0] * s0) * sc, h1 = (x2[1] * c1 + x1[1] * s1) * sc, h2 = (x2[2] * c2 + x1[2] * s2) * sc, h3 = (x2[3] * c3 + x1[3] * s3) * sc;
    lo.x = pk2(l0, l1); lo.y = pk2(l2, l3); hi.x = pk2(h0, h1); hi.y = pk2(h2, h3);
}
struct EpiWin {
    static constexpr bool PERM = true;
    bf16_t *CQ, *CKV, *KR, *GL, *QN, *KCR, *VCR, *KS, *KW; float* SSQ; const float* tab128; const float* tab64;
    __device__ __forceinline__ void operator()(const AccT& acc, const pg8::Unit& u, int wr, int wc, int fr, int fq) const {
        const int c8 = wc * 32 + fq * 8;
#pragma unroll
        for (int bj = 0; bj < 2; ++bj) {
            const int blk = 2 * u.pn + bj;
            if (blk == 23) continue;
#pragma unroll
            for (int ai = 0; ai < 2; ++ai)
#pragma unroll
                for (int m = 0; m < 4; ++m) {
                    const int row = u.pm * 256 + ai * 128 + wr * 64 + m * 16 + fr;
                    const f32x4 v0 = acc[ai][bj][m][0], v1 = acc[ai][bj][m][1];
                    u32x4 raw; raw.x = pk2(v0[0], v0[1]); raw.y = pk2(v0[2], v0[3]); raw.z = pk2(v1[0], v1[1]); raw.w = pk2(v1[2], v1[3]);
                    if (blk < 6) {
                        bf16_t* dst = (blk < 4) ? CQ + (size_t)row * 512 + blk * 128 + c8 : CKV + (size_t)row * 256 + (blk - 4) * 128 + c8;
                        *(u32x4*)dst = raw;
                        float s = (v0[0] * v0[0] + v0[1] * v0[1]) + (v0[2] * v0[2] + v0[3] * v0[3]) + (v1[0] * v1[0] + v1[1] * v1[1]) + (v1[2] * v1[2] + v1[3] * v1[3]);
                        s += __shfl_xor(s, 16); s += __shfl_xor(s, 32);
                        if (fq == 0) SSQ[(size_t)row * 24 + blk * 4 + wc] = s;
                    } else if (blk == 6) {
                        if (wc < 2) { const int i = wc * 4 + fq; const f32x4* tp = (const f32x4*)(tab64 + ((size_t)row * 32 + 4 * i) * 2);
                            u32x2 lo, hi; rope4(v0, v1, tp[0], tp[1], 1.f, lo, hi);
                            *(u32x2*)(KR + (size_t)row * 64 + 4 * i) = lo; *(u32x2*)(KR + (size_t)row * 64 + 32 + 4 * i) = hi; }
                        else if (wc == 2) { *(u32x4*)(GL + (size_t)row * 32 + fq * 8) = raw; }
                    } else if (blk == 17 || blk == 18) {
                        *(u32x4*)(VCR + ((size_t)(blk - 17) * M + row) * 128 + c8) = raw;
                    } else {
                        const int i = wc * 4 + fq; const f32x4* tp = (const f32x4*)(tab128 + ((size_t)row * 64 + 4 * i) * 2);
                        bf16_t* base; float sc = 1.f;
                        if (blk <= 14) { base = QN + ((size_t)(blk - 7) * M + row) * 128; sc = C2N; }
                        else if (blk <= 16) base = KCR + ((size_t)(blk - 15) * M + row) * 128;
                        else if (blk <= 20) base = KS + ((size_t)(blk - 19) * M + row) * 128;
                        else base = KW + ((size_t)(blk - 21) * M + row) * 128;
                        u32x2 lo, hi; rope4(v0, v1, tp[0], tp[1], sc, lo, hi);
                        *(u32x2*)(base + 4 * i) = lo; *(u32x2*)(base + 64 + 4 * i) = hi;
                    }
                }
        }
    }
};
__device__ __forceinline__ float ssq_sum16(const float* p) { const f32x4 a = *(const f32x4*)p, b = *(const f32x4*)(p + 4), c = *(const f32x4*)(p + 8), d = *(const f32x4*)(p + 12);
    return ((a[0] + a[1]) + (a[2] + a[3])) + ((b[0] + b[1]) + (b[2] + b[3])) + ((c[0] + c[1]) + (c[2] + c[3])) + ((d[0] + d[1]) + (d[2] + d[3])); }
__device__ __forceinline__ float ssq_sum8(const float* p) { const f32x4 a = *(const f32x4*)p, b = *(const f32x4*)(p + 4);
    return ((a[0] + a[1]) + (a[2] + a[3])) + ((b[0] + b[1]) + (b[2] + b[3])); }
struct EpiQup {
    static constexpr bool PERM = true;
    bf16_t* QM; const float* SSQ; const float* tab64;
    __device__ __forceinline__ void operator()(const AccT& acc, const pg8::Unit& u, int wr, int wc, int fr, int fq) const {
        const int c8 = wc * 32 + fq * 8;
#pragma unroll
        for (int ai = 0; ai < 2; ++ai)
#pragma unroll
            for (int m = 0; m < 4; ++m) {
                const int row = u.pm * 256 + ai * 128 + wr * 64 + m * 16 + fr;
                const float rs = C2M / sqrtf(ssq_sum16(SSQ + (size_t)row * 24) * (1.f / 512.f) + RMS_EPS);
#pragma unroll
                for (int bj = 0; bj < 2; ++bj) {
                    const int blk = 2 * u.pn + bj;
                    const f32x4 v0 = acc[ai][bj][m][0] * rs, v1 = acc[ai][bj][m][1] * rs;
                    if (blk < 8) { u32x4 raw; raw.x = pk2(v0[0], v0[1]); raw.y = pk2(v0[2], v0[3]); raw.z = pk2(v1[0], v1[1]); raw.w = pk2(v1[2], v1[3]);
                        *(u32x4*)(QM + ((size_t)blk * M + row) * 192 + c8) = raw; }
                    else { const int head = 2 * (blk - 8) + (wc >> 1), i = (wc & 1) * 4 + fq; const f32x4* tp = (const f32x4*)(tab64 + ((size_t)row * 32 + 4 * i) * 2);
                        u32x2 lo, hi; rope4(v0, v1, tp[0], tp[1], 1.f, lo, hi);
                        bf16_t* base = QM + ((size_t)head * M + row) * 192 + 128;
                        *(u32x2*)(base + 4 * i) = lo; *(u32x2*)(base + 32 + 4 * i) = hi; }
                }
            }
    }
};
struct EpiKn {
    static constexpr bool PERM = true;
    bf16_t* KN; const float* SSQ;
    __device__ __forceinline__ void operator()(const AccT& acc, const pg8::Unit& u, int wr, int wc, int fr, int fq) const {
        const int c8 = wc * 32 + fq * 8;
#pragma unroll
        for (int ai = 0; ai < 2; ++ai)
#pragma unroll
            for (int m = 0; m < 4; ++m) {
                const int row = u.pm * 256 + ai * 128 + wr * 64 + m * 16 + fr;
                const float rs = 1.f / sqrtf(ssq_sum8(SSQ + (size_t)row * 24 + 16) * (1.f / 256.f) + RMS_EPS);
#pragma unroll
                for (int bj = 0; bj < 2; ++bj) {
                    const int blk = 2 * u.pn + bj;
                    const f32x4 v0 = acc[ai][bj][m][0] * rs, v1 = acc[ai][bj][m][1] * rs;
                    u32x4 raw; raw.x = pk2(v0[0], v0[1]); raw.y = pk2(v0[2], v0[3]); raw.z = pk2(v1[0], v1[1]); raw.w = pk2(v1[2], v1[3]);
                    *(u32x4*)(KN + ((size_t)blk * M + row) * 128 + c8) = raw;
                }
            }
    }
};
struct EpiColBf16 {
    static constexpr bool PERM = true;
    bf16_t* out; int ld; const float* SSQ;
    __device__ __forceinline__ void operator()(const AccT& acc, const pg8::Unit& u, int wr, int wc, int fr, int fq) const {
#pragma unroll
        for (int bj = 0; bj < 2; ++bj) {
            const int col = u.pn * 256 + bj * 128 + wc * 32 + fq * 8;
            float cs[8];
#pragma unroll
            for (int j = 0; j < 8; ++j) cs[j] = SSQ ? 1.f / sqrtf(ssq_sum8(SSQ + (size_t)(col + j) * 24 + 16) * (1.f / 256.f) + RMS_EPS) : 1.f;
#pragma unroll
            for (int ai = 0; ai < 2; ++ai)
#pragma unroll
                for (int m = 0; m < 4; ++m) {
                    const int row = u.pm * 256 + ai * 128 + wr * 64 + m * 16 + fr;
                    const f32x4 v0 = acc[ai][bj][m][0], v1 = acc[ai][bj][m][1];
                    u32x2 ra, rb; ra.x = pk2(v0[0] * cs[0], v0[1] * cs[1]); ra.y = pk2(v0[2] * cs[2], v0[3] * cs[3]); rb.x = pk2(v1[0] * cs[4], v1[1] * cs[5]); rb.y = pk2(v1[2] * cs[6], v1[3] * cs[7]);
                    bf16_t* gp = out + (size_t)row * ld + (col & ~15);
                    *(u32x2*)(gp + ((col & 8) ? 4 : 0)) = ra; *(u32x2*)(gp + ((col & 8) ? 12 : 8)) = rb;
                }
        }
    }
};

__device__ __forceinline__ int perm128_d(int p) { const int i = p >> 3, j = p & 7; return (j < 4) ? 4 * i + j : 64 + 4 * i + (j - 4); }
__device__ __forceinline__ int perm64_d(int p) { const int i = p >> 3, j = p & 7; return (j < 4) ? 4 * i + j : 32 + 4 * i + (j - 4); }
enum { MAP_PLAIN = 0, MAP_GU = 1, MAP_WIN = 2, MAP_WVN = 3, MAP_UQ = 4, MAP_UKV0 = 5, MAP_UKV1 = 6 };
template <int MODE> __device__ __forceinline__ int map_col(int n, int& which) {
    which = 0;
    if (MODE == MAP_PLAIN) return n;
    if (MODE == MAP_GU) { const int pn = n >> 8, r = n & 255; which = (r < 128) ? 0 : 1; return 128 * pn + (r & 127); }
    if (MODE == MAP_WIN) { const int blk = n >> 7, p = n & 127; int col = -1;
        if (blk < 4) col = 128 * blk + p;
        else if (blk < 6) col = 512 + 128 * (blk - 4) + p;
        else if (blk == 6) { if (p < 64) col = 768 + perm64_d(p); else if (p < 88) col = 3392 + (p - 64); }
        else if (blk <= 14) col = 832 + 128 * (blk - 7) + perm128_d(p);
        else if (blk <= 16) col = 1856 + 128 * (blk - 15) + perm128_d(p);
        else if (blk <= 18) col = 2112 + 128 * (blk - 17) + p;
        else if (blk <= 20) col = 2368 + 128 * (blk - 19) + perm128_d(p);
        else if (blk <= 22) col = 2880 + 128 * (blk - 21) + perm128_d(p);
        return col; }
    if (MODE == MAP_WVN) { const int blk = n >> 7, p = n & 127; return (blk < 2) ? 2624 + 128 * blk + p : 3136 + 128 * (blk - 2) + p; }
    if (MODE == MAP_UQ) { const int blk = n >> 7, p = n & 127; if (blk < 8) return 192 * blk + p; const int head = 2 * (blk - 8) + (p >> 6); return 192 * head + 128 + perm64_d(p & 63); }
    if (MODE == MAP_UKV0) return 256 * (n >> 7) + (n & 127);
    return 256 * (n >> 7) + 128 + (n & 127);
}
template <int MODE>
__device__ __forceinline__ void transpose_job(const float* src0, const float* src1, int ld, const float* ks, int K, int NR, bf16_t* WT, LAS float* scr, int gw, int NGW, int lane) {
    const int nblk = NR / 32, items = (K / 64) * nblk;
    for (int it = gw; it < items; it += 2 * NGW) {
        const int it2 = it + NGW; const bool has2 = it2 < items;
        const int kbA = it / nblk, nbA = it % nblk, k0A = 64 * kbA, n0A = 32 * nbA;
        const int itb = has2 ? it2 : it; const int kbB = itb / nblk, nbB = itb % nblk, k0B = 64 * kbB, n0B = 32 * nbB;
        int whichA, whichB; const int colA = map_col<MODE>(n0A + (lane & 31), whichA), colB = map_col<MODE>(n0B + (lane & 31), whichB);
        const float* spA = (whichA ? src1 : src0) + (colA >= 0 ? colA : 0); const float* spB = (whichB ? src1 : src0) + (colB >= 0 ? colB : 0);
        float va[32], vb[32];
#pragma unroll
        for (int i = 0; i < 32; ++i) { const int kk = 2 * i + (lane >> 5); va[i] = spA[(size_t)(k0A + kk) * ld]; }
#pragma unroll
        for (int i = 0; i < 32; ++i) { const int kk = 2 * i + (lane >> 5); vb[i] = spB[(size_t)(k0B + kk) * ld]; }
#pragma unroll
        for (int i = 0; i < 32; ++i) { const int kk = 2 * i + (lane >> 5); float v = va[i]; if (ks) v *= ks[k0A + kk]; if (colA < 0) v = 0.f; scr[kk * 33 + (lane & 31)] = v; }
#pragma unroll
        for (int i = 0; i < 32; ++i) { const int kk = 2 * i + (lane >> 5); float v = vb[i]; if (ks) v *= ks[k0B + kk]; if (colB < 0) v = 0.f; scr[2112 + kk * 33 + (lane & 31)] = v; }
        asm volatile("s_waitcnt lgkmcnt(0)" ::: "memory");
        const int c = lane & 7;
#pragma unroll
        for (int j = 0; j < 4; ++j) { const int n = (lane >> 3) + 8 * j; const LAS float* s = scr + (8 * c) * 33 + n;
            u32x4 o; o.x = pk2(s[0 * 33], s[1 * 33]); o.y = pk2(s[2 * 33], s[3 * 33]); o.z = pk2(s[4 * 33], s[5 * 33]); o.w = pk2(s[6 * 33], s[7 * 33]);
            *(u32x4*)(WT + (size_t)(n0A + n) * K + k0A + 8 * c) = o; }
        if (has2) {
#pragma unroll
            for (int j = 0; j < 4; ++j) { const int n = (lane >> 3) + 8 * j; const LAS float* s = scr + 2112 + (8 * c) * 33 + n;
                u32x4 o; o.x = pk2(s[0 * 33], s[1 * 33]); o.y = pk2(s[2 * 33], s[3 * 33]); o.z = pk2(s[4 * 33], s[5 * 33]); o.w = pk2(s[6 * 33], s[7 * 33]);
                *(u32x4*)(WT + (size_t)(n0B + n) * K + k0B + 8 * c) = o; } }
        asm volatile("s_waitcnt lgkmcnt(0)" ::: "memory");
    }
}

__device__ __forceinline__ void ln_row(const f32x4 (&xv)[8], float* xout, bf16_t* xb, const f32x4 (&gq)[8], const f32x4 (&bq)[8], int lane) {
    f32x4 v[8]; float s = 0.f;
#pragma unroll
    for (int j = 0; j < 8; ++j) { v[j] = xv[j]; s += (v[j][0] + v[j][1]) + (v[j][2] + v[j][3]); }
    const float mean = wave_sum(s) * (1.f / DM); float s2 = 0.f;
#pragma unroll
    for (int j = 0; j < 8; ++j) { v[j] = v[j] - mean; s2 += (v[j][0] * v[j][0] + v[j][1] * v[j][1]) + (v[j][2] * v[j][2] + v[j][3] * v[j][3]); }
    const float rstd = 1.f / sqrtf(wave_sum(s2) * (1.f / DM) + LN_EPS);
#pragma unroll
    for (int j = 0; j < 8; ++j) { const f32x4 gg = gq[j], bb = bq[j];
        const f32x4 y = v[j] * rstd * gg + bb;
        ((f32x4*)xout)[64 * j + lane] = y;
        if (xb) { u32x2 w; w.x = pk2(y[0], y[1]); w.y = pk2(y[2], y[3]); ((u32x2*)xb)[64 * j + lane] = w; } }
}

__device__ __forceinline__ void ln_load_gb(f32x4 (&gq)[8], f32x4 (&bq)[8], const float* g, const float* b, int lane) {
#pragma unroll
    for (int j = 0; j < 4; ++j) { const int e0 = 8 * lane + 512 * j; gq[2 * j] = *(const f32x4*)(g + e0); gq[2 * j + 1] = *(const f32x4*)(g + e0 + 4); bq[2 * j] = *(const f32x4*)(b + e0); bq[2 * j + 1] = *(const f32x4*)(b + e0 + 4); }
}
template <bool OUT_F32>
__device__ __forceinline__ void ln_row_b(const u32x4 (&xw)[4], void* xout, const f32x4 (&gq)[8], const f32x4 (&bq)[8], int lane) {
    float v[32]; float s = 0.f;
#pragma unroll
    for (int j = 0; j < 4; ++j) { const u32x4 w = xw[j];
        v[8 * j + 0] = __uint_as_float(w.x << 16); v[8 * j + 1] = __uint_as_float(w.x & 0xffff0000u); v[8 * j + 2] = __uint_as_float(w.y << 16); v[8 * j + 3] = __uint_as_float(w.y & 0xffff0000u);
        v[8 * j + 4] = __uint_as_float(w.z << 16); v[8 * j + 5] = __uint_as_float(w.z & 0xffff0000u); v[8 * j + 6] = __uint_as_float(w.w << 16); v[8 * j + 7] = __uint_as_float(w.w & 0xffff0000u); }
#pragma unroll
    for (int i = 0; i < 32; ++i) s += v[i];
    const float mean = wave_sum(s) * (1.f / DM); float s2 = 0.f;
#pragma unroll
    for (int i = 0; i < 32; ++i) { v[i] -= mean; s2 += v[i] * v[i]; }
    const float rstd = 1.f / sqrtf(wave_sum(s2) * (1.f / DM) + LN_EPS);
#pragma unroll
    for (int j = 0; j < 4; ++j) { const int e0 = 8 * lane + 512 * j;
        const f32x4 g0 = gq[2 * j], g1 = gq[2 * j + 1], b0 = bq[2 * j], b1 = bq[2 * j + 1];
        float y[8];
#pragma unroll
        for (int k = 0; k < 4; ++k) { y[k] = v[8 * j + k] * rstd * g0[k] + b0[k]; y[4 + k] = v[8 * j + 4 + k] * rstd * g1[k] + b1[k]; }
        if (OUT_F32) { *(f32x4*)((float*)xout + e0) = (f32x4){y[0], y[1], y[2], y[3]}; *(f32x4*)((float*)xout + e0 + 4) = (f32x4){y[4], y[5], y[6], y[7]}; }
        else { u32x4 w; w.x = pk2(y[0], y[1]); w.y = pk2(y[2], y[3]); w.z = pk2(y[4], y[5]); w.w = pk2(y[6], y[7]); *(u32x4*)((bf16_t*)xout + e0) = w; } }
}
__device__ __forceinline__ int crow(int r, int hi) { return (r & 3) + 8 * (r >> 2) + 4 * hi; }
constexpr int VRS = 144;

struct TileSrc { const GAS bf16_t* K; const GAS bf16_t* KX; const GAS bf16_t* VT; int ldv; };

template <int KRS, bool HAS_X>
struct TileRegs { u32x4 k0, k1, kx, v0, v1; };

template <int KRS, bool HAS_X>
__device__ __forceinline__ void tile_load(TileRegs<KRS, HAS_X>& R, const TileSrc& s, int t, int tid) {
    const GAS bf16_t* kp = s.K + (size_t)t * 64 * 128 + tid * 8;
    R.k0 = *(const GAS u32x4*)kp; R.k1 = *(const GAS u32x4*)(kp + 4096);
    if (HAS_X) R.kx = *(const GAS u32x4*)(s.KX + (size_t)t * 64 * 64 + tid * 8);
    const int d = tid >> 3, ch = tid & 7;
    const GAS bf16_t* vp = s.VT + (size_t)d * s.ldv + t * 64 + ch * 8;
    R.v0 = *(const GAS u32x4*)vp; R.v1 = *(const GAS u32x4*)(vp + (size_t)64 * s.ldv);
}
template <int KRS, bool HAS_X>
__device__ __forceinline__ void tile_store(const TileRegs<KRS, HAS_X>& R, LAS unsigned char* buf, int tid) {
    { const int row = tid >> 4, col = tid & 15; *(LAS u32x4*)(buf + row * KRS + col * 16) = R.k0; *(LAS u32x4*)(buf + (row + 32) * KRS + col * 16) = R.k1; }
    if (HAS_X) { const int row = tid >> 3, col = tid & 7; *(LAS u32x4*)(buf + row * KRS + 256 + col * 16) = R.kx; }
    { const int d = tid >> 3, ch = tid & 7; LAS unsigned char* vb = buf + 64 * KRS + d * VRS + ch * 16;
      *(LAS u32x4*)(vb) = R.v0; *(LAS u32x4*)(vb + 64 * VRS) = R.v1; }
}
template <int KRS, bool HAS_X, bool MIDSTORE, class Body>
__device__ __forceinline__ void flash_loop(LAS unsigned char* lds, const TileSrc& src, int tb, int te, int tid, Body&& body) {
    constexpr int BUFB = 64 * KRS + 128 * VRS;
    if (tb >= te) return;
    TileRegs<KRS, HAS_X> R;
    { TileRegs<KRS, HAS_X> R0;
      tile_load<KRS, HAS_X>(R0, src, tb, tid); if (tb + 1 < te) tile_load<KRS, HAS_X>(R, src, tb + 1, tid);
      tile_store<KRS, HAS_X>(R0, lds, tid); }
    __syncthreads();
    for (int t = tb; t < te; ++t) {
        const int cur = (t - tb) & 1;
        if (t + 1 < te) tile_store<KRS, HAS_X>(R, lds + (cur ^ 1) * BUFB, tid);
        if (t + 2 < te) tile_load<KRS, HAS_X>(R, src, t + 2, tid);
        body(t, (const LAS unsigned char*)(lds + cur * BUFB), []() __attribute__((always_inline)) {});
        __syncthreads();
    }
}
template <int NKS, int KRS>
__device__ __forceinline__ void qk_tile(f32x16& p0, f32x16& p1, const LAS unsigned char* Kt, const bf16x8 (&qf)[NKS], int r32, int hi) {
    const LAS unsigned char* kb = Kt + r32 * KRS + hi * 16;
#pragma unroll
    for (int r = 0; r < 16; ++r) { p0[r] = 0.f; p1[r] = 0.f; }
    bf16x8 a0[3], a1[3];
    a0[0] = *(const LAS bf16x8*)(kb); a1[0] = *(const LAS bf16x8*)(kb + 32 * KRS);
    a0[1] = *(const LAS bf16x8*)(kb + 32); a1[1] = *(const LAS bf16x8*)(kb + 32 * KRS + 32);
    __builtin_amdgcn_sched_barrier(0);
#pragma unroll
    for (int ks = 0; ks < NKS; ++ks) {
        if (ks + 2 < NKS) { a0[(ks + 2) % 3] = *(const LAS bf16x8*)(kb + (ks + 2) * 32); a1[(ks + 2) % 3] = *(const LAS bf16x8*)(kb + 32 * KRS + (ks + 2) * 32); }
        p0 = __builtin_amdgcn_mfma_f32_32x32x16_bf16(a0[ks % 3], qf[ks], p0, 0, 0, 0);
        p1 = __builtin_amdgcn_mfma_f32_32x32x16_bf16(a1[ks % 3], qf[ks], p1, 0, 0, 0);
        __builtin_amdgcn_sched_barrier(0);
    }
}
__device__ __forceinline__ void pv_tile(f32x16 (&o)[4], const f32x16& p0, const f32x16& p1, const LAS unsigned char* Vt, int r32, int hi) {
    bf16x8 pa[4];
#pragma unroll
    for (int s = 0; s < 4; ++s) { const int b = 8 * (s & 1); u32x4 w;
        if (s < 2) { w.x = pk2(p0[b], p0[b + 1]); w.y = pk2(p0[b + 2], p0[b + 3]); w.z = pk2(p0[b + 4], p0[b + 5]); w.w = pk2(p0[b + 6], p0[b + 7]); }
        else { w.x = pk2(p1[b], p1[b + 1]); w.y = pk2(p1[b + 2], p1[b + 3]); w.z = pk2(p1[b + 4], p1[b + 5]); w.w = pk2(p1[b + 6], p1[b + 7]); }
        pa[s] = __builtin_bit_cast(bf16x8, w); }
    const LAS unsigned char* vb2 = Vt + r32 * VRS + hi * 16;
    bf16x8 vf[4];
#define PV_LD(i_) do { vf[(i_) & 3] = *(const LAS bf16x8*)(vb2 + ((i_) & 3) * 32 * VRS + ((i_) >> 2) * 32); } while (0)
    PV_LD(0); PV_LD(1); PV_LD(2);
    __builtin_amdgcn_sched_barrier(0);
#pragma unroll
    for (int i = 0; i < 16; ++i) {
        if (i + 3 < 16) PV_LD(i + 3);
        o[i & 3] = __builtin_amdgcn_mfma_f32_32x32x16_bf16(pa[i >> 2], vf[i & 3], o[i & 3], 0, 0, 0);
        __builtin_amdgcn_sched_barrier(0);
    }
#undef PV_LD
}
template <bool WITH_O>
__device__ __forceinline__ void softmax_step(float& m, float& l, f32x16 (&o)[4], f32x16& p0, f32x16& p1, LAS float* wsf, int r32, int hi) {
    float mx = fmaxf(p0[0], p1[0]);
#pragma unroll
    for (int r = 1; r < 16; ++r) mx = fmaxf(mx, fmaxf(p0[r], p1[r]));
    mx = fmaxf(mx, __shfl_xor(mx, 32));
    const bool grow = __any(mx > m + 8.f);
    const float mnew = grow ? fmaxf(m, mx) : m;
    const float f = grow ? __builtin_amdgcn_exp2f(m - mnew) : 1.f;
    m = mnew;
    float s = 0.f;
#pragma unroll
    for (int r = 0; r < 16; ++r) { p0[r] = __builtin_amdgcn_exp2f(p0[r] - mnew); p1[r] = __builtin_amdgcn_exp2f(p1[r] - mnew); s += p0[r] + p1[r]; }
    l = l * f + s;
    if (WITH_O) {
        if (grow) {
            if (hi == 0) wsf[r32] = f;
            asm volatile("s_waitcnt lgkmcnt(0)" ::: "memory");
#pragma unroll
            for (int r = 0; r < 16; ++r) { const float fr = wsf[crow(r, hi)];
#pragma unroll
                for (int db = 0; db < 4; ++db) o[db][r] *= fr; }
        }
    }
}
__device__ __forceinline__ void row_factors(float (&fr)[16], float fac, LAS float* wsf, int r32, int hi) {
    if (hi == 0) wsf[r32] = fac;
    asm volatile("s_waitcnt lgkmcnt(0)" ::: "memory");
#pragma unroll
    for (int r = 0; r < 16; ++r) fr[r] = wsf[crow(r, hi)];
    asm volatile("s_waitcnt lgkmcnt(0)" ::: "memory");
}

constexpr int KRS_MLA = 400, KRS_NSA = 272;
struct AttnPtrs { unsigned char* ws; const float* gate_b; };
#define OPQ_WS(name) GAS unsigned char* name = (GAS unsigned char*)P.ws; asm volatile("" : "+s"(name))
#define WSP(T, base, off) ((GAS T*)((base) + (off)))

__device__ __forceinline__ void mla_unit(int h, int qb, LAS unsigned char* lds, LAS float* wsf, const AttnPtrs& P) {
    int tid = threadIdx.x; asm volatile("" : "+v"(tid)); const int lane = tid & 63, w = __builtin_amdgcn_readfirstlane(tid >> 6), r32 = lane & 31, hi = lane >> 5;
    const int qrow = qb * 256 + w * 32 + r32;
    bf16x8 qf[12];
    OPQ_WS(wsl);
    { const GAS bf16_t* qp = WSP(const bf16_t, wsl, WS_QM) + ((size_t)h * M + qrow) * 192 + 8 * hi;
#pragma unroll
      for (int ks = 0; ks < 12; ++ks) qf[ks] = *(const GAS bf16x8*)(qp + 16 * ks); }
    asm volatile("s_waitcnt vmcnt(0)" ::: "memory");
#pragma unroll
    for (int ks = 0; ks < 12; ++ks) asm volatile("" : "+v"(qf[ks]));
    float m = -1e30f, l = 0.f; f32x16 o[4];
#pragma unroll
    for (int db = 0; db < 4; ++db)
#pragma unroll
        for (int r = 0; r < 16; ++r) o[db][r] = 0.f;
    TileSrc src{WSP(const bf16_t, wsl, WS_KN) + (size_t)h * M * 128, WSP(const bf16_t, wsl, WS_KR), WSP(const bf16_t, wsl, WS_VT) + (size_t)h * 128 * M, M};
    const int qmin = qb * 256 + w * 32;
    flash_loop<KRS_MLA, true, true>(lds, src, 0, 4 * qb + 4, tid, [&](int t, const LAS unsigned char* buf, auto&& mid) __attribute__((always_inline)) {
        const bool act = 64 * t <= qmin + 31;
        f32x16 p0, p1;
        if (act) {
            qk_tile<12, KRS_MLA>(p0, p1, buf, qf, r32, hi);
            if (64 * t + 63 > qmin) {
#pragma unroll
                for (int r = 0; r < 16; ++r) { const int key = 64 * t + crow(r, hi); if (key > qrow) p0[r] = -INFINITY; if (key + 32 > qrow) p1[r] = -INFINITY; }
            }
            softmax_step<true>(m, l, o, p0, p1, wsf, r32, hi);
        }
        mid();
        if (act) pv_tile(o, p0, p1, buf + 64 * KRS_MLA, r32, hi);
    });
    const float lt = l + __shfl_xor(l, 32);
    float fr[16]; row_factors(fr, 1.f / fmaxf(lt, 1e-30f), wsf, r32, hi);
    OPQ_WS(wso);
#pragma unroll
    for (int r = 0; r < 16; ++r) { GAS bf16_t* op = WSP(bf16_t, wso, WS_XB) + (size_t)(qb * 256 + w * 32 + crow(r, hi)) * DM + h * 128 + r32;
#pragma unroll
        for (int db = 0; db < 4; ++db) op[32 * db] = (bf16_t)(pk2(o[db][r] * fr[r], 0.f) & 0xffffu); }
}

constexpr int IMP_OFF = 2 * (64 * KRS_NSA + 128 * VRS);
constexpr int IMP_RS = 257;
constexpr int SEL_OFF = IMP_OFF + 64 * IMP_RS * 4;
constexpr int UNI_OFF = SEL_OFF + 64 * 8 * 4;
constexpr int WSF_OFF = 143360;

__device__ __forceinline__ unsigned range_mask(int lo, int hi, int k) {
    const int a = lo > 32 * k ? lo : 32 * k, b = hi < 32 * k + 31 ? hi : 32 * k + 31;
    if (a > b) return 0u; const int n = b - a + 1; const unsigned mk = (n >= 32) ? 0xffffffffu : ((1u << n) - 1u); return mk << (a - 32 * k);
}
template <int MODE>
__device__ __forceinline__ void nsa_finish(const f32x16 (&o)[4], float fac, LAS float* wsf, unsigned char* wsb0, int t0, int w, int hk, int tid, int r32, int hi) {
    float fr[16]; row_factors(fr, fac, wsf, r32, hi);
    GAS unsigned char* wsb = (GAS unsigned char*)wsb0; asm volatile("" : "+s"(wsb));
    GAS f32x4* ap = (GAS f32x4*)(WSP(float, wsb, WS_OACC) + (size_t)blockIdx.x * 32768 + (size_t)tid * 64);
    GAS bf16_t* OMIX = WSP(bf16_t, wsb, WS_XB);
#pragma unroll
    for (int db = 0; db < 4; ++db) {
#pragma unroll
        for (int r4 = 0; r4 < 4; ++r4) {
            f32x4 v = {o[db][4 * r4] * fr[4 * r4], o[db][4 * r4 + 1] * fr[4 * r4 + 1], o[db][4 * r4 + 2] * fr[4 * r4 + 2], o[db][4 * r4 + 3] * fr[4 * r4 + 3]};
            if (MODE >= 1) v += ap[db * 4 + r4];
            if (MODE <= 1) ap[db * 4 + r4] = v;
            else {
#pragma unroll
                for (int k = 0; k < 4; ++k) { const int row = crow(4 * r4 + k, hi), tok = t0 + 8 * w + (row >> 2), head = 4 * hk + (row & 3);
                    OMIX[(size_t)tok * DM + 1024 + head * 128 + 32 * db + r32] = (bf16_t)(pk2(v[k], 0.f) & 0xffffu); }
            }
        }
        asm volatile("" ::: "memory");
    }
}
__device__ __forceinline__ float gate_val(const AttnPtrs& P, int tok, int br, int head) {
    OPQ_WS(wsg);
    const float x = bf2f(WSP(const bf16_t, wsg, WS_GL)[(size_t)tok * 32 + br * 8 + head]) + P.gate_b[br * 8 + head];
    return 1.f / (1.f + __builtin_amdgcn_exp2f(-x * 1.4426950408889634f));
}

__device__ __forceinline__ void nsa_unit(int hk, int T, LAS unsigned char* lds, LAS float* wsf, const AttnPtrs& P) {
    int tid = threadIdx.x; asm volatile("" : "+v"(tid)); const int lane = tid & 63, w = __builtin_amdgcn_readfirstlane(tid >> 6), r32 = lane & 31, hi = lane >> 5;
    const int t0 = 64 * T, qi = r32 >> 2, g = r32 & 3, tq = t0 + 8 * w + qi, head = 4 * hk + g;
    LAS float* imp = (LAS float*)(lds + IMP_OFF);
    LAS unsigned* sel = (LAS unsigned*)(lds + SEL_OFF);
    LAS unsigned* uni = (LAS unsigned*)(lds + UNI_OFF);
    bf16x8 qf[8];
    { OPQ_WS(wsq); const GAS bf16_t* qp = WSP(const bf16_t, wsq, WS_QN) + ((size_t)head * M + tq) * 128 + 8 * hi;
#pragma unroll
      for (int ks = 0; ks < 8; ++ks) qf[ks] = *(const GAS bf16x8*)(qp + 16 * ks); }
    asm volatile("s_waitcnt vmcnt(0)" ::: "memory");
#pragma unroll
    for (int ks = 0; ks < 8; ++ks) asm volatile("" : "+v"(qf[ks]));
    const float gate_c = gate_val(P, tq, 0, head), gate_s = gate_val(P, tq, 1, head), gate_w = gate_val(P, tq, 2, head);
    f32x16 o[4];
#define ZERO_O() do { _Pragma("unroll") for (int db = 0; db < 4; ++db) _Pragma("unroll") for (int r = 0; r < 16; ++r) o[db][r] = 0.f; } while (0)
    const int cmaxT = (t0 + 63 >= 31) ? ((t0 + 63 - 31) >> 4) : -1;
    const int NTc = cmaxT >= 0 ? (cmaxT >> 6) + 1 : 0;
    const int mycmax = (tq >= 31) ? ((tq - 31) >> 4) : -1;
    OPQ_WS(wsc);
    TileSrc csrc{WSP(const bf16_t, wsc, WS_KC) + (size_t)hk * 1024 * 128, nullptr, WSP(const bf16_t, wsc, WS_KC) + 2 * 1024 * 128 + (size_t)hk * 128 * 1024, 1024};
    float m = -1e30f, l = 0.f;
    flash_loop<KRS_NSA, false, false>(lds, csrc, 0, NTc, tid, [&](int t, const LAS unsigned char* buf, auto&& mid) __attribute__((always_inline)) {
        f32x16 p0, p1;
        qk_tile<8, KRS_NSA>(p0, p1, buf, qf, r32, hi);
#pragma unroll
        for (int r = 0; r < 16; ++r) { const int c = 64 * t + crow(r, hi); if (c > mycmax) p0[r] = -INFINITY; if (c + 32 > mycmax) p1[r] = -INFINITY; }
        softmax_step<false>(m, l, o, p0, p1, wsf, r32, hi);
    });
    const float invl = 1.f / fmaxf(l + __shfl_xor(l, 32), 1e-30f);
    for (int i = tid; i < 64 * IMP_RS; i += NTHREADS) imp[i] = 0.f;
    __syncthreads();
    ZERO_O();
    flash_loop<KRS_NSA, false, false>(lds, csrc, 0, NTc, tid, [&](int t, const LAS unsigned char* buf, auto&& mid) __attribute__((always_inline)) {
        f32x16 p0, p1;
        qk_tile<8, KRS_NSA>(p0, p1, buf, qf, r32, hi);
#pragma unroll
        for (int r = 0; r < 16; ++r) { const int c = 64 * t + crow(r, hi);
            p0[r] = (c > mycmax) ? 0.f : __builtin_amdgcn_exp2f(p0[r] - m) * invl;
            p1[r] = (c + 32 > mycmax) ? 0.f : __builtin_amdgcn_exp2f(p1[r] - m) * invl; }
        float A[8], B[8];
#pragma unroll
        for (int a = 0; a < 4; ++a) {
            A[a] = 2.f * (p0[4 * a] + p0[4 * a + 1] + p0[4 * a + 2]) + p0[4 * a + 3]; B[a] = p0[4 * a + 3];
            A[4 + a] = 2.f * (p1[4 * a] + p1[4 * a + 1] + p1[4 * a + 2]) + p1[4 * a + 3]; B[4 + a] = p1[4 * a + 3]; }
#pragma unroll
        for (int a = 0; a < 8; ++a) {
            A[a] += __int_as_float(__builtin_amdgcn_mov_dpp(__float_as_int(A[a]), 0xB1, 0xF, 0xF, true)); A[a] += __int_as_float(__builtin_amdgcn_mov_dpp(__float_as_int(A[a]), 0x4E, 0xF, 0xF, true));
            B[a] += __int_as_float(__builtin_amdgcn_mov_dpp(__float_as_int(B[a]), 0xB1, 0xF, 0xF, true)); B[a] += __int_as_float(__builtin_amdgcn_mov_dpp(__float_as_int(B[a]), 0x4E, 0xF, 0xF, true)); }
        LAS float* ir = imp + (8 * w + qi) * IMP_RS + 16 * t + hi;
        if (g == 0) {
#pragma unroll
            for (int a = 0; a < 8; ++a) ir[2 * (a & 3) + 8 * (a >> 2)] += A[a];
        }
        asm volatile("s_waitcnt lgkmcnt(0)" ::: "memory");
        if (g == 0) {
#pragma unroll
            for (int a = 0; a < 8; ++a) ir[2 * (a & 3) + 8 * (a >> 2) + 1] += B[a];
        }
        asm volatile("s_waitcnt lgkmcnt(0)" ::: "memory");
        pv_tile(o, p0, p1, buf + 64 * KRS_NSA, r32, hi);
    });
    nsa_finish<0>(o, gate_c, wsf, P.ws, t0, w, hk, tid, r32, hi);
    {
        const int nforced = (T == 0) ? 1 : (T == 1) ? 2 : 3, npick = 16 - nforced, ncand = T - 2 > 0 ? T - 2 : 0;
        unsigned uniword = 0u;
        for (int q = 0; q < 8; ++q) {
            unsigned myword = 0u;
            if (lane < 8) { myword = range_mask(0, 0, lane) | range_mask(T, T, lane); if (T >= 1) myword |= range_mask(T - 1, T - 1, lane); }
            if (ncand <= npick) { if (lane < 8 && ncand > 0) myword |= range_mask(1, T - 2, lane); }
            else {
                const LAS float* irow = imp + (8 * w + q) * IMP_RS;
                unsigned k0 = 0u, k1 = 0u, k2 = 0u, k3 = 0u;
                { int j = lane; if (j >= 1 && j <= T - 2) k0 = __float_as_uint(irow[j]) + 1u; j += 64; if (j <= T - 2) k1 = __float_as_uint(irow[j]) + 1u;
                  j += 64; if (j <= T - 2) k2 = __float_as_uint(irow[j]) + 1u; j += 64; if (j <= T - 2) k3 = __float_as_uint(irow[j]) + 1u; }
                unsigned prefix = 0u;
                for (int bit = 31; bit >= 0; --bit) {
                    const unsigned cand = prefix | (1u << bit);
                    const int cnt = __popcll(__ballot(k0 >= cand)) + __popcll(__ballot(k1 >= cand)) + __popcll(__ballot(k2 >= cand)) + __popcll(__ballot(k3 >= cand));
                    if (cnt >= npick) prefix = cand;
                }
                const unsigned long long g0 = __ballot(k0 > prefix), g1 = __ballot(k1 > prefix), g2 = __ballot(k2 > prefix), g3 = __ballot(k3 > prefix);
                const unsigned long long e0 = __ballot(k0 == prefix), e1 = __ballot(k1 == prefix), e2 = __ballot(k2 == prefix), e3 = __ballot(k3 == prefix);
                const int need = npick - (__popcll(g0) + __popcll(g1) + __popcll(g2) + __popcll(g3));
                const unsigned long long ltm = (lane == 0) ? 0ull : ((~0ull) >> (64 - lane));
                int base = 0;
                const bool c0 = ((e0 >> lane) & 1ull) && (base + __popcll(e0 & ltm) < need); base += __popcll(e0);
                const bool c1 = ((e1 >> lane) & 1ull) && (base + __popcll(e1 & ltm) < need); base += __popcll(e1);
                const bool c2 = ((e2 >> lane) & 1ull) && (base + __popcll(e2 & ltm) < need); base += __popcll(e2);
                const bool c3 = ((e3 >> lane) & 1ull) && (base + __popcll(e3 & ltm) < need);
                const unsigned long long s0 = g0 | __ballot(c0), s1 = g1 | __ballot(c1), s2 = g2 | __ballot(c2), s3 = g3 | __ballot(c3);
                const unsigned long long sm = (lane >> 1) == 0 ? s0 : (lane >> 1) == 1 ? s1 : (lane >> 1) == 2 ? s2 : s3;
                if (lane < 8) myword |= (lane & 1) ? (unsigned)(sm >> 32) : (unsigned)sm;
            }
            if (lane < 8) { sel[(8 * w + q) * 8 + lane] = myword; uniword |= myword; }
        }
        if (lane < 8) uni[w * 8 + lane] = uniword;
        asm volatile("s_waitcnt lgkmcnt(0)" ::: "memory");
    }
    {
        OPQ_WS(wss);
        TileSrc ssrc{WSP(const bf16_t, wss, WS_KS) + (size_t)hk * M * 128, nullptr, WSP(const bf16_t, wss, WS_VTN) + (size_t)(hk * 128) * M, M};
        m = -1e30f; l = 0.f; ZERO_O();
        flash_loop<KRS_NSA, false, true>(lds, ssrc, 0, T + 1, tid, [&](int j, const LAS unsigned char* buf, auto&& mid) __attribute__((always_inline)) {
            const unsigned uw = __builtin_amdgcn_readfirstlane(uni[w * 8 + (j >> 5)]);
            const bool act = ((uw >> (j & 31)) & 1u) != 0u;
            f32x16 p0, p1;
            if (act) {
                qk_tile<8, KRS_NSA>(p0, p1, buf, qf, r32, hi);
                const unsigned mw = sel[(8 * w + qi) * 8 + (j >> 5)];
                const bool mine = (mw >> (j & 31)) & 1u;
#pragma unroll
                for (int r = 0; r < 16; ++r) { const int key = 64 * j + crow(r, hi);
                    if (!mine || key > tq) p0[r] = -INFINITY; if (!mine || key + 32 > tq) p1[r] = -INFINITY; }
                softmax_step<true>(m, l, o, p0, p1, wsf, r32, hi);
            }
            mid();
            if (act) pv_tile(o, p0, p1, buf + 64 * KRS_NSA, r32, hi);
        });
        const float lt = l + __shfl_xor(l, 32);
        nsa_finish<1>(o, gate_s / fmaxf(lt, 1e-30f), wsf, P.ws, t0, w, hk, tid, r32, hi);
    }
    {
        OPQ_WS(wsw);
        TileSrc wsrc{WSP(const bf16_t, wsw, WS_KW) + (size_t)hk * M * 128, nullptr, WSP(const bf16_t, wsw, WS_VTN) + (size_t)(256 + hk * 128) * M, M};
        m = -1e30f; l = 0.f; ZERO_O();
        flash_loop<KRS_NSA, false, true>(lds, wsrc, T >= 8 ? T - 8 : 0, T + 1, tid, [&](int j, const LAS unsigned char* buf, auto&& mid) __attribute__((always_inline)) {
            f32x16 p0, p1;
            qk_tile<8, KRS_NSA>(p0, p1, buf, qf, r32, hi);
            if (j == T || j == T - 8) {
#pragma unroll
                for (int r = 0; r < 16; ++r) { const int key = 64 * j + crow(r, hi);
                    if (key > tq || key <= tq - 512) p0[r] = -INFINITY; if (key + 32 > tq || key + 32 <= tq - 512) p1[r] = -INFINITY; }
            }
            softmax_step<true>(m, l, o, p0, p1, wsf, r32, hi);
            mid();
            pv_tile(o, p0, p1, buf + 64 * KRS_NSA, r32, hi);
        });
        const float lt = l + __shfl_xor(l, 32);
        nsa_finish<2>(o, gate_w / fmaxf(lt, 1e-30f), wsf, P.ws, t0, w, hk, tid, r32, hi);
    }
#undef ZERO_O
}

struct Args { const float* in[26]; float* out; unsigned char* ws; int ph_lo, ph_hi; };
constexpr int N_PHASES = 13;
#ifndef PROBE_REP7
#define PROBE_REP7 1
#endif
#ifndef PROBE_REP1
#define PROBE_REP1 1
#endif

__global__ void __launch_bounds__(NTHREADS) mega_fwd(Args args) {
    extern __shared__ __attribute__((aligned(16))) unsigned char lds_raw[];
    LAS unsigned char* lds = (LAS unsigned char*)lds_raw;
    cg::grid_group grid = cg::this_grid();
    const int G = gridDim.x, bx = blockIdx.x;
#define PHASE_IDS int tid = threadIdx.x; asm volatile("" : "+v"(tid)); const int lane = tid & 63, wave = __builtin_amdgcn_readfirstlane(tid >> 6); \
    const int gw = bx * NWAVES + wave, NGW = G * NWAVES; const int gtid = bx * NTHREADS + tid, NGT = G * NTHREADS; LAS float* scr = (LAS float*)(lds + wave * 17408); \
    (void)lane; (void)gw; (void)NGW; (void)gtid; (void)NGT; (void)scr
    unsigned char* ws = args.ws;
    float* out = args.out;
    bf16_t* WGU = (bf16_t*)(ws + WS_WGU); bf16_t* WD = (bf16_t*)(ws + WS_WD); bf16_t* WIN = (bf16_t*)(ws + WS_WIN); bf16_t* WVN = (bf16_t*)(ws + WS_WVN);
    bf16_t* WUQ = (bf16_t*)(ws + WS_WUQ); bf16_t* WKN = (bf16_t*)(ws + WS_WKN); bf16_t* WVM = (bf16_t*)(ws + WS_WVM); bf16_t* W1K = (bf16_t*)(ws + WS_W1K);
    bf16_t* W1V = (bf16_t*)(ws + WS_W1V); bf16_t* WOUT = (bf16_t*)(ws + WS_WOUT);
    float* TAB128 = (float*)(ws + WS_TAB128); float* TAB64 = (float*)(ws + WS_TAB64); float* SSQ = (float*)(ws + WS_SSQ); float* CBIAS = (float*)(ws + WS_MISC);
    float* HCP = (float*)(ws + WS_HCP); bf16_t* KC = (bf16_t*)(ws + WS_KC); bf16_t* VCT = KC + 2 * 1024 * 128;
    bf16_t* XB = (bf16_t*)(ws + WS_XB); bf16_t* H = (bf16_t*)(ws + WS_H);
    float* PRE3 = (float*)(ws + 384 * MiB);
    bf16_t* D0 = (bf16_t*)out; bf16_t* D1 = D0 + (size_t)M * DM;
    bf16_t* CQ = (bf16_t*)(ws + WS_CQ); bf16_t* CKV = (bf16_t*)(ws + WS_CKV); bf16_t* KR = (bf16_t*)(ws + WS_KR); bf16_t* GL = (bf16_t*)(ws + WS_GL);
    bf16_t* QN = (bf16_t*)(ws + WS_QN); bf16_t* KCR = (bf16_t*)(ws + WS_KCR); bf16_t* VCR = (bf16_t*)(ws + WS_VCR); bf16_t* KS = (bf16_t*)(ws + WS_KS);
    bf16_t* KW = (bf16_t*)(ws + WS_KW); bf16_t* VTN = (bf16_t*)(ws + WS_VTN); bf16_t* QM = (bf16_t*)(ws + WS_QM); bf16_t* KN = (bf16_t*)(ws + WS_KN);
    bf16_t* VT = (bf16_t*)(ws + WS_VT); float* OACC = (float*)(ws + WS_OACC);
    const int lo = args.ph_lo, hi_ph = args.ph_hi;
    unsigned* barctr = (unsigned*)(ws + WS_MISC + 65536); unsigned epoch = 0u;
    grid.sync();
#ifndef ONLY_PHASE
#define ONLY_PHASE -1
#endif
#define IN(k) ((ONLY_PHASE < 0 || ONLY_PHASE == (k)) && lo <= (k) && (k) < hi_ph)
#define SEAM(k) do { if (IN(k) && IN((k) + 1)) { \
        asm volatile("s_waitcnt vmcnt(0)" ::: "memory"); __syncthreads(); epoch += (unsigned)G; \
        if (threadIdx.x == 0) { __builtin_amdgcn_fence(__ATOMIC_RELEASE, "agent"); asm volatile("s_waitcnt vmcnt(0)" ::: "memory"); \
            __hip_atomic_fetch_add(barctr, 1u, __ATOMIC_RELAXED, __HIP_MEMORY_SCOPE_AGENT); \
            while (__hip_atomic_load(barctr, __ATOMIC_RELAXED, __HIP_MEMORY_SCOPE_AGENT) < epoch) __builtin_amdgcn_s_sleep(2); \
            __builtin_amdgcn_fence(__ATOMIC_ACQUIRE, "agent"); asm volatile("s_waitcnt vmcnt(0)" ::: "memory"); } \
        __syncthreads(); } } while (0)

    if (IN(0)) {
        PHASE_IDS;
        transpose_job<MAP_GU>(args.in[1], args.in[2], DFF, nullptr, DM, 2 * DFF, WGU, scr, gw, NGW, lane);
        transpose_job<MAP_PLAIN>(args.in[3], args.in[3], DM, nullptr, DFF, DM, WD, scr, gw, NGW, lane);
        transpose_job<MAP_WIN>(args.in[6], args.in[6], 3416, nullptr, DM, 3072, WIN, scr, gw, NGW, lane);
        transpose_job<MAP_WVN>(args.in[6], args.in[6], 3416, nullptr, DM, 512, WVN, scr, gw, NGW, lane);
        transpose_job<MAP_UQ>(args.in[8], args.in[8], 1536, args.in[7], 512, 1536, WUQ, scr, gw, NGW, lane);
        transpose_job<MAP_UKV0>(args.in[10], args.in[10], 2048, args.in[9], 256, 1024, WKN, scr, gw, NGW, lane);
        transpose_job<MAP_UKV1>(args.in[10], args.in[10], 2048, args.in[9], 256, 1024, WVM, scr, gw, NGW, lane);
        transpose_job<MAP_PLAIN>(args.in[13], args.in[13], 256, nullptr, 4096, 256, W1K, scr, gw, NGW, lane);
        transpose_job<MAP_PLAIN>(args.in[16], args.in[16], 256, nullptr, 4096, 256, W1V, scr, gw, NGW, lane);
        transpose_job<MAP_PLAIN>(args.in[18], args.in[18], DM, nullptr, DM, DM, WOUT, scr, gw, NGW, lane);
        { const float* x = args.in[0];
          const size_t nvec = (size_t)M * DM / 8;
          for (size_t i = gtid; i < nvec; i += (size_t)4 * NGT) {
              f32x4 a[4], b[4];
#pragma unroll
              for (int k = 0; k < 4; ++k) { const size_t ii = i + (size_t)k * NGT; if (ii < nvec) { a[k] = ((const f32x4*)x)[2 * ii]; b[k] = ((const f32x4*)x)[2 * ii + 1]; } }
#pragma unroll
              for (int k = 0; k < 4; ++k) { const size_t ii = i + (size_t)k * NGT; if (ii < nvec) {
                  u32x4 w; w.x = pk2(a[k][0], a[k][1]); w.y = pk2(a[k][2], a[k][3]); w.z = pk2(b[k][0], b[k][1]); w.w = pk2(b[k][2], b[k][3]); ((u32x4*)XB)[ii] = w; } }
          } }
        for (int i = gtid; i < M * 96; i += NGT) {
            int pos, f; double base; float* dst;
            if (i < M * 64) { pos = i >> 6; f = i & 63; base = 0.8659643233600653; dst = TAB128 + 2 * (size_t)i; }
            else { const int k = i - M * 64; pos = k >> 5; f = k & 31; base = 0.7498942093324558; dst = TAB64 + 2 * (size_t)k; }
            double inv = 1.0; for (int e = 0; e < f; ++e) inv *= base;
            const double ang = (double)pos * inv;
            const double kq = __builtin_rint(ang * 0.6366197723675814);
            double y = __builtin_fma(-kq, 1.5707963267948966, ang); y = __builtin_fma(-kq, 6.123233995736766e-17, y);
            const double y2 = y * y;
            double sn = -1.0 / 39916800.0; sn = sn * y2 + 1.0 / 362880.0; sn = sn * y2 - 1.0 / 5040.0; sn = sn * y2 + 1.0 / 120.0; sn = sn * y2 - 1.0 / 6.0; sn = sn * y2 * y + y;
            double cs = 1.0 / 479001600.0; cs = cs * y2 - 1.0 / 3628800.0; cs = cs * y2 + 1.0 / 40320.0; cs = cs * y2 - 1.0 / 720.0; cs = cs * y2 + 1.0 / 24.0; cs = cs * y2 - 0.5; cs = cs * y2 + 1.0;
            const int qd = ((int)((long long)kq & 3));
            double c, s; if (qd == 0) { c = cs; s = sn; } else if (qd == 1) { c = -sn; s = cs; } else if (qd == 2) { c = -cs; s = -sn; } else { c = sn; s = -cs; }
            dst[0] = (float)c; dst[1] = (float)s;
        }
        for (int item = bx; item < 256; item += G) {
            const int kv = item >> 7, n = 2 * (item & 127) + (tid & 1), k0 = (tid >> 1) * 16;
            const float* pe = args.in[kv ? 15 : 12]; const float* w1 = args.in[kv ? 16 : 13];
            float sacc = 0.f;
#pragma unroll
            for (int k = 0; k < 16; ++k) sacc += pe[k0 + k] * w1[(size_t)(k0 + k) * 256 + n];
            LAS float* red = (LAS float*)lds;
            __syncthreads(); red[tid] = sacc; __syncthreads();
            for (int st = 256; st >= 2; st >>= 1) { if (tid < st) red[tid] += red[tid + st]; __syncthreads(); }
            if (tid < 2) CBIAS[kv * 256 + 2 * (item & 127) + tid] = red[tid];
            __syncthreads();
        }
    }
    SEAM(0);
    if (IN(1)) for (int rep1 = 0; rep1 < PROBE_REP1; ++rep1) { pg8::Gemm g{XB, WGU, DM, DM, DM}; pg8::StaticOrder S; S.init(64, 44, G, bx); EpiSwiglu E{H}; pg8::gemm_phase(lds, g, S, E); }
    SEAM(1);
    if (IN(2)) { pg8::Gemm g{H, WD, DFF, DFF, DFF}; pg8::StaticOrder S; S.init(64, 8, G, bx); EpiResidB<false> E{args.in[0], D0, ALPHA, 0.5f}; pg8::gemm_phase(lds, g, S, E); }
    SEAM(2);
    if (IN(3)) {
        PHASE_IDS;
        { f32x4 gq[8], bq[8]; ln_load_gb(gq, bq, args.in[4], args.in[5], lane);
          for (int r = gw; r < M; r += 2 * NGW) { const int r2 = r + NGW; u32x4 xa[4], xb2[4];
#pragma unroll
              for (int j = 0; j < 4; ++j) { xa[j] = *(const u32x4*)(D0 + (size_t)r * DM + 8 * lane + 512 * j); if (r2 < M) xb2[j] = *(const u32x4*)(D0 + (size_t)r2 * DM + 8 * lane + 512 * j); }
              ln_row_b<false>(xa, D1 + (size_t)r * DM, gq, bq, lane); if (r2 < M) ln_row_b<false>(xb2, D1 + (size_t)r2 * DM, gq, bq, lane); } }
        transpose_job<MAP_GU>(args.in[21], args.in[22], DFF, nullptr, DM, 2 * DFF, WGU, scr, gw, NGW, lane);
        transpose_job<MAP_PLAIN>(args.in[23], args.in[23], DM, nullptr, DFF, DM, WD, scr, gw, NGW, lane);
    }
    SEAM(3);
    if (IN(4)) {
        { pg8::Gemm g{D1, WIN, DM, DM, DM}; pg8::StaticOrder S; S.init(64, 12, G, bx);
          EpiWin E{CQ, CKV, KR, GL, QN, KCR, VCR, KS, KW, SSQ, TAB128, TAB64}; pg8::gemm_phase(lds, g, S, E); }
        { pg8::Gemm g{WVN, D1, DM, DM, DM}; pg8::StaticOrder S; S.init(2, 64, G, bx); EpiColBf16 E{VTN, M, nullptr}; pg8::gemm_phase(lds, g, S, E); }
    }
    SEAM(4);
    if (IN(5)) {
        int off = 0;
        for (int job = 0; job < 16; ++job) { const int kv = job >> 3, hk = (job >> 2) & 1, sp = job & 3;
            pg8::Gemm g{(kv ? VCR : KCR) + (size_t)hk * M * 128 + sp * 1024, (kv ? W1V : W1K) + sp * 1024, 2048, 4096, 1024};
            pg8::StaticOrder S; S.init(4, 1, G, (bx + G - (off % G)) % G); EpiF32 E{HCP + (size_t)job * 1024 * 256, 256}; pg8::gemm_phase(lds, g, S, E); off += 4; }
        { pg8::Gemm g{CQ, WUQ, 512, 512, 512}; pg8::StaticOrder S; S.init(64, 6, G, (bx + G - (off % G)) % G); EpiQup E{QM, SSQ, TAB64}; pg8::gemm_phase(lds, g, S, E); off += 384; }
        { pg8::Gemm g{CKV, WKN, 256, 256, 256}; pg8::StaticOrder S; S.init(64, 4, G, (bx + G - (off % G)) % G); EpiKn E{KN, SSQ}; pg8::gemm_phase(lds, g, S, E); off += 256; }
        { pg8::Gemm g{WVM, CKV, 256, 256, 256}; pg8::StaticOrder S; S.init(4, 64, G, (bx + G - (off % G)) % G); EpiColBf16 E{VT, M, SSQ}; pg8::gemm_phase(lds, g, S, E); }
    }
    SEAM(5);
    if (IN(6)) {
        PHASE_IDS;
        LAS float* hid = (LAS float*)lds;
        for (int item = bx; item < 256; item += G) {
            const int kv = item >> 7, hk = (item >> 6) & 1, c0 = 16 * (item & 63);
            const float* hp = HCP + (size_t)((kv * 2 + hk) * 4) * 1024 * 256;
#pragma unroll
            for (int e = 0; e < 8; ++e) { const int idx = tid + 512 * e, c = idx >> 8, n = idx & 255; const size_t o = (size_t)(c0 + c) * 256 + n;
                float s = hp[o] + hp[o + 262144] + hp[o + 524288] + hp[o + 786432] + CBIAS[kv * 256 + n];
                const float u = 0.7978845608028654f * (s + 0.044715f * s * s * s);
                const float e2 = __builtin_amdgcn_exp2f(2.f * u * 1.4426950408889634f);
                const float th = 1.f - 2.f / (e2 + 1.f);
                hid[idx] = 0.5f * s * (1.f + th); }
            __syncthreads();
            const int d = tid & 127, cg4 = tid >> 7; const float* w2 = args.in[kv ? 17 : 14];
            float a0 = 0.f, a1 = 0.f, a2 = 0.f, a3 = 0.f;
#pragma unroll 16
            for (int n = 0; n < 256; ++n) { const float wv = w2[n * 128 + d]; a0 += hid[(4 * cg4) * 256 + n] * wv; a1 += hid[(4 * cg4 + 1) * 256 + n] * wv; a2 += hid[(4 * cg4 + 2) * 256 + n] * wv; a3 += hid[(4 * cg4 + 3) * 256 + n] * wv; }
            float av[4] = {a0, a1, a2, a3};
#pragma unroll
            for (int j = 0; j < 4; ++j) { const int c = c0 + 4 * cg4 + j; const float v = (c == 1023) ? 0.f : av[j]; const bf16_t b = (bf16_t)(pk2(v, 0.f) & 0xffffu);
                if (kv == 0) KC[((size_t)hk * 1024 + c) * 128 + d] = b; else { const int cpos = (c & ~15) | (c & 3) | ((c & 4) << 1) | ((c & 8) >> 1); VCT[((size_t)hk * 128 + d) * 1024 + cpos] = b; } }
            __syncthreads();
        }
    }
    SEAM(6);
    if (IN(7)) {
        PHASE_IDS;
        AttnPtrs P{ws, args.in[11]};
        LAS float* wsf = (LAS float*)(lds + WSF_OFF) + wave * 32;
        for (int rep7 = 0; rep7 < PROBE_REP7; ++rep7)
        for (int c = bx; c < 256; c += G) {
            const int x = c & 7, y = c >> 3;
#ifndef NO_NSA
            { const int hk = x & 1, pair = (x >> 1) * 32 + y;
#pragma unroll 1
              for (int rep = 0; rep < 2; ++rep) nsa_unit(hk, rep ? pair : 255 - pair, lds, wsf, P); }
#endif
#ifndef NO_MLA
            { const int h = x, pair = y;
#pragma unroll 1
              for (int rep = 0; rep < 2; ++rep) mla_unit(h, rep ? pair : 63 - pair, lds, wsf, P); }
#endif
        }
    }
    SEAM(7);
    if (IN(8)) { pg8::Gemm g{XB, WOUT, DM, DM, DM}; pg8::StaticOrder S; S.init(64, 8, G, bx); EpiResidB<true> E{D1, D0, ALPHA, 1.0f}; pg8::gemm_phase(lds, g, S, E); }
    SEAM(8);
    if (IN(9)) { PHASE_IDS; f32x4 gq[8], bq[8]; ln_load_gb(gq, bq, args.in[19], args.in[20], lane); for (int r = gw; r < M; r += 2 * NGW) { const int r2 = r + NGW; u32x4 xa[4], xb2[4];
#pragma unroll
            for (int j = 0; j < 4; ++j) { xa[j] = *(const u32x4*)(D0 + (size_t)r * DM + 8 * lane + 512 * j); if (r2 < M) xb2[j] = *(const u32x4*)(D0 + (size_t)r2 * DM + 8 * lane + 512 * j); }
            ln_row_b<false>(xa, D1 + (size_t)r * DM, gq, bq, lane); if (r2 < M) ln_row_b<false>(xb2, D1 + (size_t)r2 * DM, gq, bq, lane); } }
    SEAM(9);
    if (IN(10)) { pg8::Gemm g{D1, WGU, DM, DM, DM}; pg8::StaticOrder S; S.init(64, 44, G, bx); EpiSwiglu E{H}; pg8::gemm_phase(lds, g, S, E); }
    SEAM(10);
    if (IN(11)) { pg8::Gemm g{H, WD, DFF, DFF, DFF}; pg8::StaticOrder S; S.init(64, 8, G, bx); EpiResidB<true, true> E{D1, PRE3, ALPHA, 0.5f}; pg8::gemm_phase(lds, g, S, E); }
    SEAM(11);
    if (IN(12)) { PHASE_IDS; f32x4 gq[8], bq[8];
#pragma unroll
        for (int j = 0; j < 8; ++j) { gq[j] = ((const f32x4*)args.in[24])[64 * j + lane]; bq[j] = ((const f32x4*)args.in[25])[64 * j + lane]; }
        for (int r = gw; r < M; r += 2 * NGW) { const int r2 = r + NGW; f32x4 xa[8], xb2[8];
#pragma unroll
            for (int j = 0; j < 8; ++j) { xa[j] = ((const f32x4*)(PRE3 + (size_t)r * DM))[64 * j + lane]; if (r2 < M) xb2[j] = ((const f32x4*)(PRE3 + (size_t)r2 * DM))[64 * j + lane]; }
            ln_row(xa, out + (size_t)r * DM, nullptr, gq, bq, lane); if (r2 < M) ln_row(xb2, out + (size_t)r2 * DM, nullptr, gq, bq, lane); } }
#undef IN
#undef SEAM
}

#ifndef MK_PER_PHASE
#define MK_PER_PHASE 0
#endif
extern "C" void kernel_launch(void* const* d_in, const int* in_sizes, int n_in, void* d_out, int out_size, void* d_ws, size_t ws_size, hipStream_t stream) {
    static int grid = 0;
    if (grid == 0) {
        if (n_in != 26 || out_size != M * DM || ws_size < 512 * MiB) { fprintf(stderr, "kernel_launch: unexpected shapes (n_in %d out %d ws %zu)\n", n_in, out_size, ws_size); grid = -1; return; }
        int dev = 0, cus = 0, per_cu = 0;
        hipGetDevice(&dev); hipDeviceGetAttribute(&cus, hipDeviceAttributeMultiprocessorCount, dev);
        hipFuncSetAttribute((const void*)mega_fwd, hipFuncAttributeMaxDynamicSharedMemorySize, LDS_BYTES);
        if (hipOccupancyMaxActiveBlocksPerMultiprocessor(&per_cu, (const void*)mega_fwd, NTHREADS, LDS_BYTES) != hipSuccess || per_cu < 1) per_cu = 1;
        (void)hipGetLastError();
        grid = cus * per_cu;
    }
    if (grid < 0) return;
    Args a{};
    for (int i = 0; i < 26; ++i) a.in[i] = (const float*)d_in[i];
    a.out = (float*)d_out; a.ws = (unsigned char*)d_ws;
#if MK_PER_PHASE
    for (int p = 0; p < N_PHASES; ++p) { a.ph_lo = p; a.ph_hi = p + 1; void* kargs[] = {&a};
        hipError_t e = hipLaunchCooperativeKernel((const void*)mega_fwd, dim3(grid), dim3(NTHREADS), kargs, LDS_BYTES, stream);
        if (e != hipSuccess) { fprintf(stderr, "launch failed: %s\n", hipGetErrorString(e)); break; } }
#else
    (void)hipMemsetAsync((unsigned char*)d_ws + WS_MISC + 65536, 0, 256, stream);
    a.ph_lo = 0; a.ph_hi = N_PHASES; void* kargs[] = {&a};
    hipError_t e = hipLaunchCooperativeKernel((const void*)mega_fwd, dim3(grid), dim3(NTHREADS), kargs, LDS_BYTES, stream);
    if (e != hipSuccess) fprintf(stderr, "cooperative launch failed: %s (grid %d)\n", hipGetErrorString(e), grid);
#endif
}
```

```cpp
#include <hip/hip_runtime.h>
#include <hip/hip_cooperative_groups.h>
#include <cstdio>
#include <cstdint>
namespace cg = cooperative_groups;

#define LAS __attribute__((address_space(3)))
#define GAS __attribute__((address_space(1)))
typedef unsigned short bf16_t;
typedef short bf16x8 __attribute__((ext_vector_type(8)));
typedef short s16x4 __attribute__((ext_vector_type(4)));
typedef float f32x2 __attribute__((ext_vector_type(2)));
typedef float f32x4 __attribute__((ext_vector_type(4)));
typedef float f32x16 __attribute__((ext_vector_type(16)));
typedef unsigned u32x4 __attribute__((ext_vector_type(4)));
typedef unsigned u32x2 __attribute__((ext_vector_type(2)));
typedef __bf16 bf16x2_t __attribute__((ext_vector_type(2)));

constexpr int M = 16384, DM = 2048, DFF = 5632;
constexpr float ALPHA = 1.189207115002721f;
constexpr float LN_EPS = 1e-5f, RMS_EPS = 1e-6f;
constexpr float C2M = 0.10411754627697264f;
constexpr float C2N = 0.12751743082459868f;
constexpr int NTHREADS = 512, NWAVES = 8;
constexpr int LDS_BYTES = 147456;

constexpr size_t MiB = 1u << 20;
constexpr size_t WS_WGU = 0, WS_WD = 44 * MiB, WS_WIN = 66 * MiB, WS_WVN = 78 * MiB, WS_WUQ = 80 * MiB, WS_WKN = 82 * MiB,
                 WS_WVM = 83 * MiB, WS_W1K = 84 * MiB, WS_W1V = 86 * MiB, WS_WOUT = 88 * MiB, WS_TAB128 = 96 * MiB, WS_TAB64 = 104 * MiB,
                 WS_SSQ = 108 * MiB, WS_MISC = 110 * MiB, WS_HCP = 111 * MiB, WS_KC = 127 * MiB, WS_XB = 128 * MiB, WS_R = 192 * MiB;
constexpr size_t WS_H = WS_R;
constexpr size_t WS_CQ = 192 * MiB, WS_CKV = 208 * MiB, WS_KR = 216 * MiB, WS_GL = 218 * MiB, WS_QN = 220 * MiB, WS_KCR = 252 * MiB,
                 WS_VCR = 260 * MiB, WS_KS = 268 * MiB, WS_KW = 276 * MiB, WS_VTN = 284 * MiB, WS_QM = 300 * MiB, WS_KN = 348 * MiB,
                 WS_VT = 380 * MiB, WS_OACC = 412 * MiB, WS_END = 460 * MiB;

__device__ __forceinline__ unsigned pk2(float lo, float hi) { f32x2 v = {lo, hi}; bf16x2_t b = __builtin_convertvector(v, bf16x2_t); return __builtin_bit_cast(unsigned, b); }
__device__ __forceinline__ float bf2f(unsigned short h) { return __uint_as_float(((unsigned)h) << 16); }
__device__ __forceinline__ int get_tid0() { return (int)threadIdx.x; }
__device__ __forceinline__ float wave_sum(float v) {
#pragma unroll
    for (int o = 1; o < 64; o <<= 1) v += __shfl_xor(v, o);
    return v;
}

namespace pg8 {
constexpr int BM = 256, BK = 64, HALF = 128, HTB = HALF * BK * 2, STAGE_BYTES = 8 * HTB, NXCD = 8, WGM = 8;
__host__ __device__ __forceinline__ int lds_byte(int r, int c) { const int st = (r >> 4) * 2 + (c >> 5), rr = r & 15, cc = c & 31, ob = rr * 64 + cc * 2; return st * 1024 + (ob ^ (((ob >> 9) & 1) << 5)); }
__host__ __device__ __forceinline__ void stage_rc(int b, int& R, int& C) { const int st = b / 1024, sb = b % 1024, swz = sb ^ (((sb >> 9) & 1) << 5); R = (st >> 1) * 16 + swz / 64; C = (st & 1) * 32 + (swz % 64) / 2; }
__host__ __device__ __forceinline__ int perm32(int rho) { const int n = rho >> 4, i = rho & 15; return 8 * (i >> 2) + 4 * n + (i & 3); }

struct Unit { int pm, pn; };
struct Gemm { const bf16_t* A; const bf16_t* Bt; int lda, ldb, K; };

struct StaticOrder {
    int nM, nN, nwg, G, c;
    __device__ __forceinline__ void init(int nM_, int nN_, int G_, int c_) { nM = nM_; nN = nN_; nwg = nM * nN; G = G_; c = c_; }
    __device__ __forceinline__ bool next(int i, Unit& u) const {
        const long L = (long)i * G + c; if (L >= nwg) return false;
        int wgid = (int)L; { const int q = nwg / NXCD, r = nwg % NXCD, xcd = wgid % NXCD, off = wgid / NXCD; wgid = (xcd < r ? xcd * (q + 1) : r * (q + 1) + (xcd - r) * q) + off; }
        const int nig = WGM * nN, gid = wgid / nig, fm = gid * WGM, gsz = (nM - fm) < WGM ? (nM - fm) : WGM;
        u.pm = fm + ((wgid % nig) % gsz); u.pn = (wgid % nig) / gsz; return true;
    }
};

template <class Epi>
__device__ __forceinline__ void gemm_phase(LAS unsigned char* lds, const Gemm g, const StaticOrder& S, const Epi& E) {
    int tid = threadIdx.x; asm volatile("" : "+v"(tid)); const int wid = __builtin_amdgcn_readfirstlane(tid >> 6), lane = tid & 63, wr = wid >> 2, wc = wid & 3, fr = lane & 15, fq = lane >> 4;
    const int K = g.K, nt = K / BK;
    unsigned voffA[2], voffB[2];
#pragma unroll
    for (int i = 0; i < 2; ++i) { int R, C; stage_rc(tid * 16 + i * 8192, R, C); const int Rb = Epi::PERM ? ((R & ~31) + perm32(R & 31)) : R;
        voffA[i] = (unsigned)(R * g.lda + C) * 2u; voffB[i] = (unsigned)(Rb * g.ldb + C) * 2u; }
    const size_t kstep = (size_t)(BK * 2);
    const size_t hstepA = (size_t)HALF * g.lda * 2, hstepB = (size_t)HALF * g.ldb * 2;
    const size_t tstepA = 2 * hstepA, tstepB = 2 * hstepB;
    const unsigned ldsw = (unsigned)wid * 1024u;
    const int aoff = lds_byte(wr * 64 + fr, fq * 8), boff = lds_byte(wc * 32 + fr, fq * 8);
#define PG8_SA(b, h) (((b) * 2 + (h)) * HTB)
#define PG8_SB(b, h) ((4 + (b) * 2 + (h)) * HTB)
#define PG8_STAGE(bufoff, gbase, voff) do { _Pragma("unroll") for (int _i = 0; _i < 2; ++_i) \
        __builtin_amdgcn_global_load_lds((const unsigned*)((const char*)(gbase) + (voff)[_i]), (LAS unsigned*)(lds + (bufoff) + ldsw + _i * 8192), 16, 0, 0); } while (0)
#define PG8_LDA(dst, b, h) do { _Pragma("unroll") for (int m = 0; m < 4; ++m) _Pragma("unroll") for (int k = 0; k < 2; ++k) dst[m][k] = *(const LAS bf16x8*)(lds + PG8_SA(b, h) + aoff + m * 2048 + k * 1024); } while (0)
#define PG8_LDB(dst, b, h) do { _Pragma("unroll") for (int n = 0; n < 2; ++n) _Pragma("unroll") for (int k = 0; k < 2; ++k) dst[n][k] = *(const LAS bf16x8*)(lds + PG8_SB(b, h) + boff + n * 2048 + k * 1024); } while (0)
#define PG8_MMA(ai, bj, At, Bt) do { __builtin_amdgcn_s_setprio(1); _Pragma("unroll") for (int m = 0; m < 4; ++m) _Pragma("unroll") for (int n = 0; n < 2; ++n) _Pragma("unroll") for (int k = 0; k < 2; ++k) \
        acc[ai][bj][m][n] = __builtin_amdgcn_mfma_f32_16x16x32_bf16(Bt[n][k], At[m][k], acc[ai][bj][m][n], 0, 0, 0); __builtin_amdgcn_s_setprio(0); } while (0)
#define PG8_WAIT_V(n) asm volatile("s_waitcnt vmcnt(" #n ")" ::: "memory")
#define PG8_WAIT_L(n) asm volatile("s_waitcnt lgkmcnt(" #n ")" ::: "memory")
#define PG8_BAR __builtin_amdgcn_s_barrier()
#define PG8_SCHED __builtin_amdgcn_sched_barrier(0)
    Unit cur, nxt; int ui = 0;
    if (!S.next(0, cur)) return;
    f32x4 acc[2][2][4][2];
#pragma unroll
    for (int a = 0; a < 2; ++a)
#pragma unroll
        for (int b = 0; b < 2; ++b)
#pragma unroll
            for (int m = 0; m < 4; ++m)
#pragma unroll
                for (int n = 0; n < 2; ++n) acc[a][b][m][n] = (f32x4){0.f, 0.f, 0.f, 0.f};
    bf16x8 At[4][2], B0[2][2], B1[2][2];
    const char* cA = (const char*)g.A + (size_t)cur.pm * tstepA; const char* cB = (const char*)g.Bt + (size_t)cur.pn * tstepB;
    PG8_STAGE(PG8_SB(0, 0), cB, voffB); PG8_STAGE(PG8_SB(0, 1), cB + hstepB, voffB); PG8_STAGE(PG8_SA(0, 0), cA, voffA); PG8_STAGE(PG8_SA(0, 1), cA + hstepA, voffA);
    if (wr == 1) PG8_BAR;
    PG8_WAIT_V(2); PG8_BAR;
    PG8_STAGE(PG8_SB(1, 0), cB + kstep, voffB); PG8_STAGE(PG8_SA(1, 0), cA + kstep, voffA); PG8_STAGE(PG8_SB(1, 1), cB + hstepB + kstep, voffB);
    PG8_WAIT_V(6); PG8_BAR;
    for (;;) {
        const bool has_next = S.next(ui + 1, nxt);
        const char* nA = has_next ? (const char*)g.A + (size_t)nxt.pm * tstepA : cA; const char* nB = has_next ? (const char*)g.Bt + (size_t)nxt.pn * tstepB : cB;
        for (int t = 0; t < nt; t += 2) {
            const bool last = (t == nt - 2);
            const char* a1 = cA + (size_t)(t + 1) * kstep;
            const char* a2 = last ? nA : cA + (size_t)(t + 2) * kstep; const char* b2 = last ? nB : cB + (size_t)(t + 2) * kstep;
            const char* a3 = a2 + kstep; const char* b3 = b2 + kstep;
            PG8_LDB(B0, 0, 0); PG8_LDB(B1, 0, 1); PG8_SCHED; PG8_LDA(At, 0, 0); PG8_STAGE(PG8_SA(1, 1), a1 + hstepA, voffA);
            PG8_WAIT_V(8); PG8_WAIT_L(0); PG8_BAR; PG8_MMA(0, 0, At, B0); PG8_MMA(0, 1, At, B1); PG8_BAR; PG8_SCHED;
            PG8_LDA(At, 0, 1); PG8_STAGE(PG8_SB(0, 0), b2, voffB); PG8_STAGE(PG8_SB(0, 1), b2 + hstepB, voffB); PG8_STAGE(PG8_SA(0, 0), a2, voffA);
            PG8_WAIT_V(8); PG8_WAIT_L(0); PG8_BAR; PG8_MMA(1, 0, At, B0); PG8_MMA(1, 1, At, B1); PG8_BAR; PG8_SCHED;
            PG8_LDB(B0, 1, 0); PG8_LDB(B1, 1, 1); PG8_SCHED; PG8_LDA(At, 1, 0); PG8_STAGE(PG8_SA(0, 1), a2 + hstepA, voffA);
            PG8_WAIT_V(8); PG8_WAIT_L(0); PG8_BAR; PG8_MMA(0, 0, At, B0); PG8_MMA(0, 1, At, B1); PG8_BAR; PG8_SCHED;
            PG8_LDA(At, 1, 1); PG8_STAGE(PG8_SB(1, 0), b3, voffB); PG8_STAGE(PG8_SB(1, 1), b3 + hstepB, voffB); PG8_STAGE(PG8_SA(1, 0), a3, voffA);
            PG8_WAIT_V(8); PG8_WAIT_L(0); PG8_BAR; PG8_MMA(1, 0, At, B0); PG8_MMA(1, 1, At, B1); PG8_BAR; PG8_SCHED;
        }
        if (wr == 0) PG8_BAR;
        E(acc, cur, wr, wc, fr, fq);
        if (!has_next) break;
#pragma unroll
        for (int a = 0; a < 2; ++a)
#pragma unroll
            for (int b = 0; b < 2; ++b)
#pragma unroll
                for (int m = 0; m < 4; ++m)
#pragma unroll
                    for (int n = 0; n < 2; ++n) acc[a][b][m][n] = (f32x4){0.f, 0.f, 0.f, 0.f};
        cur = nxt; cA = nA; cB = nB; ++ui;
        if (wr == 1) PG8_BAR;
    }
    PG8_WAIT_V(0);
    PG8_BAR;
#undef PG8_SA
#undef PG8_SB
#undef PG8_STAGE
#undef PG8_LDA
#undef PG8_LDB
#undef PG8_MMA
#undef PG8_WAIT_V
#undef PG8_WAIT_L
#undef PG8_BAR
#undef PG8_SCHED
}
}

typedef f32x4 AccT[2][2][4][2];

struct EpiSwiglu {
    static constexpr bool PERM = true;
    bf16_t* H;
    __device__ __forceinline__ void operator()(const AccT& acc, const pg8::Unit& u, int wr, int wc, int fr, int fq) const {
        const int col = u.pn * 128 + wc * 32 + fq * 8;
#pragma unroll
        for (int ai = 0; ai < 2; ++ai)
#pragma unroll
            for (int m = 0; m < 4; ++m) {
                const int row = u.pm * 256 + ai * 128 + wr * 64 + m * 16 + fr;
                float o[8];
#pragma unroll
                for (int n = 0; n < 2; ++n)
#pragma unroll
                    for (int j = 0; j < 4; ++j) { const float gt = acc[ai][0][m][n][j], up = acc[ai][1][m][n][j];
                        const float sg = gt * __builtin_amdgcn_rcpf(1.f + __builtin_amdgcn_exp2f(-gt * 1.4426950408889634f)); o[n * 4 + j] = sg * up; }
                u32x4 w; w.x = pk2(o[0], o[1]); w.y = pk2(o[2], o[3]); w.z = pk2(o[4], o[5]); w.w = pk2(o[6], o[7]);
                *(u32x4*)(H + (size_t)row * DFF + col) = w;
            }
    }
};
struct EpiResid {
    static constexpr bool PERM = false;
    const float* res; float* out; float a, b;
    __device__ __forceinline__ void operator()(const AccT& acc, const pg8::Unit& u, int wr, int wc, int fr, int fq) const {
#pragma unroll
        for (int ai = 0; ai < 2; ++ai)
#pragma unroll
            for (int m = 0; m < 4; ++m) {
                const size_t rowoff = (size_t)(u.pm * 256 + ai * 128 + wr * 64 + m * 16 + fr) * DM + u.pn * 256 + wc * 32 + fq * 4;
#pragma unroll
                for (int bj = 0; bj < 2; ++bj)
#pragma unroll
                    for (int n = 0; n < 2; ++n) { const size_t off = rowoff + bj * 128 + n * 16; const f32x4 r = *(const f32x4*)(res + off);
                        *(f32x4*)(out + off) = r * a + acc[ai][bj][m][n] * b; }
            }
    }
};
template <bool RES_BF16, bool OUT_F32 = false>
struct EpiResidB {
    static constexpr bool PERM = true;
    const void* res; void* out; float a, b;
    __device__ __forceinline__ void operator()(const AccT& acc, const pg8::Unit& u, int wr, int wc, int fr, int fq) const {
#pragma unroll
        for (int ai = 0; ai < 2; ++ai)
#pragma unroll
            for (int m = 0; m < 4; ++m) {
                const size_t rowoff = (size_t)(u.pm * 256 + ai * 128 + wr * 64 + m * 16 + fr) * DM + u.pn * 256 + wc * 32 + fq * 8;
#pragma unroll
                for (int bj = 0; bj < 2; ++bj) { const size_t off = rowoff + bj * 128; float r[8];
                    if (RES_BF16) { const u32x4 w = *(const u32x4*)((const bf16_t*)res + off);
                        r[0] = __uint_as_float(w.x << 16); r[1] = __uint_as_float(w.x & 0xffff0000u); r[2] = __uint_as_float(w.y << 16); r[3] = __uint_as_float(w.y & 0xffff0000u);
                        r[4] = __uint_as_float(w.z << 16); r[5] = __uint_as_float(w.z & 0xffff0000u); r[6] = __uint_as_float(w.w << 16); r[7] = __uint_as_float(w.w & 0xffff0000u); }
                    else { const f32x4 x0 = *(const f32x4*)((const float*)res + off), x1 = *(const f32x4*)((const float*)res + off + 4);
                        r[0] = x0[0]; r[1] = x0[1]; r[2] = x0[2]; r[3] = x0[3]; r[4] = x1[0]; r[5] = x1[1]; r[6] = x1[2]; r[7] = x1[3]; }
                    const f32x4 v0 = acc[ai][bj][m][0], v1 = acc[ai][bj][m][1];
                    if (OUT_F32) { *(f32x4*)((float*)out + off) = (f32x4){r[0] * a + v0[0] * b, r[1] * a + v0[1] * b, r[2] * a + v0[2] * b, r[3] * a + v0[3] * b};
                        *(f32x4*)((float*)out + off + 4) = (f32x4){r[4] * a + v1[0] * b, r[5] * a + v1[1] * b, r[6] * a + v1[2] * b, r[7] * a + v1[3] * b}; }
                    else { u32x4 o; o.x = pk2(r[0] * a + v0[0] * b, r[1] * a + v0[1] * b); o.y = pk2(r[2] * a + v0[2] * b, r[3] * a + v0[3] * b);
                        o.z = pk2(r[4] * a + v1[0] * b, r[5] * a + v1[1] * b); o.w = pk2(r[6] * a + v1[2] * b, r[7] * a + v1[3] * b);
                        *(u32x4*)((bf16_t*)out + off) = o; } }
            }
    }
};
struct EpiF32 {
    static constexpr bool PERM = false;
    float* out; int ld;
    __device__ __forceinline__ void operator()(const AccT& acc, const pg8::Unit& u, int wr, int wc, int fr, int fq) const {
#pragma unroll
        for (int ai = 0; ai < 2; ++ai)
#pragma unroll
            for (int m = 0; m < 4; ++m) {
                const size_t rowoff = (size_t)(u.pm * 256 + ai * 128 + wr * 64 + m * 16 + fr) * ld + u.pn * 256 + wc * 32 + fq * 4;
#pragma unroll
                for (int bj = 0; bj < 2; ++bj)
#pragma unroll
                    for (int n = 0; n < 2; ++n) *(f32x4*)(out + rowoff + bj * 128 + n * 16) = acc[ai][bj][m][n];
            }
    }
};
__device__ __forceinline__ void rope4(const f32x4 x1, const f32x4 x2, const f32x4 t01, const f32x4 t23, float sc, u32x2& lo, u32x2& hi) {
    const float c0 = t01[0], s0 = t01[1], c1 = t01[2], s1 = t01[3], c2 = t23[0], s2 = t23[1], c3 = t23[2], s3 = t23[3];
    const float l0 = (x1[0] * c0 - x2[0] * s0) * sc, l1 = (x1[1] * c1 - x2[1] * s1) * sc, l2 = (x1[2] * c2 - x2[2] * s2) * sc, l3 = (x1[3] * c3 - x2[3] * s3) * sc;
    const float h0 = (x2[0] * c0 + x1[0] * s0) * sc, h1 = (x2[1] * c1 + x1[1] * s1) * sc, h2 = (x2[2] * c2 + x1[2] * s2) * sc, h3 = (x2[3] * c3 + x1[3] * s3) * sc;
    lo.x = pk2(l0, l1); lo.y = pk2(l2, l3); hi.x = pk2(h0, h1); hi.y = pk2(h2, h3);
}
struct EpiWin {
    static constexpr bool PERM = true;
    bf16_t *CQ, *CKV, *KR, *GL, *QN, *KCR, *VCR, *KS, *KW; float* SSQ; const float* tab128; const float* tab64;
    __device__ __forceinline__ void operator()(const AccT& acc, const pg8::Unit& u, int wr, int wc, int fr, int fq) const {
        const int c8 = wc * 32 + fq * 8;
#pragma unroll
        for (int bj = 0; bj < 2; ++bj) {
            const int blk = 2 * u.pn + bj;
            if (blk == 23) continue;
#pragma unroll
            for (int ai = 0; ai < 2; ++ai)
#pragma unroll
                for (int m = 0; m < 4; ++m) {
                    const int row = u.pm * 256 + ai * 128 + wr * 64 + m * 16 + fr;
                    const f32x4 v0 = acc[ai][bj][m][0], v1 = acc[ai][bj][m][1];
                    u32x4 raw; raw.x = pk2(v0[0], v0[1]); raw.y = pk2(v0[2], v0[3]); raw.z = pk2(v1[0], v1[1]); raw.w = pk2(v1[2], v1[3]);
                    if (blk < 6) {
                        bf16_t* dst = (blk < 4) ? CQ + (size_t)row * 512 + blk * 128 + c8 : CKV + (size_t)row * 256 + (blk - 4) * 128 + c8;
                        *(u32x4*)dst = raw;
                        float s = (v0[0] * v0[0] + v0[1] * v0[1]) + (v0[2] * v0[2] + v0[3] * v0[3]) + (v1[0] * v1[0] + v1[1] * v1[1]) + (v1[2] * v1[2] + v1[3] * v1[3]);
                        s += __shfl_xor(s, 16); s += __shfl_xor(s, 32);
                        if (fq == 0) SSQ[(size_t)row * 24 + blk * 4 + wc] = s;
                    } else if (blk == 6) {
                        if (wc < 2) { const int i = wc * 4 + fq; const f32x4* tp = (const f32x4*)(tab64 + ((size_t)row * 32 + 4 * i) * 2);
                            u32x2 lo, hi; rope4(v0, v1, tp[0], tp[1], 1.f, lo, hi);
                            *(u32x2*)(KR + (size_t)row * 64 + 4 * i) = lo; *(u32x2*)(KR + (size_t)row * 64 + 32 + 4 * i) = hi; }
                        else if (wc == 2) { *(u32x4*)(GL + (size_t)row * 32 + fq * 8) = raw; }
                    } else if (blk == 17 || blk == 18) {
                        *(u32x4*)(VCR + ((size_t)(blk - 17) * M + row) * 128 + c8) = raw;
                    } else {
                        const int i = wc * 4 + fq; const f32x4* tp = (const f32x4*)(tab128 + ((size_t)row * 64 + 4 * i) * 2);
                        bf16_t* base; float sc = 1.f;
                        if (blk <= 14) { base = QN + ((size_t)(blk - 7) * M + row) * 128; sc = C2N; }
                        else if (blk <= 16) base = KCR + ((size_t)(blk - 15) * M + row) * 128;
                        else if (blk <= 20) base = KS + ((size_t)(blk - 19) * M + row) * 128;
                        else base = KW + ((size_t)(blk - 21) * M + row) * 128;
                        u32x2 lo, hi; rope4(v0, v1, tp[0], tp[1], sc, lo, hi);
                        *(u32x2*)(base + 4 * i) = lo; *(u32x2*)(base + 64 + 4 * i) = hi;
                    }
                }
        }
    }
};
__device__ __forceinline__ float ssq_sum16(const float* p) { const f32x4 a = *(const f32x4*)p, b = *(const f32x4*)(p + 4), c = *(const f32x4*)(p + 8), d = *(const f32x4*)(p + 12);
    return ((a[0] + a[1]) + (a[2] + a[3])) + ((b[0] + b[1]) + (b[2] + b[3])) + ((c[0] + c[1]) + (c[2] + c[3])) + ((d[0] + d[1]) + (d[2] + d[3])); }
__device__ __forceinline__ float ssq_sum8(const float* p) { const f32x4 a = *(const f32x4*)p, b = *(const f32x4*)(p + 4);
    return ((a[0] + a[1]) + (a[2] + a[3])) + ((b[0] + b[1]) + (b[2] + b[3])); }
struct EpiQup {
    static constexpr bool PERM = true;
    bf16_t* QM; const float* SSQ; const float* tab64;
    __device__ __forceinline__ void operator()(const AccT& acc, const pg8::Unit& u, int wr, int wc, int fr, int fq) const {
        const int c8 = wc * 32 + fq * 8;
#pragma unroll
        for (int ai = 0; ai < 2; ++ai)
#pragma unroll
            for (int m = 0; m < 4; ++m) {
                const int row = u.pm * 256 + ai * 128 + wr * 64 + m * 16 + fr;
                const float rs = C2M / sqrtf(ssq_sum16(SSQ + (size_t)row * 24) * (1.f / 512.f) + RMS_EPS);
#pragma unroll
                for (int bj = 0; bj < 2; ++bj) {
                    const int blk = 2 * u.pn + bj;
                    const f32x4 v0 = acc[ai][bj][m][0] * rs, v1 = acc[ai][bj][m][1] * rs;
                    if (blk < 8) { u32x4 raw; raw.x = pk2(v0[0], v0[1]); raw.y = pk2(v0[2], v0[3]); raw.z = pk2(v1[0], v1[1]); raw.w = pk2(v1[2], v1[3]);
                        *(u32x4*)(QM + ((size_t)blk * M + row) * 192 + c8) = raw; }
                    else { const int head = 2 * (blk - 8) + (wc >> 1), i = (wc & 1) * 4 + fq; const f32x4* tp = (const f32x4*)(tab64 + ((size_t)row * 32 + 4 * i) * 2);
                        u32x2 lo, hi; rope4(v0, v1, tp[0], tp[1], 1.f, lo, hi);
                        bf16_t* base = QM + ((size_t)head * M + row) * 192 + 128;
                        *(u32x2*)(base + 4 * i) = lo; *(u32x2*)(base + 32 + 4 * i) = hi; }
                }
            }
    }
};
struct EpiKn {
    static constexpr bool PERM = true;
    bf16_t* KN; const float* SSQ;
    __device__ __forceinline__ void operator()(const AccT& acc, const pg8::Unit& u, int wr, int wc, int fr, int fq) const {
        const int c8 = wc * 32 + fq * 8;
#pragma unroll
        for (int ai = 0; ai < 2; ++ai)
#pragma unroll
            for (int m = 0; m < 4; ++m) {
                const int row = u.pm * 256 + ai * 128 + wr * 64 + m * 16 + fr;
                const float rs = 1.f / sqrtf(ssq_sum8(SSQ + (size_t)row * 24 + 16) * (1.f / 256.f) + RMS_EPS);
#pragma unroll
                for (int bj = 0; bj < 2; ++bj) {
                    const int blk = 2 * u.pn + bj;
                    const f32x4 v0 = acc[ai][bj][m][0] * rs, v1 = acc[ai][bj][m][1] * rs;
                    u32x4 raw; raw.x = pk2(v0[0], v0[1]); raw.y = pk2(v0[2], v0[3]); raw.z = pk2(v1[0], v1[1]); raw.w = pk2(v1[2], v1[3]);
                    *(u32x4*)(KN + ((size_t)blk * M + row) * 128 + c8) = raw;
                }
            }
    }
};
struct EpiColBf16 {
    static constexpr bool PERM = true;
    bf16_t* out; int ld; const float* SSQ;
    __device__ __forceinline__ void operator()(const AccT& acc, const pg8::Unit& u, int wr, int wc, int fr, int fq) const {
#pragma unroll
        for (int bj = 0; bj < 2; ++bj) {
            const int col = u.pn * 256 + bj * 128 + wc * 32 + fq * 8;
            float cs[8];
#pragma unroll
            for (int j = 0; j < 8; ++j) cs[j] = SSQ ? 1.f / sqrtf(ssq_sum8(SSQ + (size_t)(col + j) * 24 + 16) * (1.f / 256.f) + RMS_EPS) : 1.f;
#pragma unroll
            for (int ai = 0; ai < 2; ++ai)
#pragma unroll
                for (int m = 0; m < 4; ++m) {
                    const int row = u.pm * 256 + ai * 128 + wr * 64 + m * 16 + fr;
                    const f32x4 v0 = acc[ai][bj][m][0], v1 = acc[ai][bj][m][1];
                    u32x2 ra, rb; ra.x = pk2(v0[0] * cs[0], v0[1] * cs[1]); ra.y = pk2(v0[2] * cs[2], v0[3] * cs[3]); rb.x = pk2(v1[0] * cs[4], v1[1] * cs[5]); rb.y = pk2(v1[2] * cs[6], v1[3] * cs[7]);
                    bf16_t* gp = out + (size_t)row * ld + (col & ~15);
                    *(u32x2*)(gp + ((col & 8) ? 4 : 0)) = ra; *(u32x2*)(gp + ((col & 8) ? 12 : 8)) = rb;
                }
        }
    }
};

__device__ __forceinline__ int perm128_d(int p) { const int i = p >> 3, j = p & 7; return (j < 4) ? 4 * i + j : 64 + 4 * i + (j - 4); }
__device__ __forceinline__ int perm64_d(int p) { const int i = p >> 3, j = p & 7; return (j < 4) ? 4 * i + j : 32 + 4 * i + (j - 4); }
enum { MAP_PLAIN = 0, MAP_GU = 1, MAP_WIN = 2, MAP_WVN = 3, MAP_UQ = 4, MAP_UKV0 = 5, MAP_UKV1 = 6 };
template <int MODE> __device__ __forceinline__ int map_col(int n, int& which) {
    which = 0;
    if (MODE == MAP_PLAIN) return n;
    if (MODE == MAP_GU) { const int pn = n >> 8, r = n & 255; which = (r < 128) ? 0 : 1; return 128 * pn + (r & 127); }
    if (MODE == MAP_WIN) { const int blk = n >> 7, p = n & 127; int col = -1;
        if (blk < 4) col = 128 * blk + p;
        else if (blk < 6) col = 512 + 128 * (blk - 4) + p;
        else if (blk == 6) { if (p < 64) col = 768 + perm64_d(p); else if (p < 88) col = 3392 + (p - 64); }
        else if (blk <= 14) col = 832 + 128 * (blk - 7) + perm128_d(p);
        else if (blk <= 16) col = 1856 + 128 * (blk - 15) + perm128_d(p);
        else if (blk <= 18) col = 2112 + 128 * (blk - 17) + p;
        else if (blk <= 20) col = 2368 + 128 * (blk - 19) + perm128_d(p);
        else if (blk <= 22) col = 2880 + 128 * (blk - 21) + perm128_d(p);
        return col; }
    if (MODE == MAP_WVN) { const int blk = n >> 7, p = n & 127; return (blk < 2) ? 2624 + 128 * blk + p : 3136 + 128 * (blk - 2) + p; }
    if (MODE == MAP_UQ) { const int blk = n >> 7, p = n & 127; if (blk < 8) return 192 * blk + p; const int head = 2 * (blk - 8) + (p >> 6); return 192 * head + 128 + perm64_d(p & 63); }
    if (MODE == MAP_UKV0) return 256 * (n >> 7) + (n & 127);
    return 256 * (n >> 7) + 128 + (n & 127);
}
template <int MODE>
__device__ __forceinline__ void transpose_job(const float* src0, const float* src1, int ld, const float* ks, int K, int NR, bf16_t* WT, LAS float* scr, int gw, int NGW, int lane) {
    const int nblk = NR / 32, items = (K / 64) * nblk;
    for (int it = gw; it < items; it += 2 * NGW) {
        const int it2 = it + NGW; const bool has2 = it2 < items;
        const int kbA = it / nblk, nbA = it % nblk, k0A = 64 * kbA, n0A = 32 * nbA;
        const int itb = has2 ? it2 : it; const int kbB = itb / nblk, nbB = itb % nblk, k0B = 64 * kbB, n0B = 32 * nbB;
        int whichA, whichB; const int colA = map_col<MODE>(n0A + (lane & 31), whichA), colB = map_col<MODE>(n0B + (lane & 31), whichB);
        const float* spA = (whichA ? src1 : src0) + (colA >= 0 ? colA : 0); const float* spB = (whichB ? src1 : src0) + (colB >= 0 ? colB : 0);
        float va[32], vb[32];
#pragma unroll
        for (int i = 0; i < 32; ++i) { const int kk = 2 * i + (lane >> 5); va[i] = spA[(size_t)(k0A + kk) * ld]; }
#pragma unroll
        for (int i = 0; i < 32; ++i) { const int kk = 2 * i + (lane >> 5); vb[i] = spB[(size_t)(k0B + kk) * ld]; }
#pragma unroll
        for (int i = 0; i < 32; ++i) { const int kk = 2 * i + (lane >> 5); float v = va[i]; if (ks) v *= ks[k0A + kk]; if (colA < 0) v = 0.f; scr[kk * 33 + (lane & 31)] = v; }
#pragma unroll
        for (int i = 0; i < 32; ++i) { const int kk = 2 * i + (lane >> 5); float v = vb[i]; if (ks) v *= ks[k0B + kk]; if (colB < 0) v = 0.f; scr[2112 + kk * 33 + (lane & 31)] = v; }
        asm volatile("s_waitcnt lgkmcnt(0)" ::: "memory");
        const int c = lane & 7;
#pragma unroll
        for (int j = 0; j < 4; ++j) { const int n = (lane >> 3) + 8 * j; const LAS float* s = scr + (8 * c) * 33 + n;
            u32x4 o; o.x = pk2(s[0 * 33], s[1 * 33]); o.y = pk2(s[2 * 33], s[3 * 33]); o.z = pk2(s[4 * 33], s[5 * 33]); o.w = pk2(s[6 * 33], s[7 * 33]);
            *(u32x4*)(WT + (size_t)(n0A + n) * K + k0A + 8 * c) = o; }
        if (has2) {
#pragma unroll
            for (int j = 0; j < 4; ++j) { const int n = (lane >> 3) + 8 * j; const LAS float* s = scr + 2112 + (8 * c) * 33 + n;
                u32x4 o; o.x = pk2(s[0 * 33], s[1 * 33]); o.y = pk2(s[2 * 33], s[3 * 33]); o.z = pk2(s[4 * 33], s[5 * 33]); o.w = pk2(s[6 * 33], s[7 * 33]);
                *(u32x4*)(WT + (size_t)(n0B + n) * K + k0B + 8 * c) = o; } }
        asm volatile("s_waitcnt lgkmcnt(0)" ::: "memory");
    }
}

__device__ __forceinline__ void ln_row(const float* xin, float* xout, bf16_t* xb, const f32x4 (&gq)[8], const f32x4 (&bq)[8], int lane) {
    const f32x4* xr = (const f32x4*)xin + lane;
    f32x4 v[8]; float s = 0.f;
#pragma unroll
    for (int j = 0; j < 8; ++j) { v[j] = xr[64 * j]; s += (v[j][0] + v[j][1]) + (v[j][2] + v[j][3]); }
    const float mean = wave_sum(s) * (1.f / DM); float s2 = 0.f;
#pragma unroll
    for (int j = 0; j < 8; ++j) { v[j] = v[j] - mean; s2 += (v[j][0] * v[j][0] + v[j][1] * v[j][1]) + (v[j][2] * v[j][2] + v[j][3] * v[j][3]); }
    const float rstd = 1.f / sqrtf(wave_sum(s2) * (1.f / DM) + LN_EPS);
#pragma unroll
    for (int j = 0; j < 8; ++j) { const f32x4 gg = gq[j], bb = bq[j];
        const f32x4 y = v[j] * rstd * gg + bb;
        ((f32x4*)xout)[64 * j + lane] = y;
        if (xb) { u32x2 w; w.x = pk2(y[0], y[1]); w.y = pk2(y[2], y[3]); ((u32x2*)xb)[64 * j + lane] = w; } }
}

__device__ __forceinline__ void ln_load_gb(f32x4 (&gq)[8], f32x4 (&bq)[8], const float* g, const float* b, int lane) {
#pragma unroll
    for (int j = 0; j < 4; ++j) { const int e0 = 8 * lane + 512 * j; gq[2 * j] = *(const f32x4*)(g + e0); gq[2 * j + 1] = *(const f32x4*)(g + e0 + 4); bq[2 * j] = *(const f32x4*)(b + e0); bq[2 * j + 1] = *(const f32x4*)(b + e0 + 4); }
}
template <bool OUT_F32>
__device__ __forceinline__ void ln_row_b(const u32x4 (&xw)[4], void* xout, const f32x4 (&gq)[8], const f32x4 (&bq)[8], int lane) {
    float v[32]; float s = 0.f;
#pragma unroll
    for (int j = 0; j < 4; ++j) { const u32x4 w = xw[j];
        v[8 * j + 0] = __uint_as_float(w.x << 16); v[8 * j + 1] = __uint_as_float(w.x & 0xffff0000u); v[8 * j + 2] = __uint_as_float(w.y << 16); v[8 * j + 3] = __uint_as_float(w.y & 0xffff0000u);
        v[8 * j + 4] = __uint_as_float(w.z << 16); v[8 * j + 5] = __uint_as_float(w.z & 0xffff0000u); v[8 * j + 6] = __uint_as_float(w.w << 16); v[8 * j + 7] = __uint_as_float(w.w & 0xffff0000u); }
#pragma unroll
    for (int i = 0; i < 32; ++i) s += v[i];
    const float mean = wave_sum(s) * (1.f / DM); float s2 = 0.f;
#pragma unroll
    for (int i = 0; i < 32; ++i) { v[i] -= mean; s2 += v[i] * v[i]; }
    const float rstd = 1.f / sqrtf(wave_sum(s2) * (1.f / DM) + LN_EPS);
#pragma unroll
    for (int j = 0; j < 4; ++j) { const int e0 = 8 * lane + 512 * j;
        const f32x4 g0 = gq[2 * j], g1 = gq[2 * j + 1], b0 = bq[2 * j], b1 = bq[2 * j + 1];
        float y[8];
#pragma unroll
        for (int k = 0; k < 4; ++k) { y[k] = v[8 * j + k] * rstd * g0[k] + b0[k]; y[4 + k] = v[8 * j + 4 + k] * rstd * g1[k] + b1[k]; }
        if (OUT_F32) { *(f32x4*)((float*)xout + e0) = (f32x4){y[0], y[1], y[2], y[3]}; *(f32x4*)((float*)xout + e0 + 4) = (f32x4){y[4], y[5], y[6], y[7]}; }
        else { u32x4 w; w.x = pk2(y[0], y[1]); w.y = pk2(y[2], y[3]); w.z = pk2(y[4], y[5]); w.w = pk2(y[6], y[7]); *(u32x4*)((bf16_t*)xout + e0) = w; } }
}
__device__ __forceinline__ int crow(int r, int hi) { return (r & 3) + 8 * (r >> 2) + 4 * hi; }
constexpr int VRS = 144;

struct TileSrc { const GAS bf16_t* K; const GAS bf16_t* KX; const GAS bf16_t* VT; int ldv; };

template <int KRS, bool HAS_X>
struct TileRegs { u32x4 k0, k1, kx, v0, v1; };

template <int KRS, bool HAS_X>
__device__ __forceinline__ void tile_load(TileRegs<KRS, HAS_X>& R, const TileSrc& s, int t, int tid) {
    const GAS bf16_t* kp = s.K + (size_t)t * 64 * 128 + tid * 8;
    R.k0 = *(const GAS u32x4*)kp; R.k1 = *(const GAS u32x4*)(kp + 4096);
    if (HAS_X) R.kx = *(const GAS u32x4*)(s.KX + (size_t)t * 64 * 64 + tid * 8);
    const int d = tid >> 3, ch = tid & 7;
    const GAS bf16_t* vp = s.VT + (size_t)d * s.ldv + t * 64 + ch * 8;
    R.v0 = *(const GAS u32x4*)vp; R.v1 = *(const GAS u32x4*)(vp + (size_t)64 * s.ldv);
}
template <int KRS, bool HAS_X>
__device__ __forceinline__ void tile_store(const TileRegs<KRS, HAS_X>& R, LAS unsigned char* buf, int tid) {
    { const int row = tid >> 4, col = tid & 15; *(LAS u32x4*)(buf + row * KRS + col * 16) = R.k0; *(LAS u32x4*)(buf + (row + 32) * KRS + col * 16) = R.k1; }
    if (HAS_X) { const int row = tid >> 3, col = tid & 7; *(LAS u32x4*)(buf + row * KRS + 256 + col * 16) = R.kx; }
    { const int d = tid >> 3, ch = tid & 7; LAS unsigned char* vb = buf + 64 * KRS + d * VRS + ch * 16;
      *(LAS u32x4*)(vb) = R.v0; *(LAS u32x4*)(vb + 64 * VRS) = R.v1; }
}
template <int KRS, bool HAS_X, bool MIDSTORE, class Pre, class Body>
__device__ __forceinline__ void flash_loop_pre(LAS unsigned char* lds, const TileSrc& src, int tb, int te, int tid, Pre&& pre, Body&& body) {
    constexpr int BUFB = 64 * KRS + 128 * VRS;
    if (tb >= te) return;
    TileRegs<KRS, HAS_X> R;
    { TileRegs<KRS, HAS_X> R0;
      tile_load<KRS, HAS_X>(R0, src, tb, tid); if (tb + 1 < te) tile_load<KRS, HAS_X>(R, src, tb + 1, tid);
      pre();
      tile_store<KRS, HAS_X>(R0, lds, tid); }
    __syncthreads();
    for (int t = tb; t < te; ++t) {
        const int cur = (t - tb) & 1;
        if (t + 1 < te) tile_store<KRS, HAS_X>(R, lds + (cur ^ 1) * BUFB, tid);
        if (t + 2 < te) tile_load<KRS, HAS_X>(R, src, t + 2, tid);
        body(t, (const LAS unsigned char*)(lds + cur * BUFB), []() __attribute__((always_inline)) {});
        __syncthreads();
    }
}
template <int KRS, bool HAS_X, bool MIDSTORE, class Body>
__device__ __forceinline__ void flash_loop(LAS unsigned char* lds, const TileSrc& src, int tb, int te, int tid, Body&& body) {
    flash_loop_pre<KRS, HAS_X, MIDSTORE>(lds, src, tb, te, tid, []() __attribute__((always_inline)) {}, body);
}
template <int NKS, int KRS>
__device__ __forceinline__ void qk_tile(f32x16& p0, f32x16& p1, const LAS unsigned char* Kt, const bf16x8 (&qf)[NKS], int r32, int hi) {
    const LAS unsigned char* kb = Kt + r32 * KRS + hi * 16;
#pragma unroll
    for (int r = 0; r < 16; ++r) { p0[r] = 0.f; p1[r] = 0.f; }
    bf16x8 a0[3], a1[3];
    a0[0] = *(const LAS bf16x8*)(kb); a1[0] = *(const LAS bf16x8*)(kb + 32 * KRS);
    a0[1] = *(const LAS bf16x8*)(kb + 32); a1[1] = *(const LAS bf16x8*)(kb + 32 * KRS + 32);
    __builtin_amdgcn_sched_barrier(0);
#pragma unroll
    for (int ks = 0; ks < NKS; ++ks) {
        if (ks + 2 < NKS) { a0[(ks + 2) % 3] = *(const LAS bf16x8*)(kb + (ks + 2) * 32); a1[(ks + 2) % 3] = *(const LAS bf16x8*)(kb + 32 * KRS + (ks + 2) * 32); }
        p0 = __builtin_amdgcn_mfma_f32_32x32x16_bf16(a0[ks % 3], qf[ks], p0, 0, 0, 0);
        p1 = __builtin_amdgcn_mfma_f32_32x32x16_bf16(a1[ks % 3], qf[ks], p1, 0, 0, 0);
        __builtin_amdgcn_sched_barrier(0);
    }
}
__device__ __forceinline__ void pv_tile(f32x16 (&o)[4], const f32x16& p0, const f32x16& p1, const LAS unsigned char* Vt, int r32, int hi) {
    bf16x8 pa[4];
#pragma unroll
    for (int s = 0; s < 4; ++s) { const int b = 8 * (s & 1); u32x4 w;
        if (s < 2) { w.x = pk2(p0[b], p0[b + 1]); w.y = pk2(p0[b + 2], p0[b + 3]); w.z = pk2(p0[b + 4], p0[b + 5]); w.w = pk2(p0[b + 6], p0[b + 7]); }
        else { w.x = pk2(p1[b], p1[b + 1]); w.y = pk2(p1[b + 2], p1[b + 3]); w.z = pk2(p1[b + 4], p1[b + 5]); w.w = pk2(p1[b + 6], p1[b + 7]); }
        pa[s] = __builtin_bit_cast(bf16x8, w); }
    const LAS unsigned char* vb2 = Vt + r32 * VRS + hi * 16;
    bf16x8 vf[4];
#define PV_LD(i_) do { vf[(i_) & 3] = *(const LAS bf16x8*)(vb2 + ((i_) & 3) * 32 * VRS + ((i_) >> 2) * 32); } while (0)
    PV_LD(0); PV_LD(1); PV_LD(2);
    __builtin_amdgcn_sched_barrier(0);
#pragma unroll
    for (int i = 0; i < 16; ++i) {
        if (i + 3 < 16) PV_LD(i + 3);
        o[i & 3] = __builtin_amdgcn_mfma_f32_32x32x16_bf16(pa[i >> 2], vf[i & 3], o[i & 3], 0, 0, 0);
        __builtin_amdgcn_sched_barrier(0);
    }
#undef PV_LD
}
template <bool WITH_O>
__device__ __forceinline__ void softmax_step(float& m, float& l, f32x16 (&o)[4], f32x16& p0, f32x16& p1, LAS float* wsf, int r32, int hi) {
    float mx = fmaxf(p0[0], p1[0]);
#pragma unroll
    for (int r = 1; r < 16; ++r) mx = fmaxf(mx, fmaxf(p0[r], p1[r]));
    mx = fmaxf(mx, __shfl_xor(mx, 32));
    const bool grow = __any(mx > m + 8.f);
    const float mnew = grow ? fmaxf(m, mx) : m;
    const float f = grow ? __builtin_amdgcn_exp2f(m - mnew) : 1.f;
    m = mnew;
    float s = 0.f;
#pragma unroll
    for (int r = 0; r < 16; ++r) { p0[r] = __builtin_amdgcn_exp2f(p0[r] - mnew); p1[r] = __builtin_amdgcn_exp2f(p1[r] - mnew); s += p0[r] + p1[r]; }
    l = l * f + s;
    if (WITH_O) {
        if (grow) {
            if (hi == 0) wsf[r32] = f;
            asm volatile("s_waitcnt lgkmcnt(0)" ::: "memory");
#pragma unroll
            for (int r = 0; r < 16; ++r) { const float fr = wsf[crow(r, hi)];
#pragma unroll
                for (int db = 0; db < 4; ++db) o[db][r] *= fr; }
        }
    }
}
__device__ __forceinline__ void row_factors(float (&fr)[16], float fac, LAS float* wsf, int r32, int hi) {
    if (hi == 0) wsf[r32] = fac;
    asm volatile("s_waitcnt lgkmcnt(0)" ::: "memory");
#pragma unroll
    for (int r = 0; r < 16; ++r) fr[r] = wsf[crow(r, hi)];
    asm volatile("s_waitcnt lgkmcnt(0)" ::: "memory");
}

constexpr int KRS_MLA = 400, KRS_NSA = 272;
struct AttnPtrs { unsigned char* ws; const float* gate_b; };
#define OPQ_WS(name) GAS unsigned char* name = (GAS unsigned char*)P.ws; asm volatile("" : "+s"(name))
#define WSP(T, base, off) ((GAS T*)((base) + (off)))

__device__ __forceinline__ void mla_unit(int h, int qb, LAS unsigned char* lds, LAS float* wsf, const AttnPtrs& P) {
    int tid = threadIdx.x; asm volatile("" : "+v"(tid)); const int lane = tid & 63, w = __builtin_amdgcn_readfirstlane(tid >> 6), r32 = lane & 31, hi = lane >> 5;
    const int qrow = qb * 256 + w * 32 + r32;
    bf16x8 qf[12];
    OPQ_WS(wsl);
    { const GAS bf16_t* qp = WSP(const bf16_t, wsl, WS_QM) + ((size_t)h * M + qrow) * 192 + 8 * hi;
#pragma unroll
      for (int ks = 0; ks < 12; ++ks) qf[ks] = *(const GAS bf16x8*)(qp + 16 * ks); }
    float m = -1e30f, l = 0.f; f32x16 o[4];
#pragma unroll
    for (int db = 0; db < 4; ++db)
#pragma unroll
        for (int r = 0; r < 16; ++r) o[db][r] = 0.f;
    TileSrc src{WSP(const bf16_t, wsl, WS_KN) + (size_t)h * M * 128, WSP(const bf16_t, wsl, WS_KR), WSP(const bf16_t, wsl, WS_VT) + (size_t)h * 128 * M, M};
    const int qmin = qb * 256 + w * 32;
    flash_loop_pre<KRS_MLA, true, true>(lds, src, 0, 4 * qb + 4, tid, [&]() __attribute__((always_inline)) {
        asm volatile("s_waitcnt vmcnt(0)" ::: "memory");
#pragma unroll
        for (int ks = 0; ks < 12; ++ks) asm volatile("" : "+v"(qf[ks]));
    }, [&](int t, const LAS unsigned char* buf, auto&& mid) __attribute__((always_inline)) {
        const bool act = 64 * t <= qmin + 31;
        f32x16 p0, p1;
        if (act) {
            qk_tile<12, KRS_MLA>(p0, p1, buf, qf, r32, hi);
            if (64 * t + 63 > qmin) {
#pragma unroll
                for (int r = 0; r < 16; ++r) { const int key = 64 * t + crow(r, hi); if (key > qrow) p0[r] = -INFINITY; if (key + 32 > qrow) p1[r] = -INFINITY; }
            }
            softmax_step<true>(m, l, o, p0, p1, wsf, r32, hi);
        }
        mid();
        if (act) pv_tile(o, p0, p1, buf + 64 * KRS_MLA, r32, hi);
    });
    const float lt = l + __shfl_xor(l, 32);
    float fr[16]; row_factors(fr, 1.f / fmaxf(lt, 1e-30f), wsf, r32, hi);
    OPQ_WS(wso);
#pragma unroll
    for (int r = 0; r < 16; ++r) { GAS bf16_t* op = WSP(bf16_t, wso, WS_XB) + (size_t)(qb * 256 + w * 32 + crow(r, hi)) * DM + h * 128 + r32;
#pragma unroll
        for (int db = 0; db < 4; ++db) op[32 * db] = (bf16_t)(pk2(o[db][r] * fr[r], 0.f) & 0xffffu); }
}

constexpr int IMP_OFF = 2 * (64 * KRS_NSA + 128 * VRS);
constexpr int IMP_RS = 257;
constexpr int SEL_OFF = IMP_OFF + 64 * IMP_RS * 4;
constexpr int UNI_OFF = SEL_OFF + 64 * 8 * 4;
constexpr int WSF_OFF = 143360;

__device__ __forceinline__ unsigned range_mask(int lo, int hi, int k) {
    const int a = lo > 32 * k ? lo : 32 * k, b = hi < 32 * k + 31 ? hi : 32 * k + 31;
    if (a > b) return 0u; const int n = b - a + 1; const unsigned mk = (n >= 32) ? 0xffffffffu : ((1u << n) - 1u); return mk << (a - 32 * k);
}
template <int MODE>
__device__ __forceinline__ void nsa_finish(const f32x16 (&o)[4], float fac, LAS float* wsf, unsigned char* wsb0, int t0, int w, int hk, int tid, int r32, int hi) {
    float fr[16]; row_factors(fr, fac, wsf, r32, hi);
    GAS unsigned char* wsb = (GAS unsigned char*)wsb0; asm volatile("" : "+s"(wsb));
    GAS f32x4* ap = (GAS f32x4*)(WSP(float, wsb, WS_OACC) + (size_t)blockIdx.x * 32768 + (size_t)tid * 64);
    GAS bf16_t* OMIX = WSP(bf16_t, wsb, WS_XB);
#pragma unroll
    for (int db = 0; db < 4; ++db) {
#pragma unroll
        for (int r4 = 0; r4 < 4; ++r4) {
            f32x4 v = {o[db][4 * r4] * fr[4 * r4], o[db][4 * r4 + 1] * fr[4 * r4 + 1], o[db][4 * r4 + 2] * fr[4 * r4 + 2], o[db][4 * r4 + 3] * fr[4 * r4 + 3]};
            if (MODE >= 1) v += ap[db * 4 + r4];
            if (MODE <= 1) ap[db * 4 + r4] = v;
            else {
#pragma unroll
                for (int k = 0; k < 4; ++k) { const int row = crow(4 * r4 + k, hi), tok = t0 + 8 * w + (row >> 2), head = 4 * hk + (row & 3);
                    OMIX[(size_t)tok * DM + 1024 + head * 128 + 32 * db + r32] = (bf16_t)(pk2(v[k], 0.f) & 0xffffu); }
            }
        }
        asm volatile("" ::: "memory");
    }
}
__device__ __forceinline__ float gate_val(const AttnPtrs& P, int tok, int br, int head) {
    OPQ_WS(wsg);
    const float x = bf2f(WSP(const bf16_t, wsg, WS_GL)[(size_t)tok * 32 + br * 8 + head]) + P.gate_b[br * 8 + head];
    return 1.f / (1.f + __builtin_amdgcn_exp2f(-x * 1.4426950408889634f));
}

__device__ __forceinline__ void nsa_unit(int hk, int T, LAS unsigned char* lds, LAS float* wsf, const AttnPtrs& P) {
    int tid = threadIdx.x; asm volatile("" : "+v"(tid)); const int lane = tid & 63, w = __builtin_amdgcn_readfirstlane(tid >> 6), r32 = lane & 31, hi = lane >> 5;
    const int t0 = 64 * T, qi = r32 >> 2, g = r32 & 3, tq = t0 + 8 * w + qi, head = 4 * hk + g;
    LAS float* imp = (LAS float*)(lds + IMP_OFF);
    LAS unsigned* sel = (LAS unsigned*)(lds + SEL_OFF);
    LAS unsigned* uni = (LAS unsigned*)(lds + UNI_OFF);
    bf16x8 qf[8];
    { OPQ_WS(wsq); const GAS bf16_t* qp = WSP(const bf16_t, wsq, WS_QN) + ((size_t)head * M + tq) * 128 + 8 * hi;
#pragma unroll
      for (int ks = 0; ks < 8; ++ks) qf[ks] = *(const GAS bf16x8*)(qp + 16 * ks); }
    asm volatile("s_waitcnt vmcnt(0)" ::: "memory");
#pragma unroll
    for (int ks = 0; ks < 8; ++ks) asm volatile("" : "+v"(qf[ks]));
    const float gate_c = gate_val(P, tq, 0, head), gate_s = gate_val(P, tq, 1, head), gate_w = gate_val(P, tq, 2, head);
    f32x16 o[4];
#define ZERO_O() do { _Pragma("unroll") for (int db = 0; db < 4; ++db) _Pragma("unroll") for (int r = 0; r < 16; ++r) o[db][r] = 0.f; } while (0)
    const int cmaxT = (t0 + 63 >= 31) ? ((t0 + 63 - 31) >> 4) : -1;
    const int NTc = cmaxT >= 0 ? (cmaxT >> 6) + 1 : 0;
    const int mycmax = (tq >= 31) ? ((tq - 31) >> 4) : -1;
    OPQ_WS(wsc);
    TileSrc csrc{WSP(const bf16_t, wsc, WS_KC) + (size_t)hk * 1024 * 128, nullptr, WSP(const bf16_t, wsc, WS_KC) + 2 * 1024 * 128 + (size_t)hk * 128 * 1024, 1024};
    float m = -1e30f, l = 0.f;
    flash_loop<KRS_NSA, false, false>(lds, csrc, 0, NTc, tid, [&](int t, const LAS unsigned char* buf, auto&& mid) __attribute__((always_inline)) {
        f32x16 p0, p1;
        qk_tile<8, KRS_NSA>(p0, p1, buf, qf, r32, hi);
#pragma unroll
        for (int r = 0; r < 16; ++r) { const int c = 64 * t + crow(r, hi); if (c > mycmax) p0[r] = -INFINITY; if (c + 32 > mycmax) p1[r] = -INFINITY; }
        softmax_step<false>(m, l, o, p0, p1, wsf, r32, hi);
    });
    const float invl = 1.f / fmaxf(l + __shfl_xor(l, 32), 1e-30f);
    for (int i = tid; i < 64 * IMP_RS; i += NTHREADS) imp[i] = 0.f;
    __syncthreads();
    ZERO_O();
    flash_loop<KRS_NSA, false, false>(lds, csrc, 0, NTc, tid, [&](int t, const LAS unsigned char* buf, auto&& mid) __attribute__((always_inline)) {
        f32x16 p0, p1;
        qk_tile<8, KRS_NSA>(p0, p1, buf, qf, r32, hi);
#pragma unroll
        for (int r = 0; r < 16; ++r) { const int c = 64 * t + crow(r, hi);
            p0[r] = (c > mycmax) ? 0.f : __builtin_amdgcn_exp2f(p0[r] - m) * invl;
            p1[r] = (c + 32 > mycmax) ? 0.f : __builtin_amdgcn_exp2f(p1[r] - m) * invl; }
        float A[8], B[8];
#pragma unroll
        for (int a = 0; a < 4; ++a) {
            A[a] = 2.f * (p0[4 * a] + p0[4 * a + 1] + p0[4 * a + 2]) + p0[4 * a + 3]; B[a] = p0[4 * a + 3];
            A[4 + a] = 2.f * (p1[4 * a] + p1[4 * a + 1] + p1[4 * a + 2]) + p1[4 * a + 3]; B[4 + a] = p1[4 * a + 3]; }
#pragma unroll
        for (int a = 0; a < 8; ++a) {
            A[a] += __int_as_float(__builtin_amdgcn_mov_dpp(__float_as_int(A[a]), 0xB1, 0xF, 0xF, true)); A[a] += __int_as_float(__builtin_amdgcn_mov_dpp(__float_as_int(A[a]), 0x4E, 0xF, 0xF, true));
            B[a] += __int_as_float(__builtin_amdgcn_mov_dpp(__float_as_int(B[a]), 0xB1, 0xF, 0xF, true)); B[a] += __int_as_float(__builtin_amdgcn_mov_dpp(__float_as_int(B[a]), 0x4E, 0xF, 0xF, true)); }
        LAS float* ir = imp + (8 * w + qi) * IMP_RS + 16 * t + hi;
        if (g == 0) {
#pragma unroll
            for (int a = 0; a < 8; ++a) ir[2 * (a & 3) + 8 * (a >> 2)] += A[a];
        }
        asm volatile("s_waitcnt lgkmcnt(0)" ::: "memory");
        if (g == 0) {
#pragma unroll
            for (int a = 0; a < 8; ++a) ir[2 * (a & 3) + 8 * (a >> 2) + 1] += B[a];
        }
        asm volatile("s_waitcnt lgkmcnt(0)" ::: "memory");
        pv_tile(o, p0, p1, buf + 64 * KRS_NSA, r32, hi);
    });
    nsa_finish<0>(o, gate_c, wsf, P.ws, t0, w, hk, tid, r32, hi);
    {
        const int nforced = (T == 0) ? 1 : (T == 1) ? 2 : 3, npick = 16 - nforced, ncand = T - 2 > 0 ? T - 2 : 0;
        unsigned uniword = 0u;
        for (int q = 0; q < 8; ++q) {
            unsigned myword = 0u;
            if (lane < 8) { myword = range_mask(0, 0, lane) | range_mask(T, T, lane); if (T >= 1) myword |= range_mask(T - 1, T - 1, lane); }
            if (ncand <= npick) { if (lane < 8 && ncand > 0) myword |= range_mask(1, T - 2, lane); }
            else {
                const LAS float* irow = imp + (8 * w + q) * IMP_RS;
                unsigned k0 = 0u, k1 = 0u, k2 = 0u, k3 = 0u;
                { int j = lane; if (j >= 1 && j <= T - 2) k0 = __float_as_uint(irow[j]) + 1u; j += 64; if (j <= T - 2) k1 = __float_as_uint(irow[j]) + 1u;
                  j += 64; if (j <= T - 2) k2 = __float_as_uint(irow[j]) + 1u; j += 64; if (j <= T - 2) k3 = __float_as_uint(irow[j]) + 1u; }
                unsigned prefix = 0u;
                for (int bit = 31; bit >= 0; --bit) {
                    const unsigned cand = prefix | (1u << bit);
                    const int cnt = __popcll(__ballot(k0 >= cand)) + __popcll(__ballot(k1 >= cand)) + __popcll(__ballot(k2 >= cand)) + __popcll(__ballot(k3 >= cand));
                    if (cnt >= npick) prefix = cand;
                }
                const unsigned long long g0 = __ballot(k0 > prefix), g1 = __ballot(k1 > prefix), g2 = __ballot(k2 > prefix), g3 = __ballot(k3 > prefix);
                const unsigned long long e0 = __ballot(k0 == prefix), e1 = __ballot(k1 == prefix), e2 = __ballot(k2 == prefix), e3 = __ballot(k3 == prefix);
                const int need = npick - (__popcll(g0) + __popcll(g1) + __popcll(g2) + __popcll(g3));
                const unsigned long long ltm = (lane == 0) ? 0ull : ((~0ull) >> (64 - lane));
                int base = 0;
                const bool c0 = ((e0 >> lane) & 1ull) && (base + __popcll(e0 & ltm) < need); base += __popcll(e0);
                const bool c1 = ((e1 >> lane) & 1ull) && (base + __popcll(e1 & ltm) < need); base += __popcll(e1);
                const bool c2 = ((e2 >> lane) & 1ull) && (base + __popcll(e2 & ltm) < need); base += __popcll(e2);
                const bool c3 = ((e3 >> lane) & 1ull) && (base + __popcll(e3 & ltm) < need);
                const unsigned long long s0 = g0 | __ballot(c0), s1 = g1 | __ballot(c1), s2 = g2 | __ballot(c2), s3 = g3 | __ballot(c3);
                const unsigned long long sm = (lane >> 1) == 0 ? s0 : (lane >> 1) == 1 ? s1 : (lane >> 1) == 2 ? s2 : s3;
                if (lane < 8) myword |= (lane & 1) ? (unsigned)(sm >> 32) : (unsigned)sm;
            }
            if (lane < 8) { sel[(8 * w + q) * 8 + lane] = myword; uniword |= myword; }
        }
        if (lane < 8) uni[w * 8 + lane] = uniword;
        asm volatile("s_waitcnt lgkmcnt(0)" ::: "memory");
    }
    {
        OPQ_WS(wss);
        TileSrc ssrc{WSP(const bf16_t, wss, WS_KS) + (size_t)hk * M * 128, nullptr, WSP(const bf16_t, wss, WS_VTN) + (size_t)(hk * 128) * M, M};
        m = -1e30f; l = 0.f; ZERO_O();
        flash_loop<KRS_NSA, false, true>(lds, ssrc, 0, T + 1, tid, [&](int j, const LAS unsigned char* buf, auto&& mid) __attribute__((always_inline)) {
            const unsigned uw = __builtin_amdgcn_readfirstlane(uni[w * 8 + (j >> 5)]);
            const bool act = ((uw >> (j & 31)) & 1u) != 0u;
            f32x16 p0, p1;
            if (act) {
                qk_tile<8, KRS_NSA>(p0, p1, buf, qf, r32, hi);
                const unsigned mw = sel[(8 * w + qi) * 8 + (j >> 5)];
                const bool mine = (mw >> (j & 31)) & 1u;
#pragma unroll
                for (int r = 0; r < 16; ++r) { const int key = 64 * j + crow(r, hi);
                    if (!mine || key > tq) p0[r] = -INFINITY; if (!mine || key + 32 > tq) p1[r] = -INFINITY; }
                softmax_step<true>(m, l, o, p0, p1, wsf, r32, hi);
            }
            mid();
            if (act) pv_tile(o, p0, p1, buf + 64 * KRS_NSA, r32, hi);
        });
        const float lt = l + __shfl_xor(l, 32);
        nsa_finish<1>(o, gate_s / fmaxf(lt, 1e-30f), wsf, P.ws, t0, w, hk, tid, r32, hi);
    }
    {
        OPQ_WS(wsw);
        TileSrc wsrc{WSP(const bf16_t, wsw, WS_KW) + (size_t)hk * M * 128, nullptr, WSP(const bf16_t, wsw, WS_VTN) + (size_t)(256 + hk * 128) * M, M};
        m = -1e30f; l = 0.f; ZERO_O();
        flash_loop<KRS_NSA, false, true>(lds, wsrc, T >= 8 ? T - 8 : 0, T + 1, tid, [&](int j, const LAS unsigned char* buf, auto&& mid) __attribute__((always_inline)) {
            f32x16 p0, p1;
            qk_tile<8, KRS_NSA>(p0, p1, buf, qf, r32, hi);
            if (j == T || j == T - 8) {
#pragma unroll
                for (int r = 0; r < 16; ++r) { const int key = 64 * j + crow(r, hi);
                    if (key > tq || key <= tq - 512) p0[r] = -INFINITY; if (key + 32 > tq || key + 32 <= tq - 512) p1[r] = -INFINITY; }
            }
            softmax_step<true>(m, l, o, p0, p1, wsf, r32, hi);
            mid();
            pv_tile(o, p0, p1, buf + 64 * KRS_NSA, r32, hi);
        });
        const float lt = l + __shfl_xor(l, 32);
        nsa_finish<2>(o, gate_w / fmaxf(lt, 1e-30f), wsf, P.ws, t0, w, hk, tid, r32, hi);
    }
#undef ZERO_O
}

struct Args { const float* in[26]; float* out; unsigned char* ws; int ph_lo, ph_hi; };
constexpr int N_PHASES = 13;
#ifndef PROBE_REP7
#define PROBE_REP7 1
#endif
#ifndef PROBE_REP1
#define PROBE_REP1 1
#endif

__global__ void __launch_bounds__(NTHREADS) mega_fwd(Args args) {
    extern __shared__ __attribute__((aligned(16))) unsigned char lds_raw[];
    LAS unsigned char* lds = (LAS unsigned char*)lds_raw;
    cg::grid_group grid = cg::this_grid();
    const int G = gridDim.x, bx = blockIdx.x;
#define PHASE_IDS int tid = threadIdx.x; asm volatile("" : "+v"(tid)); const int lane = tid & 63, wave = __builtin_amdgcn_readfirstlane(tid >> 6); \
    const int gw = bx * NWAVES + wave, NGW = G * NWAVES; const int gtid = bx * NTHREADS + tid, NGT = G * NTHREADS; LAS float* scr = (LAS float*)(lds + wave * 17408); \
    (void)lane; (void)gw; (void)NGW; (void)gtid; (void)NGT; (void)scr
    unsigned char* ws = args.ws;
    float* out = args.out;
    bf16_t* WGU = (bf16_t*)(ws + WS_WGU); bf16_t* WD = (bf16_t*)(ws + WS_WD); bf16_t* WIN = (bf16_t*)(ws + WS_WIN); bf16_t* WVN = (bf16_t*)(ws + WS_WVN);
    bf16_t* WUQ = (bf16_t*)(ws + WS_WUQ); bf16_t* WKN = (bf16_t*)(ws + WS_WKN); bf16_t* WVM = (bf16_t*)(ws + WS_WVM); bf16_t* W1K = (bf16_t*)(ws + WS_W1K);
    bf16_t* W1V = (bf16_t*)(ws + WS_W1V); bf16_t* WOUT = (bf16_t*)(ws + WS_WOUT);
    float* TAB128 = (float*)(ws + WS_TAB128); float* TAB64 = (float*)(ws + WS_TAB64); float* SSQ = (float*)(ws + WS_SSQ); float* CBIAS = (float*)(ws + WS_MISC);
    float* HCP = (float*)(ws + WS_HCP); bf16_t* KC = (bf16_t*)(ws + WS_KC); bf16_t* VCT = KC + 2 * 1024 * 128;
    bf16_t* XB = (bf16_t*)(ws + WS_XB); bf16_t* H = (bf16_t*)(ws + WS_H);
    float* PRE3 = (float*)(ws + 384 * MiB);
    bf16_t* D0 = (bf16_t*)out; bf16_t* D1 = D0 + (size_t)M * DM;
    bf16_t* CQ = (bf16_t*)(ws + WS_CQ); bf16_t* CKV = (bf16_t*)(ws + WS_CKV); bf16_t* KR = (bf16_t*)(ws + WS_KR); bf16_t* GL = (bf16_t*)(ws + WS_GL);
    bf16_t* QN = (bf16_t*)(ws + WS_QN); bf16_t* KCR = (bf16_t*)(ws + WS_KCR); bf16_t* VCR = (bf16_t*)(ws + WS_VCR); bf16_t* KS = (bf16_t*)(ws + WS_KS);
    bf16_t* KW = (bf16_t*)(ws + WS_KW); bf16_t* VTN = (bf16_t*)(ws + WS_VTN); bf16_t* QM = (bf16_t*)(ws + WS_QM); bf16_t* KN = (bf16_t*)(ws + WS_KN);
    bf16_t* VT = (bf16_t*)(ws + WS_VT); float* OACC = (float*)(ws + WS_OACC);
    const int lo = args.ph_lo, hi_ph = args.ph_hi;
    unsigned* barctr = (unsigned*)(ws + WS_MISC + 65536); unsigned epoch = 0u;
    grid.sync();
#ifndef ONLY_PHASE
#define ONLY_PHASE -1
#endif
#define IN(k) ((ONLY_PHASE < 0 || ONLY_PHASE == (k)) && lo <= (k) && (k) < hi_ph)
#define SEAM(k) do { if (IN(k) && IN((k) + 1)) { \
        asm volatile("s_waitcnt vmcnt(0)" ::: "memory"); __syncthreads(); epoch += (unsigned)G; \
        if (threadIdx.x == 0) { __builtin_amdgcn_fence(__ATOMIC_RELEASE, "agent"); asm volatile("s_waitcnt vmcnt(0)" ::: "memory"); \
            __hip_atomic_fetch_add(barctr, 1u, __ATOMIC_RELAXED, __HIP_MEMORY_SCOPE_AGENT); \
            while (__hip_atomic_load(barctr, __ATOMIC_RELAXED, __HIP_MEMORY_SCOPE_AGENT) < epoch) __builtin_amdgcn_s_sleep(2); \
            __builtin_amdgcn_fence(__ATOMIC_ACQUIRE, "agent"); asm volatile("s_waitcnt vmcnt(0)" ::: "memory"); } \
        __syncthreads(); } } while (0)

    if (IN(0)) {
        PHASE_IDS;
        transpose_job<MAP_GU>(args.in[1], args.in[2], DFF, nullptr, DM, 2 * DFF, WGU, scr, gw, NGW, lane);
        transpose_job<MAP_PLAIN>(args.in[3], args.in[3], DM, nullptr, DFF, DM, WD, scr, gw, NGW, lane);
        transpose_job<MAP_WIN>(args.in[6], args.in[6], 3416, nullptr, DM, 3072, WIN, scr, gw, NGW, lane);
        transpose_job<MAP_WVN>(args.in[6], args.in[6], 3416, nullptr, DM, 512, WVN, scr, gw, NGW, lane);
        transpose_job<MAP_UQ>(args.in[8], args.in[8], 1536, args.in[7], 512, 1536, WUQ, scr, gw, NGW, lane);
        transpose_job<MAP_UKV0>(args.in[10], args.in[10], 2048, args.in[9], 256, 1024, WKN, scr, gw, NGW, lane);
        transpose_job<MAP_UKV1>(args.in[10], args.in[10], 2048, args.in[9], 256, 1024, WVM, scr, gw, NGW, lane);
        transpose_job<MAP_PLAIN>(args.in[13], args.in[13], 256, nullptr, 4096, 256, W1K, scr, gw, NGW, lane);
        transpose_job<MAP_PLAIN>(args.in[16], args.in[16], 256, nullptr, 4096, 256, W1V, scr, gw, NGW, lane);
        transpose_job<MAP_PLAIN>(args.in[18], args.in[18], DM, nullptr, DM, DM, WOUT, scr, gw, NGW, lane);
        { const float* x = args.in[0];
          const size_t nvec = (size_t)M * DM / 8;
          for (size_t i = gtid; i < nvec; i += (size_t)4 * NGT) {
              f32x4 a[4], b[4];
#pragma unroll
              for (int k = 0; k < 4; ++k) { const size_t ii = i + (size_t)k * NGT; if (ii < nvec) { a[k] = ((const f32x4*)x)[2 * ii]; b[k] = ((const f32x4*)x)[2 * ii + 1]; } }
#pragma unroll
              for (int k = 0; k < 4; ++k) { const size_t ii = i + (size_t)k * NGT; if (ii < nvec) {
                  u32x4 w; w.x = pk2(a[k][0], a[k][1]); w.y = pk2(a[k][2], a[k][3]); w.z = pk2(b[k][0], b[k][1]); w.w = pk2(b[k][2], b[k][3]); ((u32x4*)XB)[ii] = w; } }
          } }
        for (int i = gtid; i < M * 96; i += NGT) {
            int pos, f; double base; float* dst;
            if (i < M * 64) { pos = i >> 6; f = i & 63; base = 0.8659643233600653; dst = TAB128 + 2 * (size_t)i; }
            else { const int k = i - M * 64; pos = k >> 5; f = k & 31; base = 0.7498942093324558; dst = TAB64 + 2 * (size_t)k; }
            double inv = 1.0; for (int e = 0; e < f; ++e) inv *= base;
            const double ang = (double)pos * inv;
            const double kq = __builtin_rint(ang * 0.6366197723675814);
            double y = __builtin_fma(-kq, 1.5707963267948966, ang); y = __builtin_fma(-kq, 6.123233995736766e-17, y);
            const double y2 = y * y;
            double sn = -1.0 / 39916800.0; sn = sn * y2 + 1.0 / 362880.0; sn = sn * y2 - 1.0 / 5040.0; sn = sn * y2 + 1.0 / 120.0; sn = sn * y2 - 1.0 / 6.0; sn = sn * y2 * y + y;
            double cs = 1.0 / 479001600.0; cs = cs * y2 - 1.0 / 3628800.0; cs = cs * y2 + 1.0 / 40320.0; cs = cs * y2 - 1.0 / 720.0; cs = cs * y2 + 1.0 / 24.0; cs = cs * y2 - 0.5; cs = cs * y2 + 1.0;
            const int qd = ((int)((long long)kq & 3));
            double c, s; if (qd == 0) { c = cs; s = sn; } else if (qd == 1) { c = -sn; s = cs; } else if (qd == 2) { c = -cs; s = -sn; } else { c = sn; s = -cs; }
            dst[0] = (float)c; dst[1] = (float)s;
        }
        for (int item = bx; item < 256; item += G) {
            const int kv = item >> 7, n = 2 * (item & 127) + (tid & 1), k0 = (tid >> 1) * 16;
            const float* pe = args.in[kv ? 15 : 12]; const float* w1 = args.in[kv ? 16 : 13];
            float sacc = 0.f;
#pragma unroll
            for (int k = 0; k < 16; ++k) sacc += pe[k0 + k] * w1[(size_t)(k0 + k) * 256 + n];
            LAS float* red = (LAS float*)lds;
            __syncthreads(); red[tid] = sacc; __syncthreads();
            for (int st = 256; st >= 2; st >>= 1) { if (tid < st) red[tid] += red[tid + st]; __syncthreads(); }
            if (tid < 2) CBIAS[kv * 256 + 2 * (item & 127) + tid] = red[tid];
            __syncthreads();
        }
    }
    SEAM(0);
    if (IN(1)) for (int rep1 = 0; rep1 < PROBE_REP1; ++rep1) { pg8::Gemm g{XB, WGU, DM, DM, DM}; pg8::StaticOrder S; S.init(64, 44, G, bx); EpiSwiglu E{H}; pg8::gemm_phase(lds, g, S, E); }
    SEAM(1);
    if (IN(2)) { pg8::Gemm g{H, WD, DFF, DFF, DFF}; pg8::StaticOrder S; S.init(64, 8, G, bx); EpiResidB<false> E{args.in[0], D0, ALPHA, 0.5f}; pg8::gemm_phase(lds, g, S, E); }
    SEAM(2);
    if (IN(3)) {
        PHASE_IDS;
        { f32x4 gq[8], bq[8]; ln_load_gb(gq, bq, args.in[4], args.in[5], lane);
          for (int r = gw; r < M; r += 2 * NGW) { const int r2 = r + NGW; u32x4 xa[4], xb2[4];
#pragma unroll
              for (int j = 0; j < 4; ++j) { xa[j] = *(const u32x4*)(D0 + (size_t)r * DM + 8 * lane + 512 * j); if (r2 < M) xb2[j] = *(const u32x4*)(D0 + (size_t)r2 * DM + 8 * lane + 512 * j); }
              ln_row_b<false>(xa, D1 + (size_t)r * DM, gq, bq, lane); if (r2 < M) ln_row_b<false>(xb2, D1 + (size_t)r2 * DM, gq, bq, lane); } }
        transpose_job<MAP_GU>(args.in[21], args.in[22], DFF, nullptr, DM, 2 * DFF, WGU, scr, gw, NGW, lane);
        transpose_job<MAP_PLAIN>(args.in[23], args.in[23], DM, nullptr, DFF, DM, WD, scr, gw, NGW, lane);
    }
    SEAM(3);
    if (IN(4)) {
        { pg8::Gemm g{D1, WIN, DM, DM, DM}; pg8::StaticOrder S; S.init(64, 12, G, bx);
          EpiWin E{CQ, CKV, KR, GL, QN, KCR, VCR, KS, KW, SSQ, TAB128, TAB64}; pg8::gemm_phase(lds, g, S, E); }
        { pg8::Gemm g{WVN, D1, DM, DM, DM}; pg8::StaticOrder S; S.init(2, 64, G, bx); EpiColBf16 E{VTN, M, nullptr}; pg8::gemm_phase(lds, g, S, E); }
    }
    SEAM(4);
    if (IN(5)) {
        int off = 0;
        for (int job = 0; job < 16; ++job) { const int kv = job >> 3, hk = (job >> 2) & 1, sp = job & 3;
            pg8::Gemm g{(kv ? VCR : KCR) + (size_t)hk * M * 128 + sp * 1024, (kv ? W1V : W1K) + sp * 1024, 2048, 4096, 1024};
            pg8::StaticOrder S; S.init(4, 1, G, (bx + G - (off % G)) % G); EpiF32 E{HCP + (size_t)job * 1024 * 256, 256}; pg8::gemm_phase(lds, g, S, E); off += 4; }
        { pg8::Gemm g{CQ, WUQ, 512, 512, 512}; pg8::StaticOrder S; S.init(64, 6, G, (bx + G - (off % G)) % G); EpiQup E{QM, SSQ, TAB64}; pg8::gemm_phase(lds, g, S, E); off += 384; }
        { pg8::Gemm g{CKV, WKN, 256, 256, 256}; pg8::StaticOrder S; S.init(64, 4, G, (bx + G - (off % G)) % G); EpiKn E{KN, SSQ}; pg8::gemm_phase(lds, g, S, E); off += 256; }
        { pg8::Gemm g{WVM, CKV, 256, 256, 256}; pg8::StaticOrder S; S.init(4, 64, G, (bx + G - (off % G)) % G); EpiColBf16 E{VT, M, SSQ}; pg8::gemm_phase(lds, g, S, E); }
    }
    SEAM(5);
    if (IN(6)) {
        PHASE_IDS;
        LAS float* hid = (LAS float*)lds;
        for (int item = bx; item < 256; item += G) {
            const int kv = item >> 7, hk = (item >> 6) & 1, c0 = 16 * (item & 63);
            const float* hp = HCP + (size_t)((kv * 2 + hk) * 4) * 1024 * 256;
#pragma unroll
            for (int e = 0; e < 8; ++e) { const int idx = tid + 512 * e, c = idx >> 8, n = idx & 255; const size_t o = (size_t)(c0 + c) * 256 + n;
                float s = hp[o] + hp[o + 262144] + hp[o + 524288] + hp[o + 786432] + CBIAS[kv * 256 + n];
                const float u = 0.7978845608028654f * (s + 0.044715f * s * s * s);
                const float e2 = __builtin_amdgcn_exp2f(2.f * u * 1.4426950408889634f);
                const float th = 1.f - 2.f / (e2 + 1.f);
                hid[idx] = 0.5f * s * (1.f + th); }
            __syncthreads();
            const int d = tid & 127, cg4 = tid >> 7; const float* w2 = args.in[kv ? 17 : 14];
            float a0 = 0.f, a1 = 0.f, a2 = 0.f, a3 = 0.f;
#pragma unroll 16
            for (int n = 0; n < 256; ++n) { const float wv = w2[n * 128 + d]; a0 += hid[(4 * cg4) * 256 + n] * wv; a1 += hid[(4 * cg4 + 1) * 256 + n] * wv; a2 += hid[(4 * cg4 + 2) * 256 + n] * wv; a3 += hid[(4 * cg4 + 3) * 256 + n] * wv; }
            float av[4] = {a0, a1, a2, a3};
#pragma unroll
            for (int j = 0; j < 4; ++j) { const int c = c0 + 4 * cg4 + j; const float v = (c == 1023) ? 0.f : av[j]; const bf16_t b = (bf16_t)(pk2(v, 0.f) & 0xffffu);
                if (kv == 0) KC[((size_t)hk * 1024 + c) * 128 + d] = b; else { const int cpos = (c & ~15) | (c & 3) | ((c & 4) << 1) | ((c & 8) >> 1); VCT[((size_t)hk * 128 + d) * 1024 + cpos] = b; } }
            __syncthreads();
        }
    }
    SEAM(6);
    if (IN(7)) {
        PHASE_IDS;
        AttnPtrs P{ws, args.in[11]};
        LAS float* wsf = (LAS float*)(lds + WSF_OFF) + wave * 32;
        for (int rep7 = 0; rep7 < PROBE_REP7; ++rep7)
        for (int c = bx; c < 256; c += G) {
            const int x = c & 7, y = c >> 3;
#ifndef NO_NSA
            { const int hk = x & 1, pair = (x >> 1) * 32 + y;
#pragma unroll 1
              for (int rep = 0; rep < 2; ++rep) nsa_unit(hk, rep ? pair : 255 - pair, lds, wsf, P); }
#endif
#ifndef NO_MLA
            { const int h = x, pair = y;
#pragma unroll 1
              for (int rep = 0; rep < 2; ++rep) mla_unit(h, rep ? pair : 63 - pair, lds, wsf, P); }
#endif
        }
    }
    SEAM(7);
    if (IN(8)) { pg8::Gemm g{XB, WOUT, DM, DM, DM}; pg8::StaticOrder S; S.init(64, 8, G, bx); EpiResidB<true> E{D1, D0, ALPHA, 1.0f}; pg8::gemm_phase(lds, g, S, E); }
    SEAM(8);
    if (IN(9)) { PHASE_IDS; f32x4 gq[8], bq[8]; ln_load_gb(gq, bq, args.in[19], args.in[20], lane); for (int r = gw; r < M; r += 2 * NGW) { const int r2 = r + NGW; u32x4 xa[4], xb2[4];
#pragma unroll
            for (int j = 0; j < 4; ++j) { xa[j] = *(const u32x4*)(D0 + (size_t)r * DM + 8 * lane + 512 * j); if (r2 < M) xb2[j] = *(const u32x4*)(D0 + (size_t)r2 * DM + 8 * lane + 512 * j); }
            ln_row_b<false>(xa, D1 + (size_t)r * DM, gq, bq, lane); if (r2 < M) ln_row_b<false>(xb2, D1 + (size_t)r2 * DM, gq, bq, lane); } }
    SEAM(9);
    if (IN(10)) { pg8::Gemm g{D1, WGU, DM, DM, DM}; pg8::StaticOrder S; S.init(64, 44, G, bx); EpiSwiglu E{H}; pg8::gemm_phase(lds, g, S, E); }
    SEAM(10);
    if (IN(11)) { pg8::Gemm g{H, WD, DFF, DFF, DFF}; pg8::StaticOrder S; S.init(64, 8, G, bx); EpiResidB<true, true> E{D1, PRE3, ALPHA, 0.5f}; pg8::gemm_phase(lds, g, S, E); }
    SEAM(11);
    if (IN(12)) { PHASE_IDS; f32x4 gq[8], bq[8];
#pragma unroll
        for (int j = 0; j < 8; ++j) { gq[j] = ((const f32x4*)args.in[24])[64 * j + lane]; bq[j] = ((const f32x4*)args.in[25])[64 * j + lane]; }
        for (int r = gw; r < M; r += NGW) ln_row(PRE3 + (size_t)r * DM, out + (size_t)r * DM, nullptr, gq, bq, lane); }
#undef IN
#undef SEAM
}

#ifndef MK_PER_PHASE
#define MK_PER_PHASE 0
#endif
extern "C" void kernel_launch(void* const* d_in, const int* in_sizes, int n_in, void* d_out, int out_size, void* d_ws, size_t ws_size, hipStream_t stream) {
    static int grid = 0;
    if (grid == 0) {
        if (n_in != 26 || out_size != M * DM || ws_size < 512 * MiB) { fprintf(stderr, "kernel_launch: unexpected shapes (n_in %d out %d ws %zu)\n", n_in, out_size, ws_size); grid = -1; return; }
        int dev = 0, cus = 0, per_cu = 0;
        hipGetDevice(&dev); hipDeviceGetAttribute(&cus, hipDeviceAttributeMultiprocessorCount, dev);
        hipFuncSetAttribute((const void*)mega_fwd, hipFuncAttributeMaxDynamicSharedMemorySize, LDS_BYTES);
        if (hipOccupancyMaxActiveBlocksPerMultiprocessor(&per_cu, (const void*)mega_fwd, NTHREADS, LDS_BYTES) != hipSuccess || per_cu < 1) per_cu = 1;
        (void)hipGetLastError();
        grid = cus * per_cu;
    }
    if (grid < 0) return;
    Args a{};
    for (int i = 0; i < 26; ++i) a.in[i] = (const float*)d_in[i];
    a.out = (float*)d_out; a.ws = (unsigned char*)d_ws;
#if MK_PER_PHASE
    for (int p = 0; p < N_PHASES; ++p) { a.ph_lo = p; a.ph_hi = p + 1; void* kargs[] = {&a};
        hipError_t e = hipLaunchCooperativeKernel((const void*)mega_fwd, dim3(grid), dim3(NTHREADS), kargs, LDS_BYTES, stream);
        if (e != hipSuccess) { fprintf(stderr, "launch failed: %s\n", hipGetErrorString(e)); break; } }
#else
    (void)hipMemsetAsync((unsigned char*)d_ws + WS_MISC + 65536, 0, 256, stream);
    a.ph_lo = 0; a.ph_hi = N_PHASES; void* kargs[] = {&a};
    hipError_t e = hipLaunchCooperativeKernel((const void*)mega_fwd, dim3(grid), dim3(NTHREADS), kargs, LDS_BYTES, stream);
    if (e != hipSuccess) fprintf(stderr, "cooperative launch failed: %s (grid %d)\n", hipGetErrorString(e), grid);
#endif
}
```
